# Optimizing an MI355X kernel written in HIP

```python
import functools
import jax, jax.numpy as jnp
from jax import lax
import numpy as np

D_MODEL = 1024
BATCH = 8
SEQ = 2048
DEPTH = 1
DEC_BATCH = 128
DEC_SEQ = 8
PAST_LEN = 16384
PAGE_SIZE = 128

PLE_DIM = 256
NORM_EPS = 1e-6
GLA_HEADS = 4
GLA_DK = 64
GLA_DV = 128
GLA_KEY = GLA_HEADS * GLA_DK
GLA_VAL = GLA_HEADS * GLA_DV
GLA_GATE_RANK = 16
GLA_GATE_TEMP = 16.0
GLA_CHUNK = 16
GDN_HEADS = 4
GDN_DK = 128
GDN_DV = 128
GDN_KEY = GDN_HEADS * GDN_DK
GDN_VAL = GDN_HEADS * GDN_DV
GDN_CHUNK = 64
CONV_WIDTH = 4
CONV_CH = 2 * GDN_KEY + GDN_VAL
IN_SPLITS = (GLA_KEY, GLA_KEY, GLA_VAL, GLA_GATE_RANK, GLA_VAL,
             CONV_CH, GDN_HEADS, GDN_HEADS, GDN_VAL,
             D_MODEL, D_MODEL)
IN_COLS = sum(IN_SPLITS)

kernel_name = "hybrid_gla_gated_deltanet_decode_step"


def _split_offsets():
    return [int(v) for v in np.cumsum(IN_SPLITS)[:-1]]


def rms_norm(x, w):
    xf = x.astype(jnp.float32)
    y = xf * lax.rsqrt(jnp.mean(xf * xf, axis=-1, keepdims=True) + NORM_EPS)
    return (y * w.astype(jnp.float32)).astype(x.dtype)


def _l2norm(x):
    return x * lax.rsqrt(jnp.sum(x * x, axis=-1, keepdims=True) + NORM_EPS)


def _heads(x, n_heads):
    b, t, _ = x.shape
    return x.reshape(b, t, n_heads, -1).transpose(0, 2, 1, 3)


def _chunk(x, c):
    t = x.shape[2]
    n = -(-t // c)
    pad = n * c - t
    if pad:
        x = jnp.pad(x, [(0, 0), (0, 0), (0, pad)] + [(0, 0)] * (x.ndim - 3))
    return x.reshape(x.shape[:2] + (n, c) + x.shape[3:])


def gla_recurrence(q, k, v, gk, s0):
    t_len = q.shape[2]
    c = min(GLA_CHUNK, t_len)
    q, k, v, gk = (_chunk(a_.astype(jnp.float32), c) for a_ in (q, k, v, gk))
    b = jnp.cumsum(gk, axis=3)
    b_last = b[:, :, :, -1:, :]
    q_e = q * jnp.exp(b)
    k_e = k * jnp.exp(-b)
    k_end = k * jnp.exp(b_last - b)
    causal = jnp.tril(jnp.ones((c, c), dtype=bool))
    att = jnp.where(causal, jnp.einsum('bhncd,bhnsd->bhncs', q_e, k_e), 0.0)
    o_intra = jnp.einsum('bhncs,bhnsv->bhncv', att, v)
    chunk_decay = jnp.exp(b_last[:, :, :, 0, :])

    def step(s, inp):
        q_c, k_c, v_c, d_c = inp
        o_c = jnp.einsum('bhcd,bhdv->bhcv', q_c, s)
        s = s * d_c[..., None] + jnp.einsum('bhcd,bhcv->bhdv', k_c, v_c)
        return s, o_c

    xs = tuple(jnp.moveaxis(a_, 2, 0) for a_ in (q_e, k_end, v, chunk_decay))
    s_fin, o_inter = lax.scan(step, s0.astype(jnp.float32), xs)
    o = o_intra + jnp.moveaxis(o_inter, 0, 2)
    bsz, nh, n, _, dv = o.shape
    return o.reshape(bsz, nh, n * c, dv)[:, :, :t_len], s_fin


def gdn_recurrence(q, k, v, g, beta, s0):
    t_len = q.shape[2]
    c = min(GDN_CHUNK, t_len)
    q, k, v, g, beta = (_chunk(a_.astype(jnp.float32), c) for a_ in (q, k, v, g, beta))
    decay = jnp.cumsum(g, axis=-1)
    diff = decay[..., :, None] - decay[..., None, :]
    causal = jnp.tril(jnp.ones((c, c), dtype=bool))
    strict = jnp.tril(jnp.ones((c, c), dtype=bool), -1)
    gamma = jnp.where(causal, jnp.exp(jnp.where(causal, diff, 0.0)), 0.0)
    k_beta = k * beta[..., None]
    v_beta = v * beta[..., None]
    a_mat = jnp.where(strict, jnp.einsum('bhnid,bhnjd->bhnij', k_beta, k) * gamma, 0.0)
    t_mat = a_mat + jnp.eye(c, dtype=jnp.float32)
    solve = functools.partial(lax.linalg.triangular_solve, left_side=True, lower=True,
                              unit_diagonal=True)
    u = solve(t_mat, v_beta)
    w = solve(t_mat, k_beta * jnp.exp(decay)[..., None])
    qk = jnp.einsum('bhnid,bhnjd->bhnij', q, k) * gamma
    q_e = q * jnp.exp(decay)[..., None]
    d_last = decay[..., -1:]
    k_end = k * jnp.exp(d_last - decay)[..., None]
    chunk_decay = jnp.exp(d_last[..., 0])

    def step(s, inp):
        w_c, u_c, q_c, qk_c, k_c, d_c = inp
        v_new = u_c - jnp.einsum('bhcd,bhdv->bhcv', w_c, s)
        o_c = jnp.einsum('bhcd,bhdv->bhcv', q_c, s) + jnp.einsum('bhcs,bhsv->bhcv', qk_c, v_new)
        s = s * d_c[..., None, None] + jnp.einsum('bhcd,bhcv->bhdv', k_c, v_new)
        return s, o_c

    xs = tuple(jnp.moveaxis(a_, 2, 0) for a_ in (w, u, q_e, qk, k_end, chunk_decay))
    s_fin, o = lax.scan(step, s0.astype(jnp.float32), xs)
    o = jnp.moveaxis(o, 0, 2)
    bsz, nh, n, _, dv = o.shape
    return o.reshape(bsz, nh, n * c, dv)[:, :, :t_len], s_fin


def mixer_layer(h, p, s_gla, s_gdn, conv_buf, norm_w, w_in, w_gla_gate, b_gla_gate, gla_norm_w,
                conv_w, gdn_a_log, gdn_dt_bias, gdn_norm_w, w_up_gla, w_up_gdn, w_out,
                w_ple_gate, w_ple):
    bsz, t_len, _ = h.shape
    f32 = jnp.float32
    xn = rms_norm(h, norm_w)
    proj = xn @ w_in
    (q_a, k_a, v_a, g_a, z_a, qkv_b, a_b, b_b, z_b, gate_a, gate_b) = jnp.split(
        proj, _split_offsets(), axis=-1)

    gk = jax.nn.log_sigmoid((g_a @ w_gla_gate + b_gla_gate).astype(f32)) / GLA_GATE_TEMP
    o_a, s_gla_new = gla_recurrence(_heads(q_a, GLA_HEADS) * GLA_DK ** -0.5,
                                    _heads(k_a, GLA_HEADS), _heads(v_a, GLA_HEADS),
                                    _heads(gk, GLA_HEADS), s_gla)
    o_a = rms_norm(o_a.transpose(0, 2, 1, 3), gla_norm_w).reshape(bsz, t_len, GLA_VAL)
    y_a = (o_a.astype(h.dtype) * jax.nn.silu(z_a)) @ w_up_gla

    xpad = jnp.concatenate([conv_buf.astype(qkv_b.dtype), qkv_b], axis=1)
    conv = lax.conv_general_dilated(xpad.astype(f32), conv_w.astype(f32)[:, None, :], (1,), 'VALID',
                                    dimension_numbers=('NWC', 'WIO', 'NWC'),
                                    feature_group_count=CONV_CH)
    conv = jax.nn.silu(conv)
    conv_new = xpad[:, -(CONV_WIDTH - 1):, :]
    q_b, k_b, v_b = jnp.split(conv, [GDN_KEY, 2 * GDN_KEY], axis=-1)
    q_b = _l2norm(_heads(q_b, GDN_HEADS)) * GDN_DK ** -0.5
    k_b = _l2norm(_heads(k_b, GDN_HEADS))
    v_b = _heads(v_b, GDN_HEADS)
    beta = jax.nn.sigmoid(b_b.astype(f32)).transpose(0, 2, 1)
    g = (-jnp.exp(gdn_a_log.astype(f32)) *
         jax.nn.softplus((a_b + gdn_dt_bias).astype(f32))).transpose(0, 2, 1)
    o_b, s_gdn_new = gdn_recurrence(q_b, k_b, v_b, g, beta, s_gdn)
    o_b = rms_norm(o_b.transpose(0, 2, 1, 3), gdn_norm_w).reshape(bsz, t_len, GDN_VAL)
    y_b = (o_b.astype(h.dtype) * jax.nn.silu(z_b)) @ w_up_gdn

    merged = jax.nn.sigmoid(gate_a) * y_a + jax.nn.sigmoid(gate_b) * y_b
    h = h + merged @ w_out
    h = h + jax.nn.sigmoid(h @ w_ple_gate) * (p @ w_ple)
    return (h, s_gla_new.astype(h.dtype), s_gdn_new.astype(h.dtype), conv_new.astype(h.dtype))


def trunk(h, p, s_gla, s_gdn, conv_buf, norm_w, w_in, w_gla_gate, b_gla_gate, gla_norm_w, conv_w,
          gdn_a_log, gdn_dt_bias, gdn_norm_w, w_up_gla, w_up_gdn, w_out, w_ple_gate, w_ple,
          final_norm_w):
    new_gla, new_gdn, new_conv = [], [], []
    for i in range(DEPTH):
        h, sg, sd, cb = mixer_layer(h, p[i], s_gla[i], s_gdn[i], conv_buf[i], norm_w[i], w_in[i],
                                    w_gla_gate[i], b_gla_gate[i], gla_norm_w[i], conv_w[i],
                                    gdn_a_log[i], gdn_dt_bias[i], gdn_norm_w[i], w_up_gla[i],
                                    w_up_gdn[i], w_out[i], w_ple_gate[i], w_ple[i])
        new_gla.append(sg)
        new_gdn.append(sd)
        new_conv.append(cb)
    y = rms_norm(h, final_norm_w)
    return y, jnp.stack(new_gla), jnp.stack(new_gdn), jnp.stack(new_conv)


def setup_inputs(seed: int = 0) -> dict:
    key = jax.random.key(seed)
    ks = jax.random.split(key, 24)
    f32 = jnp.float32
    nrm = lambda k, shape, scale: jax.random.normal(k, shape, f32) * scale
    dt = jnp.exp(jax.random.uniform(ks[12], (DEPTH, GDN_HEADS), f32,
                                    minval=float(np.log(1e-3)), maxval=float(np.log(1e-1))))
    return {
        "x_prompt": nrm(ks[0], (BATCH, SEQ, D_MODEL), 1.0),
        "x_sample": nrm(ks[1], (DEC_BATCH, DEC_SEQ, D_MODEL), 1.0),
        "state_gla": nrm(ks[2], (DEPTH, DEC_BATCH, GLA_HEADS, GLA_DK, GLA_DV), 0.5),
        "state_gdn": nrm(ks[3], (DEPTH, DEC_BATCH, GDN_HEADS, GDN_DK, GDN_DV), 0.5),
        "state_conv": nrm(ks[4], (DEPTH, DEC_BATCH, CONV_WIDTH - 1, CONV_CH), 1.0),
        "p_prompt": nrm(ks[5], (DEPTH, BATCH, SEQ, PLE_DIM), 1.0),
        "p_sample": nrm(ks[6], (DEPTH, DEC_BATCH, DEC_SEQ, PLE_DIM), 1.0),
        "norm_w": 1.0 + nrm(ks[7], (DEPTH, D_MODEL), 0.02),
        "w_in": nrm(ks[8], (DEPTH, D_MODEL, IN_COLS), D_MODEL ** -0.5),
        "w_gla_gate": nrm(ks[9], (DEPTH, GLA_GATE_RANK, GLA_KEY), GLA_GATE_RANK ** -0.5),
        "b_gla_gate": nrm(ks[10], (DEPTH, GLA_KEY), 0.1),
        "gla_norm_w": 1.0 + nrm(ks[11], (DEPTH, GLA_DV), 0.02),
        "conv_w": nrm(ks[13], (DEPTH, CONV_WIDTH, CONV_CH), CONV_WIDTH ** -0.5),
        "gdn_a_log": jnp.log(jax.random.uniform(ks[14], (DEPTH, GDN_HEADS), f32, minval=1.0, maxval=16.0)),
        "gdn_dt_bias": dt + jnp.log(-jnp.expm1(-dt)),
        "gdn_norm_w": 1.0 + nrm(ks[15], (DEPTH, GDN_DV), 0.02),
        "w_up_gla": nrm(ks[16], (DEPTH, GLA_VAL, D_MODEL), GLA_VAL ** -0.5),
        "w_up_gdn": nrm(ks[17], (DEPTH, GDN_VAL, D_MODEL), GDN_VAL ** -0.5),
        "w_out": nrm(ks[18], (DEPTH, D_MODEL, D_MODEL), D_MODEL ** -0.5),
        "w_ple_gate": nrm(ks[19], (DEPTH, D_MODEL, D_MODEL), D_MODEL ** -0.5),
        "w_ple": nrm(ks[20], (DEPTH, PLE_DIM, D_MODEL), PLE_DIM ** -0.5),
        "final_norm_w": 1.0 + nrm(ks[21], (D_MODEL,), 0.02),
    }


def reference(x_prompt, x_sample, state_gla, state_gdn, state_conv, p_prompt, p_sample, norm_w, w_in,
              w_gla_gate, b_gla_gate, gla_norm_w, conv_w, gdn_a_log, gdn_dt_bias, gdn_norm_w,
              w_up_gla, w_up_gdn, w_out, w_ple_gate, w_ple, final_norm_w):
    bsz = x_prompt.shape[0]
    dt_ = x_prompt.dtype
    zero_gla = jnp.zeros((DEPTH, bsz, GLA_HEADS, GLA_DK, GLA_DV), dt_)
    zero_gdn = jnp.zeros((DEPTH, bsz, GDN_HEADS, GDN_DK, GDN_DV), dt_)
    zero_conv = jnp.zeros((DEPTH, bsz, CONV_WIDTH - 1, CONV_CH), dt_)
    y_prompt, gla_p, gdn_p, conv_p = trunk(
        x_prompt, p_prompt, zero_gla, zero_gdn, zero_conv, norm_w, w_in, w_gla_gate, b_gla_gate,
        gla_norm_w, conv_w, gdn_a_log, gdn_dt_bias, gdn_norm_w, w_up_gla, w_up_gdn, w_out,
        w_ple_gate, w_ple, final_norm_w)
    y_sample, gla_s, gdn_s, conv_s = trunk(
        x_sample, p_sample, state_gla, state_gdn, state_conv, norm_w, w_in, w_gla_gate, b_gla_gate,
        gla_norm_w, conv_w, gdn_a_log, gdn_dt_bias, gdn_norm_w, w_up_gla, w_up_gdn, w_out,
        w_ple_gate, w_ple, final_norm_w)
    return (y_prompt, y_sample, gla_p, gdn_p, conv_p, gla_s, gdn_s, conv_s)
```

```cpp
#include <hip/hip_runtime.h>
#include <cstdio>
#include <cstdint>
#define MK_N_LAUNCHES 1
namespace pg8 {
#define PG8_LAS __attribute__((address_space(3)))
typedef unsigned short bf16_t;
typedef short bf16x8 __attribute__((ext_vector_type(8)));
typedef float f32x4 __attribute__((ext_vector_type(4)));
typedef unsigned u32x4 __attribute__((ext_vector_type(4)));
constexpr int BM = 256, BK = 64, HALF = 128, HTB = HALF * BK * 2  , STAGE_BYTES = 8 * HTB, NXCD = 8, WGM = 8;

__host__ __device__ __forceinline__ int lds_byte(int r, int c) { const int st = (r >> 4) * 2 + (c >> 5), rr = r & 15, cc = c & 31, ob = rr * 64 + cc * 2; return st * 1024 + (ob ^ (((ob >> 9) & 1) << 5)); }
__host__ __device__ __forceinline__ void stage_rc(int b, int& R, int& C) { const int st = b / 1024, sb = b % 1024, swz = sb ^ (((sb >> 9) & 1) << 5); R = (st >> 1) * 16 + swz / 64; C = (st & 1) * 32 + (swz % 64) / 2; }
__host__ __device__ __forceinline__ int perm32(int rho) { const int n = rho >> 4, i = rho & 15; return 8 * (i >> 2) + 4 * n + (i & 3); }

struct Unit { int pm, pn; };
struct Gemm { const bf16_t* A; const bf16_t* Bt; int M, N, K; };

struct StaticOrder {
    int nM, nN, nwg, G, c;
    __host__ __device__ void init(int M, int N, int G_, int c_) { nM = M / BM; nN = N / BM; nwg = nM * nN; G = G_; c = c_; }
    __host__ __device__ bool next(int i, Unit& u) const {
        const long L = (long)i * G + c; if (L >= nwg) return false;
        int wgid = (int)L; { const int q = nwg / NXCD, r = nwg % NXCD, xcd = wgid % NXCD, off = wgid / NXCD; wgid = (xcd < r ? xcd * (q + 1) : r * (q + 1) + (xcd - r) * q) + off; }
        const int nig = WGM * nN, gid = wgid / nig, fm = gid * WGM, gsz = (nM - fm) < WGM ? (nM - fm) : WGM;
        u.pm = fm + ((wgid % nig) % gsz); u.pn = (wgid % nig) / gsz; return true;
    }
    __device__ __forceinline__ void a_ready(const Unit&) const {}
    __device__ __forceinline__ void done(const Unit&) const {}
};

__device__ __forceinline__ unsigned cvt_pk_bf16(float lo, float hi) { unsigned r; asm volatile("v_cvt_pk_bf16_f32 %0, %1, %2" : "=v"(r) : "v"(lo), "v"(hi)); return r; }

template <class Epi, class Sched>
__device__ __forceinline__ void gemm_phase(PG8_LAS unsigned char* lds, const Gemm g, const Sched& S, const Epi& E) {
    const int tid = threadIdx.x, wid = __builtin_amdgcn_readfirstlane(tid >> 6), lane = tid & 63, wr = wid >> 2, wc = wid & 3, fr = lane & 15, fq = lane >> 4;
    const int K = g.K, nt = K / BK;
    unsigned voffA[2], voffB[2];
#pragma unroll
    for (int i = 0; i < 2; ++i) { int R, C; stage_rc(tid * 16 + i * 8192, R, C); const int Rb = Epi::PERM ? ((R & ~31) + perm32(R & 31)) : R;
        voffA[i] = (unsigned)(R * K + C) * 2u; voffB[i] = (unsigned)(Rb * K + C) * 2u; }
    const size_t kstep = (size_t)(BK * 2);
    const size_t hstep = (size_t)HALF * K * 2;
    const size_t tstep = 2 * hstep;
    const unsigned ldsw = (unsigned)wid * 1024u;
    const int aoff = lds_byte(wr * 64 + fr, fq * 8), boff = lds_byte(wc * 32 + fr, fq * 8);
#define PG8_SA(b, h) (((b) * 2 + (h)) * HTB)
#define PG8_SB(b, h) ((4 + (b) * 2 + (h)) * HTB)
#define PG8_STAGE(bufoff, gbase, voff) do { _Pragma("unroll") for (int _i = 0; _i < 2; ++_i) \
        __builtin_amdgcn_global_load_lds((const unsigned*)((const char*)(gbase) + (voff)[_i]), (PG8_LAS unsigned*)(lds + (bufoff) + ldsw + _i * 8192), 16, 0, 0); } while (0)
#define PG8_LDA(dst, b, h) do { _Pragma("unroll") for (int m = 0; m < 4; ++m) _Pragma("unroll") for (int k = 0; k < 2; ++k) dst[m][k] = *(const PG8_LAS bf16x8*)(lds + PG8_SA(b, h) + aoff + m * 2048 + k * 1024); } while (0)
#define PG8_LDB(dst, b, h) do { _Pragma("unroll") for (int n = 0; n < 2; ++n) _Pragma("unroll") for (int k = 0; k < 2; ++k) dst[n][k] = *(const PG8_LAS bf16x8*)(lds + PG8_SB(b, h) + boff + n * 2048 + k * 1024); } while (0)
#define PG8_MMA(ai, bj, At, Bt) do { __builtin_amdgcn_s_setprio(1); _Pragma("unroll") for (int m = 0; m < 4; ++m) _Pragma("unroll") for (int n = 0; n < 2; ++n) _Pragma("unroll") for (int k = 0; k < 2; ++k) \
        acc[ai][bj][m][n] = __builtin_amdgcn_mfma_f32_16x16x32_bf16(Bt[n][k], At[m][k], acc[ai][bj][m][n], 0, 0, 0); __builtin_amdgcn_s_setprio(0); } while (0)
#define PG8_WAIT_V(n) asm volatile("s_waitcnt vmcnt(" #n ")" ::: "memory")
#define PG8_WAIT_L(n) asm volatile("s_waitcnt lgkmcnt(" #n ")" ::: "memory")
#define PG8_BAR __builtin_amdgcn_s_barrier()
#define PG8_SCHED __builtin_amdgcn_sched_barrier(0)
    Unit cur, nxt; int ui = 0;
    if (!S.next(0, cur)) return;
    f32x4 acc[2][2][4][2];
#pragma unroll
    for (int a = 0; a < 2; ++a)
#pragma unroll
        for (int b = 0; b < 2; ++b)
#pragma unroll
            for (int m = 0; m < 4; ++m)
#pragma unroll
                for (int n = 0; n < 2; ++n) acc[a][b][m][n] = (f32x4){0.f, 0.f, 0.f, 0.f};
    bf16x8 At[4][2], B0[2][2], B1[2][2];
    const char* cA = (const char*)g.A + (size_t)cur.pm * tstep; const char* cB = (const char*)g.Bt + (size_t)cur.pn * tstep;
    S.a_ready(cur);
    PG8_STAGE(PG8_SB(0, 0), cB, voffB); PG8_STAGE(PG8_SA(0, 0), cA, voffA); PG8_STAGE(PG8_SB(0, 1), cB + hstep, voffB); PG8_STAGE(PG8_SA(0, 1), cA + hstep, voffA);
    if (wr == 1) PG8_BAR;
    PG8_WAIT_V(4); PG8_BAR;
    PG8_STAGE(PG8_SB(1, 0), cB + kstep, voffB); PG8_STAGE(PG8_SA(1, 0), cA + kstep, voffA); PG8_STAGE(PG8_SB(1, 1), cB + hstep + kstep, voffB);
    PG8_WAIT_V(6); PG8_BAR;
    for (;;) {
        const bool has_next = S.next(ui + 1, nxt);
        const char* nA = has_next ? (const char*)g.A + (size_t)nxt.pm * tstep : cA; const char* nB = has_next ? (const char*)g.Bt + (size_t)nxt.pn * tstep : cB;
        for (int t = 0; t < nt; t += 2) {
            const bool last = (t == nt - 2);
            const char* a1 = cA + (size_t)(t + 1) * kstep;
            const char* a2 = last ? nA : cA + (size_t)(t + 2) * kstep; const char* b2 = last ? nB : cB + (size_t)(t + 2) * kstep;
            const char* a3 = a2 + kstep; const char* b3 = b2 + kstep;
            if (last && has_next) S.a_ready(nxt);
            PG8_LDB(B0, 0, 0); PG8_SCHED; PG8_LDA(At, 0, 0); PG8_STAGE(PG8_SA(1, 1), a1 + hstep, voffA);
            PG8_WAIT_L(8); PG8_BAR; PG8_WAIT_L(0); PG8_MMA(0, 0, At, B0); PG8_BAR; PG8_SCHED;
            PG8_LDB(B1, 0, 1); PG8_STAGE(PG8_SB(0, 0), b2, voffB);
            PG8_BAR; PG8_WAIT_L(0); PG8_MMA(0, 1, At, B1); PG8_BAR;
            PG8_LDA(At, 0, 1); PG8_STAGE(PG8_SA(0, 0), a2, voffA);
            PG8_BAR; PG8_WAIT_L(0); PG8_MMA(1, 0, At, B0); PG8_BAR; PG8_SCHED;
            PG8_STAGE(PG8_SB(0, 1), b2 + hstep, voffB);
            PG8_WAIT_V(6); PG8_BAR; PG8_MMA(1, 1, At, B1); PG8_BAR;
            PG8_LDB(B0, 1, 0); PG8_SCHED; PG8_LDA(At, 1, 0); PG8_STAGE(PG8_SA(0, 1), a2 + hstep, voffA);
            PG8_WAIT_L(8); PG8_BAR; PG8_WAIT_L(0); PG8_MMA(0, 0, At, B0); PG8_BAR; PG8_SCHED;
            PG8_LDB(B1, 1, 1); PG8_STAGE(PG8_SB(1, 0), b3, voffB);
            PG8_BAR; PG8_WAIT_L(0); PG8_MMA(0, 1, At, B1); PG8_BAR;
            PG8_LDA(At, 1, 1); PG8_STAGE(PG8_SA(1, 0), a3, voffA);
            PG8_BAR; PG8_WAIT_L(0); PG8_MMA(1, 0, At, B0); PG8_BAR; PG8_SCHED;
            PG8_STAGE(PG8_SB(1, 1), b3 + hstep, voffB);
            PG8_WAIT_V(6); PG8_BAR; PG8_MMA(1, 1, At, B1); PG8_BAR;
        }
        E(acc, cur, wr, wc, fr, fq); S.done(cur);
        if (!has_next) break;
#pragma unroll
        for (int a = 0; a < 2; ++a)
#pragma unroll
            for (int b = 0; b < 2; ++b)
#pragma unroll
                for (int m = 0; m < 4; ++m)
#pragma unroll
                    for (int n = 0; n < 2; ++n) acc[a][b][m][n] = (f32x4){0.f, 0.f, 0.f, 0.f};
        cur = nxt; cA = nA; cB = nB; ++ui;
    }
    PG8_WAIT_V(0);
    if (wr == 0) PG8_BAR;
    PG8_BAR;
#undef PG8_SA
#undef PG8_SB
#undef PG8_STAGE
#undef PG8_LDA
#undef PG8_LDB
#undef PG8_MMA
#undef PG8_WAIT_V
#undef PG8_WAIT_L
#undef PG8_BAR
#undef PG8_SCHED
}
}
struct Args { const float* in[22]; float* out; unsigned char* ws; int ph_lo, ph_hi; };
constexpr int D = 1024, SEQ = 2048, NB = 8, MP = NB * SEQ, DB = 128, DSQ = 8, MS = DB * DSQ, M = MP + MS;
constexpr int NPANEL = 23, NPROJ = NPANEL * 256;
constexpr float NORM_EPS = 1e-6f;
constexpr int GLA_DK = 64, GLA_DV = 128, GDN_DK = 128, GDN_DV = 128, CONV_CH = 1536;

constexpr size_t MiB = 1u << 20;
constexpr size_t SZ_PANEL = (size_t)M * 256 * 2;
constexpr size_t WS_CTL = 0, CTL_ZERO_BYTES = 64 * 1024;
constexpr size_t WS_WIN = 1 * MiB;
constexpr size_t WS_WUA = WS_WIN + (size_t)NPROJ * 1024 * 2;
constexpr size_t WS_WUB = WS_WUA + 1 * MiB;
constexpr size_t WS_WO = WS_WUB + 1 * MiB;
constexpr size_t WS_WG = WS_WO + 2 * MiB;
constexpr size_t WS_WP = WS_WG + 2 * MiB;
constexpr size_t WS_SPEC = WS_WP + MiB / 2;
constexpr size_t WS_RSSP = WS_SPEC + (size_t)M * 32 * 2;
constexpr size_t WS_PB = WS_RSSP + (size_t)M * 16 * 4;
constexpr size_t WS_XN = WS_PB + SZ_PANEL;
constexpr size_t WS_PROJ = WS_XN + (size_t)M * 1024 * 2;
constexpr size_t WS_END = WS_PROJ + 22 * SZ_PANEL;
static_assert(WS_END <= 256 * MiB, "workspace map exceeds 256 MiB");
static_assert(WS_WIN % 256 == 0 && WS_SPEC % 256 == 0 && WS_RSSP % 256 == 0 && WS_PB % 256 == 0 && WS_XN % 256 == 0 && WS_PROJ % 256 == 0, "alignment");
constexpr size_t WS_OA = WS_XN, WS_OB = WS_XN + (size_t)M * 512 * 2;
constexpr size_t WS_MERGED = WS_PROJ + 0 * SZ_PANEL;
constexpr size_t WS_H1B = WS_PROJ + 6 * SZ_PANEL;
constexpr size_t WS_PE = WS_PROJ + 10 * SZ_PANEL;
constexpr int PN_QA = 0, PN_KA = 1, PN_VA = 2, PN_ZA = 4, PN_QB = 6, PN_KB = 8, PN_VB = 10, PN_ZB = 12, PN_GA = 14, PN_GB = 18, PN_SPEC = 22;
constexpr size_t OUT_Y = 0, OUT_GLA_P = (size_t)M * D, OUT_GDN_P = OUT_GLA_P + 8 * 4 * 64 * 128, OUT_CONV_P = OUT_GDN_P + 8 * 4 * 128 * 128,
                 OUT_GLA_S = OUT_CONV_P + 8 * 3 * 1536, OUT_GDN_S = OUT_GLA_S + (size_t)128 * 4 * 64 * 128, OUT_CONV_S = OUT_GDN_S + (size_t)128 * 4 * 128 * 128,
                 OUT_TOTAL = OUT_CONV_S + 128 * 3 * 1536;
constexpr int CW_BAR = 1024;

constexpr int RING_OFF = 0, RING_BYTES = 131072;
constexpr int LDSCTL_OFF = RING_BYTES, MISC_OFF = LDSCTL_OFF + 320;
constexpr int LDS_BYTES = 147456;
constexpr int NWAVES = 8, NTHREADS = 512;

#define GAS __attribute__((address_space(1)))
#define LAS __attribute__((address_space(3)))
typedef unsigned short bf16;
typedef unsigned v4u __attribute__((ext_vector_type(4)));
typedef unsigned v2u __attribute__((ext_vector_type(2)));
typedef float f32x4 __attribute__((ext_vector_type(4)));
typedef GAS unsigned gu32;
#define RLX_AGENT __ATOMIC_RELAXED, __HIP_MEMORY_SCOPE_AGENT
#define LDS_WAIT() asm volatile("s_waitcnt lgkmcnt(0)" ::: "memory")
#define VM_WAIT() asm volatile("s_waitcnt vmcnt(0)" ::: "memory")
__device__ __forceinline__ unsigned f2bf(float f) { unsigned u = __builtin_bit_cast(unsigned, f); return (u + 0x7fffu + ((u >> 16) & 1u)) >> 16; }
__device__ __forceinline__ unsigned pk2(float lo, float hi) { return f2bf(lo) | (f2bf(hi) << 16); }
__device__ __forceinline__ float bf2f(unsigned short b) { return __builtin_bit_cast(float, (unsigned)b << 16); }
__device__ __forceinline__ float bflo(unsigned w) { return __builtin_bit_cast(float, w << 16); }
__device__ __forceinline__ float bfhi(unsigned w) { return __builtin_bit_cast(float, w & 0xffff0000u); }
__device__ __forceinline__ float sigmoidf_(float x) { return 1.f / (1.f + __expf(-x)); }
__device__ __forceinline__ float siluf_(float x) { return x / (1.f + __expf(-x)); }
__device__ __forceinline__ float softplusf_(float x) { return fmaxf(x, 0.f) + log1pf(__expf(-fabsf(x))); }
__device__ __forceinline__ float wave_sum(float v) {
#pragma unroll
    for (int o = 1; o < 64; o <<= 1) v += __shfl_xor(v, o);
    return v;
}

#define XB_TMO      128
#define XB_XCNT(j)  (256  + 64 * (j))
#define XB_XSUB(j)  (1280 + 64 * (j))
#define XB_XGEN(j)  (2304 + 64 * (j))
#define XB_TOP      3328
#define XB_TOPGEN   3392
#define XCD_BAR_WORDS 3456
#define XB_SPIN_CAP (1u << 18)
__device__ __forceinline__ unsigned xb_ld(unsigned* p)              { return __hip_atomic_load(p, __ATOMIC_RELAXED, __HIP_MEMORY_SCOPE_AGENT); }
__device__ __forceinline__ unsigned xb_add(unsigned* p, unsigned v) { return __hip_atomic_fetch_add(p, v, __ATOMIC_RELAXED, __HIP_MEMORY_SCOPE_AGENT); }
__device__ __forceinline__ unsigned xb_xcc_id() { return (unsigned)__builtin_amdgcn_s_getreg((3 << 11) | 20) & 0xFu; }
#define XB_SPIN(cond, bar) do { unsigned _sp = 0; while (cond) { __builtin_amdgcn_s_sleep(1); \
    if ((++_sp & 255u) == 0u) { if (xb_ld(&(bar)[XB_TMO])) break; if (_sp > XB_SPIN_CAP) { atomicAdd(&(bar)[XB_TMO], 1u); break; } } } } while (0)
struct XcdBarrier { unsigned* bar; unsigned x; volatile LAS unsigned* st; };
__device__ __forceinline__ XcdBarrier xcd_barrier_post(unsigned* bar, volatile LAS unsigned* st) {
    XcdBarrier b; b.bar = bar; b.x = xb_xcc_id(); b.st = st;
    if (threadIdx.x == 0) (void)xb_add(&bar[XB_XCNT(b.x)], 1u);
    return b;
}
__device__ __forceinline__ void xcd_barrier_complete(unsigned* bar, unsigned x, unsigned& nloc, unsigned& nx) {
    const unsigned G = gridDim.x * gridDim.y * gridDim.z;
    unsigned sum, cnt, mine, sp = 0u;
    for (;;) {
        sum = 0u; cnt = 0u; mine = 0u;
#pragma unroll
        for (unsigned j = 0; j < 16; ++j) { const unsigned c = xb_ld(&bar[XB_XCNT(j)]); sum += c; cnt += (c > 0u) ? 1u : 0u; mine = (j == x) ? c : mine; }
        if (sum == G) break;
        __builtin_amdgcn_s_sleep(1);
        if ((++sp & 255u) == 0u) { if (xb_ld(&bar[XB_TMO])) break; if (sp > XB_SPIN_CAP) { atomicAdd(&bar[XB_TMO], 1u); break; } }
    }
    nloc = mine > 0u ? mine : 1u; nx = cnt > 0u ? cnt : 1u;
}
__device__ __forceinline__ void xcd_barrier(const XcdBarrier& b) {
    asm volatile("s_waitcnt vmcnt(0)" ::: "memory");
    __syncthreads();
    if (threadIdx.x == 0) {
        unsigned* bar = b.bar;
        __builtin_amdgcn_s_waitcnt(0);
        unsigned nloc = b.st[0], nx = b.st[1];
        if (nloc == 0u) { xcd_barrier_complete(bar, b.x, nloc, nx); b.st[0] = nloc; b.st[1] = nx; }
        const unsigned old = xb_add(&bar[XB_XSUB(b.x)], 1u);
        const unsigned gen = old / nloc;
        if (old + 1u == (gen + 1u) * nloc) {
            __builtin_amdgcn_fence(__ATOMIC_RELEASE, "agent");
            asm volatile("s_waitcnt vmcnt(0)" ::: "memory");
            const unsigned og = xb_add(&bar[XB_TOP], 1u);
            const unsigned tg = og / nx;
            if (og + 1u == (tg + 1u) * nx) xb_add(&bar[XB_TOPGEN], 1u);
            else XB_SPIN(xb_ld(&bar[XB_TOPGEN]) == tg, bar);
            __builtin_amdgcn_fence(__ATOMIC_ACQUIRE, "agent");
            xb_add(&bar[XB_XGEN(b.x)], 1u);
            asm volatile("s_waitcnt vmcnt(0)" ::: "memory");
        } else {
            XB_SPIN(xb_ld(&bar[XB_XGEN(b.x)]) == gen, bar);
            __builtin_amdgcn_fence(__ATOMIC_ACQUIRE, "agent");
            asm volatile("s_waitcnt vmcnt(0)" ::: "memory");
        }
    }
    __syncthreads();
}

struct Frame {
    LAS unsigned char* lds;
    volatile LAS unsigned* MISC;
    int tid, lane, wave, G, vcu;
    const float* in[22];
    float* out;
    unsigned char* ws;
};
__device__ __forceinline__ int win_src_col(int n) {
    if (n < 1024) return n;
    if (n < 3072) return n + 16;
    if (n < 5632) return n + 24;
    if (n < 5648) return 1024 + (n - 5632);
    if (n < 5656) return 3088 + (n - 5648);
    return -1;
}
template <bool MAPCOL>
__device__ __forceinline__ void p0_transpose_item(const float* W, int K, int Nsrc, int Ndst, bf16* WT, LAS float* scr, int item, int lane) {
    const int nblk = Ndst / 32, kb = item / nblk, nb = item % nblk, k0 = 64 * kb, n0 = 32 * nb;
    int sc = n0 + (lane & 31); if (MAPCOL) sc = win_src_col(sc);
#pragma unroll 8
    for (int i = 0; i < 32; ++i) { const int kk = 2 * i + (lane >> 5); scr[kk * 33 + (lane & 31)] = (sc >= 0) ? W[(size_t)(k0 + kk) * Nsrc + sc] : 0.f; }
    LDS_WAIT(); asm volatile("" ::: "memory");
    const int c = lane & 7;
#pragma unroll
    for (int j = 0; j < 4; ++j) { const int n = (lane >> 3) + 8 * j; const LAS float* s = scr + (8 * c) * 33 + n;
        v4u o; o.x = pk2(s[0 * 33], s[1 * 33]); o.y = pk2(s[2 * 33], s[3 * 33]); o.z = pk2(s[4 * 33], s[5 * 33]); o.w = pk2(s[6 * 33], s[7 * 33]);
        *(GAS v4u*)(WT + (size_t)(n0 + n) * K + k0 + 8 * c) = o; }
    LDS_WAIT(); asm volatile("" ::: "memory");
}
__device__ __forceinline__ void rms_row_to_bf16(const float* xrow, const float* w, bf16* orow, int lane) {
    const GAS f32x4* xr = (const GAS f32x4*)xrow + lane;
    const GAS f32x4* wr = (const GAS f32x4*)w + lane;
    f32x4 v[4]; float s = 0.f;
#pragma unroll
    for (int j = 0; j < 4; ++j) { v[j] = xr[64 * j]; s += (v[j].x * v[j].x + v[j].y * v[j].y) + (v[j].z * v[j].z + v[j].w * v[j].w); }
    const float r = 1.f / sqrtf(wave_sum(s) * (1.f / D) + NORM_EPS);
    GAS unsigned long long* o8 = (GAS unsigned long long*)orow + lane;
#pragma unroll
    for (int j = 0; j < 4; ++j) { const f32x4 ww = wr[64 * j];
        o8[64 * j] = (unsigned long long)pk2(v[j].x * r * ww.x, v[j].y * r * ww.y) | ((unsigned long long)pk2(v[j].z * r * ww.z, v[j].w * r * ww.w) << 32); }
}
__device__ __forceinline__ void p0_prologue(const Args& A, LAS unsigned char* lds, int vcu, int G, int wave, int lane) {
    LAS float* scr = (LAS float*)(lds + RING_OFF + wave * 16384);
    const int gw = vcu * NWAVES + wave, NGW = G * NWAVES;
    unsigned char* ws = A.ws;
    constexpr int I_IN = (1024 / 64) * (NPROJ / 32), I_UP = (512 / 64) * (1024 / 32), I_SQ = (1024 / 64) * (1024 / 32), I_PL = (256 / 64) * (1024 / 32);
    constexpr int NITEMS = I_IN + 2 * I_UP + 2 * I_SQ + I_PL;
    for (int it = gw; it < NITEMS; it += NGW) {
        int r = it;
        if (r < I_IN) { p0_transpose_item<true>(A.in[8], 1024, 5656, NPROJ, (bf16*)(ws + WS_WIN), scr, r, lane); continue; } r -= I_IN;
        if (r < I_UP) { p0_transpose_item<false>(A.in[16], 512, 1024, 1024, (bf16*)(ws + WS_WUA), scr, r, lane); continue; } r -= I_UP;
        if (r < I_UP) { p0_transpose_item<false>(A.in[17], 512, 1024, 1024, (bf16*)(ws + WS_WUB), scr, r, lane); continue; } r -= I_UP;
        if (r < I_SQ) { p0_transpose_item<false>(A.in[18], 1024, 1024, 1024, (bf16*)(ws + WS_WO), scr, r, lane); continue; } r -= I_SQ;
        if (r < I_SQ) { p0_transpose_item<false>(A.in[19], 1024, 1024, 1024, (bf16*)(ws + WS_WG), scr, r, lane); continue; } r -= I_SQ;
        p0_transpose_item<false>(A.in[20], 256, 1024, 1024, (bf16*)(ws + WS_WP), scr, r, lane);
    }
    bf16* XN = (bf16*)(ws + WS_XN);
    for (int m = gw; m < M; m += NGW) {
        const float* xrow = (m < MP) ? A.in[0] + (size_t)m * D : A.in[1] + (size_t)(m - MP) * D;
        rms_row_to_bf16(xrow, A.in[7], XN + (size_t)m * D, lane);
    }
    bf16* PB = (bf16*)(ws + WS_PB);
    const int gt = gw * 64 + lane, NGT = NGW * 64;
    for (int i = gt; i < M * 256 / 8; i += NGT) {
        const size_t e = (size_t)i * 8; const int m = (int)(e >> 8), c = (int)(e & 255);
        const float* src = (m < MP) ? A.in[5] + (size_t)m * 256 + c : A.in[6] + (size_t)(m - MP) * 256 + c;
        const f32x4 a = *(const GAS f32x4*)src, b = *(const GAS f32x4*)(src + 4);
        v4u o; o.x = pk2(a.x, a.y); o.y = pk2(a.z, a.w); o.z = pk2(b.x, b.y); o.w = pk2(b.z, b.w);
        *(GAS v4u*)(PB + e) = o;
    }
}
__device__ __forceinline__ const bf16* panel(const unsigned char* ws, int pn) { return (const bf16*)(ws + WS_PROJ + (size_t)pn * SZ_PANEL); }

__device__ __forceinline__ void gla_item(const Args& A, LAS unsigned char* lds, int b, int h, int T, int m0, const float* S0, float* Sout) {
    constexpr int TB = 32;
    const int tid = threadIdx.x, lane = tid & 63, wave = tid >> 6;
    const unsigned char* ws = A.ws;
    LAS float* sq = (LAS float*)lds;
    LAS float* sk = sq + TB * 64;
    LAS float* sd = sk + TB * 64;
    LAS float* sv = sd + TB * 64;
    LAS float* part = sv + TB * 128;
    LAS float* oraw = part + 2 * 4 * 128;
    const int dv = tid & 127, g = tid >> 7;
    float S[16];
#pragma unroll
    for (int i = 0; i < 16; ++i) S[i] = S0 ? S0[(size_t)(g * 16 + i) * 128 + dv] : 0.f;
    const int gdk = tid & 63;
    float wg[16];
#pragma unroll
    for (int r = 0; r < 16; ++r) wg[r] = A.in[9][r * 256 + h * 64 + gdk];
    const float bgv = A.in[10][h * 64 + gdk];
    const bf16* PQ = panel(ws, PN_QA); const bf16* PK = panel(ws, PN_KA);
    const bf16* PV = panel(ws, PN_VA + (h >> 1)); const bf16* PZ = panel(ws, PN_ZA + (h >> 1));
    const bf16* SPEC = (const bf16*)(ws + WS_SPEC);
    bf16* OA = (bf16*)(A.ws + WS_OA);
    const float nw0 = A.in[11][lane], nw1 = A.in[11][lane + 64];
    for (int t0 = 0; t0 < T; t0 += TB) {
        const int nb = (T - t0) < TB ? (T - t0) : TB;
        __syncthreads();
        for (int idx = tid; idx < nb * 64; idx += NTHREADS) { const int tk = idx >> 6, dk = idx & 63; const size_t m = (size_t)(m0 + t0 + tk);
            sq[idx] = bf2f(PQ[m * 256 + h * 64 + dk]) * 0.125f; sk[idx] = bf2f(PK[m * 256 + h * 64 + dk]); }
        for (int idx = tid; idx < nb * 128; idx += NTHREADS) { const int tk = idx >> 7, c = idx & 127; const size_t m = (size_t)(m0 + t0 + tk);
            sv[idx] = bf2f(PV[m * 256 + (h & 1) * 128 + c]); }
        for (int tk = wave; tk < nb; tk += 8) { const size_t m = (size_t)(m0 + t0 + tk);
            float x = bgv;
#pragma unroll
            for (int r = 0; r < 16; ++r) x += bf2f(SPEC[m * 32 + r]) * wg[r];
            const float ls = fminf(x, 0.f) - log1pf(__expf(-fabsf(x)));
            sd[tk * 64 + gdk] = __expf(ls * (1.f / 16.f)); }
        __syncthreads();
        for (int tk = 0; tk < nb; ++tk) {
            const float vv = sv[tk * 128 + dv];
            float po = 0.f;
#pragma unroll
            for (int i = 0; i < 16; ++i) { const int dk = g * 16 + i;
                S[i] = sd[tk * 64 + dk] * S[i] + sk[tk * 64 + dk] * vv; po += sq[tk * 64 + dk] * S[i]; }
            part[((tk & 1) * 4 + g) * 128 + dv] = po;
            __syncthreads();
            if (g == 0) { const LAS float* pp = part + (tk & 1) * 512 + dv; oraw[tk * 128 + dv] = (pp[0] + pp[128]) + (pp[256] + pp[384]); }
        }
        __syncthreads();
        for (int tk = wave; tk < nb; tk += 8) { const size_t m = (size_t)(m0 + t0 + tk);
            const float o0 = oraw[tk * 128 + lane], o1 = oraw[tk * 128 + lane + 64];
            const float r = 1.f / sqrtf(wave_sum(o0 * o0 + o1 * o1) * (1.f / 128.f) + NORM_EPS);
            const float z0 = bf2f(PZ[m * 256 + (h & 1) * 128 + lane]), z1 = bf2f(PZ[m * 256 + (h & 1) * 128 + lane + 64]);
            OA[m * 512 + h * 128 + lane] = (bf16)f2bf(o0 * r * nw0 * siluf_(z0));
            OA[m * 512 + h * 128 + lane + 64] = (bf16)f2bf(o1 * r * nw1 * siluf_(z1)); }
    }
#pragma unroll
    for (int i = 0; i < 16; ++i) Sout[(size_t)(g * 16 + i) * 128 + dv] = S[i];
    __syncthreads();
}

__device__ __forceinline__ void gdn_item(const Args& A, LAS unsigned char* lds, int b, int h, int T, int m0, const float* S0, float* Sout, const float* convbuf) {
    constexpr int TB = 16;
    const int tid = threadIdx.x, lane = tid & 63, wave = tid >> 6;
    const unsigned char* ws = A.ws;
    LAS float* raw = (LAS float*)lds;
    LAS float* sq = raw + (TB + 3) * 384;
    LAS float* sk = sq + TB * 128;
    LAS float* sv = sk + TB * 128;
    LAS float* sbeta = sv + TB * 128;
    LAS float* sgd = sbeta + TB;
    LAS float* sqk = sgd + TB;
    LAS float* part = sqk + TB;
    LAS float* oraw = part + 2 * 2 * 4 * 128;
    const int dv = tid & 127, g = tid >> 7;
    float S[32];
#pragma unroll
    for (int i = 0; i < 32; ++i) S[i] = S0 ? S0[(size_t)(g * 32 + i) * 128 + dv] : 0.f;
    const bf16* PQ = panel(ws, PN_QB + (h >> 1)); const bf16* PK = panel(ws, PN_KB + (h >> 1)); const bf16* PV = panel(ws, PN_VB + (h >> 1));
    const bf16* PZ = panel(ws, PN_ZB + (h >> 1));
    const bf16* SPEC = (const bf16*)(ws + WS_SPEC);
    bf16* OB = (bf16*)(A.ws + WS_OB);
    const float nw0 = A.in[15][lane], nw1 = A.in[15][lane + 64];
    const float negA = -__expf(A.in[13][h]), dtb = A.in[14][h];
    const float* cw = A.in[12];
    for (int t0 = 0; t0 < T; t0 += TB) {
        const int nb = (T - t0) < TB ? (T - t0) : TB;
        __syncthreads();
        for (int idx = tid; idx < (nb + 3) * 384; idx += NTHREADS) { const int r = idx / 384, c = idx - r * 384, seg = c >> 7, cc = c & 127; const int t = t0 - 3 + r;
            float x;
            if (t >= 0) { const bf16* P = seg == 0 ? PQ : (seg == 1 ? PK : PV); x = bf2f(P[(size_t)(m0 + t) * 256 + (h & 1) * 128 + cc]); }
            else x = convbuf ? convbuf[(3 + t) * 1536 + seg * 512 + h * 128 + cc] : 0.f;
            raw[idx] = x; }
        if (tid < nb) { const size_t m = (size_t)(m0 + t0 + tid);
            sbeta[tid] = sigmoidf_(bf2f(SPEC[m * 32 + 20 + h]));
            sgd[tid] = __expf(negA * softplusf_(bf2f(SPEC[m * 32 + 16 + h]) + dtb)); }
        __syncthreads();
        for (int idx = tid; idx < nb * 384; idx += NTHREADS) { const int tk = idx / 384, c = idx - tk * 384, seg = c >> 7, cc = c & 127; const int ch = seg * 512 + h * 128 + cc;
            const float x = cw[ch] * raw[tk * 384 + c] + cw[1536 + ch] * raw[(tk + 1) * 384 + c] + cw[3072 + ch] * raw[(tk + 2) * 384 + c] + cw[4608 + ch] * raw[(tk + 3) * 384 + c];
            const float y = siluf_(x);
            LAS float* dst = seg == 0 ? sq : (seg == 1 ? sk : sv); dst[tk * 128 + cc] = y; }
        __syncthreads();
        for (int tk = wave; tk < nb; tk += 8) {
            float q0 = sq[tk * 128 + lane], q1 = sq[tk * 128 + lane + 64], k0 = sk[tk * 128 + lane], k1 = sk[tk * 128 + lane + 64];
            const float rq = 1.f / sqrtf(wave_sum(q0 * q0 + q1 * q1) + NORM_EPS) * 0.08838834764831845f;
            const float rk = 1.f / sqrtf(wave_sum(k0 * k0 + k1 * k1) + NORM_EPS);
            q0 *= rq; q1 *= rq; k0 *= rk; k1 *= rk;
            sq[tk * 128 + lane] = q0; sq[tk * 128 + lane + 64] = q1; sk[tk * 128 + lane] = k0; sk[tk * 128 + lane + 64] = k1;
            const float qk = wave_sum(q0 * k0 + q1 * k1);
            if (lane == 0) sqk[tk] = qk; }
        __syncthreads();
        for (int tk = 0; tk < nb; ++tk) {
            float pk = 0.f, pq = 0.f;
#pragma unroll
            for (int i = 0; i < 32; ++i) { const int dk = g * 32 + i; pk += sk[tk * 128 + dk] * S[i]; pq += sq[tk * 128 + dk] * S[i]; }
            LAS float* pp = part + (tk & 1) * 1024;
            pp[g * 128 + dv] = pk; pp[512 + g * 128 + dv] = pq;
            __syncthreads();
            const float gd = sgd[tk];
            const float kS = gd * ((pp[dv] + pp[128 + dv]) + (pp[256 + dv] + pp[384 + dv]));
            const float vnew = sbeta[tk] * (sv[tk * 128 + dv] - kS);
#pragma unroll
            for (int i = 0; i < 32; ++i) { const int dk = g * 32 + i; S[i] = gd * S[i] + sk[tk * 128 + dk] * vnew; }
            if (g == 0) { const float qS = gd * ((pp[512 + dv] + pp[640 + dv]) + (pp[768 + dv] + pp[896 + dv])); oraw[tk * 128 + dv] = qS + sqk[tk] * vnew; }
        }
        __syncthreads();
        for (int tk = wave; tk < nb; tk += 8) { const size_t m = (size_t)(m0 + t0 + tk);
            const float o0 = oraw[tk * 128 + lane], o1 = oraw[tk * 128 + lane + 64];
            const float r = 1.f / sqrtf(wave_sum(o0 * o0 + o1 * o1) * (1.f / 128.f) + NORM_EPS);
            const float z0 = bf2f(PZ[m * 256 + (h & 1) * 128 + lane]), z1 = bf2f(PZ[m * 256 + (h & 1) * 128 + lane + 64]);
            OB[m * 512 + h * 128 + lane] = (bf16)f2bf(o0 * r * nw0 * siluf_(z0));
            OB[m * 512 + h * 128 + lane + 64] = (bf16)f2bf(o1 * r * nw1 * siluf_(z1)); }
    }
#pragma unroll
    for (int i = 0; i < 32; ++i) Sout[(size_t)(g * 32 + i) * 128 + dv] = S[i];
    __syncthreads();
}

__device__ __forceinline__ void p2_recurrences(const Args& A, LAS unsigned char* lds, int c, int G) {
    float* out = A.out;
    if (c < 32) { const int b = c >> 2, h = c & 3; gla_item(A, lds, b, h, SEQ, b * SEQ, nullptr, out + OUT_GLA_P + (size_t)c * 64 * 128); }
    else if (c < 64) { const int i = c - 32, b = i >> 2, h = i & 3; gdn_item(A, lds, b, h, SEQ, b * SEQ, nullptr, out + OUT_GDN_P + (size_t)i * 128 * 128, nullptr); }
    else {
        const int nw = G - 64;
        for (int it = c - 64; it < 1024; it += nw) {
            if (it < 512) { const int b = it >> 2, h = it & 3; gla_item(A, lds, b, h, DSQ, MP + b * DSQ, A.in[2] + (size_t)it * 64 * 128, out + OUT_GLA_S + (size_t)it * 64 * 128); }
            else { const int i = it - 512, b = i >> 2, h = i & 3; gdn_item(A, lds, b, h, DSQ, MP + b * DSQ, A.in[3] + (size_t)i * 128 * 128, out + OUT_GDN_S + (size_t)i * 128 * 128, A.in[4] + (size_t)b * 3 * 1536); }
        }
    }
    const int gt = c * NTHREADS + threadIdx.x, NGT = G * NTHREADS;
    for (int i = gt; i < 8 * 3 * 1536; i += NGT) { const int ch = i % 1536, j = (i / 1536) % 3, b = i / (3 * 1536); const size_t m = (size_t)b * SEQ + SEQ - 3 + j;
        out[OUT_CONV_P + i] = bf2f(panel(A.ws, PN_QB + (ch >> 8))[m * 256 + (ch & 255)]); }
    for (int i = gt; i < 128 * 3 * 1536; i += NGT) { const int ch = i % 1536, j = (i / 1536) % 3, b = i / (3 * 1536); const size_t m = (size_t)MP + b * DSQ + DSQ - 3 + j;
        out[OUT_CONV_S + i] = bf2f(panel(A.ws, PN_QB + (ch >> 8))[m * 256 + (ch & 255)]); }
}
typedef pg8::f32x4 (&AccRef)[2][2][4][2];
typedef const pg8::f32x4 (&CAccRef)[2][2][4][2];
__device__ __forceinline__ v4u pack8(const f32x4 a, const f32x4 b) { v4u w; w.x = pg8::cvt_pk_bf16(a.x, a.y); w.y = pg8::cvt_pk_bf16(a.z, a.w); w.z = pg8::cvt_pk_bf16(b.x, b.y); w.w = pg8::cvt_pk_bf16(b.z, b.w); return w; }
__device__ __forceinline__ void unpack8(const v4u w, f32x4& a, f32x4& b) { a = (f32x4){bflo(w.x), bfhi(w.x), bflo(w.y), bfhi(w.y)}; b = (f32x4){bflo(w.z), bfhi(w.z), bflo(w.w), bfhi(w.w)}; }
__device__ __forceinline__ f32x4 sig4(const f32x4 x) { return (f32x4){sigmoidf_(x.x), sigmoidf_(x.y), sigmoidf_(x.z), sigmoidf_(x.w)}; }

#define EPI_LOOP_BEGIN  const int row0 = u.pm * 256 + wr * 64 + fr, cin = wc * 32 + 8 * fq; \
    _Pragma("unroll") for (int ai = 0; ai < 2; ++ai) _Pragma("unroll") for (int m = 0; m < 4; ++m) { const size_t row = (size_t)(row0 + ai * 128 + m * 16); \
    _Pragma("unroll") for (int bj = 0; bj < 2; ++bj) { const int cp = bj * 128 + cin;   const f32x4 a0 = acc[ai][bj][m][0], a1 = acc[ai][bj][m][1];
#define EPI_LOOP_END } }

struct EpiProj { static constexpr bool PERM = true; unsigned char* ws;
    __device__ __forceinline__ void operator()(CAccRef acc, const pg8::Unit& u, int wr, int wc, int fr, int fq) const {
        if (u.pn < PN_SPEC) { bf16* P = (bf16*)(ws + WS_PROJ + (size_t)u.pn * SZ_PANEL);
            EPI_LOOP_BEGIN *(GAS v4u*)(P + row * 256 + cp) = pack8(a0, a1); EPI_LOOP_END }
        else { bf16* P = (bf16*)(ws + WS_SPEC);
            EPI_LOOP_BEGIN if (cp < 32) *(GAS v4u*)(P + row * 32 + cp) = pack8(a0, a1); EPI_LOOP_END }
    } };
struct EpiUpA { static constexpr bool PERM = true; unsigned char* ws;
    __device__ __forceinline__ void operator()(CAccRef acc, const pg8::Unit& u, int wr, int wc, int fr, int fq) const {
        const bf16* Gp = (const bf16*)(ws + WS_PROJ + (size_t)(PN_GA + u.pn) * SZ_PANEL); bf16* O = (bf16*)(ws + WS_MERGED);
        EPI_LOOP_BEGIN f32x4 g0, g1; unpack8(*(const GAS v4u*)(Gp + row * 256 + cp), g0, g1);
            *(GAS v4u*)(O + row * 1024 + u.pn * 256 + cp) = pack8(sig4(g0) * a0, sig4(g1) * a1); EPI_LOOP_END
    } };
struct EpiUpB { static constexpr bool PERM = true; unsigned char* ws;
    __device__ __forceinline__ void operator()(CAccRef acc, const pg8::Unit& u, int wr, int wc, int fr, int fq) const {
        const bf16* Gp = (const bf16*)(ws + WS_PROJ + (size_t)(PN_GB + u.pn) * SZ_PANEL); bf16* O = (bf16*)(ws + WS_MERGED);
        EPI_LOOP_BEGIN f32x4 g0, g1, y0, y1; unpack8(*(const GAS v4u*)(Gp + row * 256 + cp), g0, g1);
            GAS v4u* op = (GAS v4u*)(O + row * 1024 + u.pn * 256 + cp); unpack8(*op, y0, y1);
            *op = pack8(y0 + sig4(g0) * a0, y1 + sig4(g1) * a1); EPI_LOOP_END
    } };
struct EpiOut { static constexpr bool PERM = true; unsigned char* ws; const float* xp; const float* xs; float* out;
    __device__ __forceinline__ void operator()(CAccRef acc, const pg8::Unit& u, int wr, int wc, int fr, int fq) const {
        bf16* HB = (bf16*)(ws + WS_H1B);
        EPI_LOOP_BEGIN const size_t col = (size_t)u.pn * 256 + cp;
            const float* xr = (row < (size_t)MP) ? xp + row * 1024 + col : xs + (row - MP) * 1024 + col;
            const f32x4 h0 = *(const GAS f32x4*)xr + a0, h1 = *(const GAS f32x4*)(xr + 4) + a1;
            float* o = out + row * 1024 + col; *(GAS f32x4*)o = h0; *(GAS f32x4*)(o + 4) = h1;
            *(GAS v4u*)(HB + row * 1024 + col) = pack8(h0, h1); EPI_LOOP_END
    } };
struct EpiPe { static constexpr bool PERM = true; unsigned char* ws;
    __device__ __forceinline__ void operator()(CAccRef acc, const pg8::Unit& u, int wr, int wc, int fr, int fq) const {
        bf16* O = (bf16*)(ws + WS_PE);
        EPI_LOOP_BEGIN *(GAS v4u*)(O + row * 1024 + u.pn * 256 + cp) = pack8(a0, a1); EPI_LOOP_END
    } };
struct EpiGate { static constexpr bool PERM = true; unsigned char* ws; float* out;
    __device__ __forceinline__ void operator()(CAccRef acc, const pg8::Unit& u, int wr, int wc, int fr, int fq) const {
        const bf16* PEp = (const bf16*)(ws + WS_PE); float* RS = (float*)(ws + WS_RSSP);
        const int row0 = u.pm * 256 + wr * 64 + fr, cin = wc * 32 + 8 * fq;
#pragma unroll
        for (int ai = 0; ai < 2; ++ai)
#pragma unroll
            for (int m = 0; m < 4; ++m) { const size_t row = (size_t)(row0 + ai * 128 + m * 16); float ss = 0.f;
#pragma unroll
                for (int bj = 0; bj < 2; ++bj) { const size_t col = (size_t)u.pn * 256 + bj * 128 + cin; const f32x4 a0 = acc[ai][bj][m][0], a1 = acc[ai][bj][m][1];
                    f32x4 p0, p1; unpack8(*(const GAS v4u*)(PEp + row * 1024 + col), p0, p1);
                    float* o = out + row * 1024 + col;
                    const f32x4 h0 = *(const GAS f32x4*)o + sig4(a0) * p0, h1 = *(const GAS f32x4*)(o + 4) + sig4(a1) * p1;
                    *(GAS f32x4*)o = h0; *(GAS f32x4*)(o + 4) = h1;
                    ss += (h0.x * h0.x + h0.y * h0.y) + (h0.z * h0.z + h0.w * h0.w) + (h1.x * h1.x + h1.y * h1.y) + (h1.z * h1.z + h1.w * h1.w); }
                ss += __shfl_xor(ss, 16); ss += __shfl_xor(ss, 32);
                if (fq == 0) RS[row * 16 + u.pn * 4 + wc] = ss; }
    } };

__device__ __forceinline__ void p6_final_norm(const Args& A, int vcu, int G, int wave, int lane) {
    const int gw = vcu * NWAVES + wave, NGW = G * NWAVES;
    const float* RS = (const float*)(A.ws + WS_RSSP);
    const GAS f32x4* fw = (const GAS f32x4*)A.in[21] + lane;
    for (int m = gw; m < M; m += NGW) {
        float ss = 0.f;
#pragma unroll
        for (int i = 0; i < 16; ++i) ss += RS[(size_t)m * 16 + i];
        const float r = 1.f / sqrtf(ss * (1.f / D) + NORM_EPS);
        GAS f32x4* o = (GAS f32x4*)(A.out + (size_t)m * D) + lane;
#pragma unroll
        for (int j = 0; j < 4; ++j) { const f32x4 v = o[64 * j], w = fw[64 * j]; o[64 * j] = v * r * w; }
    }
}
#ifndef MK_N_LAUNCHES
#define MK_N_LAUNCHES 1
#endif
constexpr int N_PHASES = 7;
__global__ void __launch_bounds__(NTHREADS, 2) mk_fwd(Args args) {
    extern __shared__ __attribute__((aligned(16))) unsigned char lds_raw[];
    LAS unsigned char* lds = (LAS unsigned char*)lds_raw;
    volatile LAS unsigned* MISC = (volatile LAS unsigned*)(lds + MISC_OFF);
    const int tid = threadIdx.x, lane = tid & 63, wave = __builtin_amdgcn_readfirstlane(tid >> 6);
    const int G = gridDim.x, bx = blockIdx.x;
    const int vcu = (G % 8 == 0) ? (bx % 8) * (G / 8) + bx / 8 : bx;
    for (int u = tid; u < (LDS_BYTES - LDSCTL_OFF) / 4; u += NTHREADS) ((LAS unsigned*)(lds + LDSCTL_OFF))[u] = 0u;
    __syncthreads();
    unsigned char* ws = args.ws;
    XcdBarrier bar; bar.bar = (unsigned*)(ws + WS_CTL) + CW_BAR; bar.x = 0; bar.st = nullptr;
    if (MK_N_LAUNCHES == 1) bar = xcd_barrier_post((unsigned*)(ws + WS_CTL) + CW_BAR, MISC + 8);
    const int lo = args.ph_lo, hi = args.ph_hi;
#define IN(k) (lo <= (k) && (k) < hi)
#define SEAM(k) do { if (IN(k) && IN((k) + 1)) xcd_barrier(bar); } while (0)

    if (IN(0)) { p0_prologue(args, lds, vcu, G, wave, lane); }
    SEAM(0);
    if (IN(1)) {
        pg8::Gemm g{(const bf16*)(ws + WS_XN), (const bf16*)(ws + WS_WIN), M, NPROJ, 1024}; pg8::StaticOrder S; S.init(M, NPROJ, G, bx);
        EpiProj E{ws};
        pg8::gemm_phase<EpiProj, pg8::StaticOrder>(lds + RING_OFF, g, S, E);
    }
    SEAM(1);
    if (IN(2)) { p2_recurrences(args, lds, vcu, G); }
    SEAM(2);
    if (IN(3)) {
        pg8::StaticOrder S; S.init(M, 1024, G, bx);
        { pg8::Gemm g{(const bf16*)(ws + WS_OA), (const bf16*)(ws + WS_WUA), M, 1024, 512}; EpiUpA E{ws}; pg8::gemm_phase<EpiUpA, pg8::StaticOrder>(lds + RING_OFF, g, S, E); }
        { pg8::Gemm g{(const bf16*)(ws + WS_OB), (const bf16*)(ws + WS_WUB), M, 1024, 512}; EpiUpB E{ws}; pg8::gemm_phase<EpiUpB, pg8::StaticOrder>(lds + RING_OFF, g, S, E); }
    }
    SEAM(3);
    if (IN(4)) {
        pg8::StaticOrder S; S.init(M, 1024, G, bx);
        pg8::Gemm g{(const bf16*)(ws + WS_MERGED), (const bf16*)(ws + WS_WO), M, 1024, 1024}; EpiOut E{ws, args.in[0], args.in[1], args.out};
        pg8::gemm_phase<EpiOut, pg8::StaticOrder>(lds + RING_OFF, g, S, E);
    }
    SEAM(4);
    if (IN(5)) {
        pg8::StaticOrder S; S.init(M, 1024, G, bx);
        { pg8::Gemm g{(const bf16*)(ws + WS_PB), (const bf16*)(ws + WS_WP), M, 1024, 256}; EpiPe E{ws}; pg8::gemm_phase<EpiPe, pg8::StaticOrder>(lds + RING_OFF, g, S, E); }
        { pg8::Gemm g{(const bf16*)(ws + WS_H1B), (const bf16*)(ws + WS_WG), M, 1024, 1024}; EpiGate E{ws, args.out}; pg8::gemm_phase<EpiGate, pg8::StaticOrder>(lds + RING_OFF, g, S, E); }
    }
    SEAM(5);
    if (IN(6)) { p6_final_norm(args, vcu, G, wave, lane); }
#undef IN
#undef SEAM
}

extern "C" void kernel_launch(void* const* d_in, const int* in_sizes, int n_in, void* d_out, int out_size, void* d_ws, size_t ws_size, hipStream_t stream) {
    static int grid = 0;
    if (grid == 0) {
        if (n_in != 22 || in_sizes[0] != MP * D || (size_t)out_size != OUT_TOTAL || ws_size < WS_END) {
            fprintf(stderr, "kernel_launch: unexpected shapes: n_in %d in0 %d out %d ws %zu (need %zu)\n", n_in, n_in > 0 ? in_sizes[0] : -1, out_size, ws_size, (size_t)WS_END); grid = -1; return; }
        int dev = 0, cus = 0, per_cu = 0;
        if (hipGetDevice(&dev) != hipSuccess || hipDeviceGetAttribute(&cus, hipDeviceAttributeMultiprocessorCount, dev) != hipSuccess) { grid = -1; return; }
        if (hipFuncSetAttribute((const void*)mk_fwd, hipFuncAttributeMaxDynamicSharedMemorySize, LDS_BYTES) != hipSuccess) { fprintf(stderr, "kernel_launch: hipFuncSetAttribute failed\n"); grid = -1; return; }
        if (hipOccupancyMaxActiveBlocksPerMultiprocessor(&per_cu, (const void*)mk_fwd, NTHREADS, LDS_BYTES) != hipSuccess || per_cu < 1) {
            fprintf(stderr, "kernel_launch: occupancy query reports %d workgroups per CU\n", per_cu); (void)hipGetLastError(); grid = -1; return; }
        grid = cus;
    }
    if (grid < 0) return;
    (void)hipMemsetAsync((char*)d_ws + WS_CTL, 0, CTL_ZERO_BYTES, stream);
    Args a{};
    for (int i = 0; i < 22; ++i) a.in[i] = (const float*)d_in[i];
    a.out = (float*)d_out; a.ws = (unsigned char*)d_ws;
#if MK_N_LAUNCHES == 1
    a.ph_lo = 0; a.ph_hi = N_PHASES;
    hipLaunchKernelGGL(mk_fwd, dim3(grid), dim3(NTHREADS), LDS_BYTES, stream, a);
#else
    for (int p = 0; p < N_PHASES; ++p) { a.ph_lo = p; a.ph_hi = p + 1; hipLaunchKernelGGL(mk_fwd, dim3(grid), dim3(NTHREADS), LDS_BYTES, stream, a); }
#endif
}
```

```cpp
#include <hip/hip_runtime.h>
#include <cstdio>
#include <cstdint>
#define MK_N_LAUNCHES 1
namespace pg8 {
#define PG8_LAS __attribute__((address_space(3)))
typedef unsigned short bf16_t;
typedef short bf16x8 __attribute__((ext_vector_type(8)));
typedef float f32x4 __attribute__((ext_vector_type(4)));
typedef unsigned u32x4 __attribute__((ext_vector_type(4)));
constexpr int BM = 256, BK = 64, HALF = 128, HTB = HALF * BK * 2  , STAGE_BYTES = 8 * HTB, NXCD = 8, WGM = 8;

__host__ __device__ __forceinline__ int lds_byte(int r, int c) { const int st = (r >> 4) * 2 + (c >> 5), rr = r & 15, cc = c & 31, ob = rr * 64 + cc * 2; return st * 1024 + (ob ^ (((ob >> 9) & 1) << 5)); }
__host__ __device__ __forceinline__ void stage_rc(int b, int& R, int& C) { const int st = b / 1024, sb = b % 1024, swz = sb ^ (((sb >> 9) & 1) << 5); R = (st >> 1) * 16 + swz / 64; C = (st & 1) * 32 + (swz % 64) / 2; }
__host__ __device__ __forceinline__ int perm32(int rho) { const int n = rho >> 4, i = rho & 15; return 8 * (i >> 2) + 4 * n + (i & 3); }

struct Unit { int pm, pn; };
struct Gemm { const bf16_t* A; const bf16_t* Bt; int M, N, K; };

struct StaticOrder {
    int nM, nN, nwg, G, c;
    __host__ __device__ void init(int M, int N, int G_, int c_) { nM = M / BM; nN = N / BM; nwg = nM * nN; G = G_; c = c_; }
    __host__ __device__ bool next(int i, Unit& u) const {
        const long L = (long)i * G + c; if (L >= nwg) return false;
        int wgid = (int)L; { const int q = nwg / NXCD, r = nwg % NXCD, xcd = wgid % NXCD, off = wgid / NXCD; wgid = (xcd < r ? xcd * (q + 1) : r * (q + 1) + (xcd - r) * q) + off; }
        const int nig = WGM * nN, gid = wgid / nig, fm = gid * WGM, gsz = (nM - fm) < WGM ? (nM - fm) : WGM;
        u.pm = fm + ((wgid % nig) % gsz); u.pn = (wgid % nig) / gsz; return true;
    }
    __device__ __forceinline__ void a_ready(const Unit&) const {}
    __device__ __forceinline__ void done(const Unit&) const {}
};

typedef __bf16 bf16x2_t __attribute__((ext_vector_type(2)));
typedef float f32x2_t __attribute__((ext_vector_type(2)));
__device__ __forceinline__ unsigned cvt_pk_bf16(float lo, float hi) { const f32x2_t v = {lo, hi}; return __builtin_bit_cast(unsigned, __builtin_convertvector(v, bf16x2_t)); }

template <class Epi, class Sched>
__device__ __forceinline__ void gemm_phase(PG8_LAS unsigned char* lds, const Gemm g, const Sched& S, const Epi& E) {
    const int tid = threadIdx.x, wid = __builtin_amdgcn_readfirstlane(tid >> 6), lane = tid & 63, wr = wid >> 2, wc = wid & 3, fr = lane & 15, fq = lane >> 4;
    const int K = g.K, nt = K / BK;
    unsigned voffA[2], voffB[2];
#pragma unroll
    for (int i = 0; i < 2; ++i) { int R, C; stage_rc(tid * 16 + i * 8192, R, C); const int Rb = Epi::PERM ? ((R & ~31) + perm32(R & 31)) : R;
        voffA[i] = (unsigned)(R * K + C) * 2u; voffB[i] = (unsigned)(Rb * K + C) * 2u; }
    const size_t kstep = (size_t)(BK * 2);
    const size_t hstep = (size_t)HALF * K * 2;
    const size_t tstep = 2 * hstep;
    const unsigned ldsw = (unsigned)wid * 1024u;
    const int aoff = lds_byte(wr * 64 + fr, fq * 8), boff = lds_byte(wc * 32 + fr, fq * 8);
#define PG8_SA(b, h) (((b) * 2 + (h)) * HTB)
#define PG8_SB(b, h) ((4 + (b) * 2 + (h)) * HTB)
#define PG8_STAGE(bufoff, gbase, voff) do { _Pragma("unroll") for (int _i = 0; _i < 2; ++_i) \
        __builtin_amdgcn_global_load_lds((const unsigned*)((const char*)(gbase) + (voff)[_i]), (PG8_LAS unsigned*)(lds + (bufoff) + ldsw + _i * 8192), 16, 0, 0); } while (0)
#define PG8_LDA(dst, b, h) do { _Pragma("unroll") for (int m = 0; m < 4; ++m) _Pragma("unroll") for (int k = 0; k < 2; ++k) dst[m][k] = *(const PG8_LAS bf16x8*)(lds + PG8_SA(b, h) + aoff + m * 2048 + k * 1024); } while (0)
#define PG8_LDB(dst, b, h) do { _Pragma("unroll") for (int n = 0; n < 2; ++n) _Pragma("unroll") for (int k = 0; k < 2; ++k) dst[n][k] = *(const PG8_LAS bf16x8*)(lds + PG8_SB(b, h) + boff + n * 2048 + k * 1024); } while (0)
#define PG8_MMA(ai, bj, At, Bt) do { __builtin_amdgcn_s_setprio(1); _Pragma("unroll") for (int m = 0; m < 4; ++m) _Pragma("unroll") for (int n = 0; n < 2; ++n) _Pragma("unroll") for (int k = 0; k < 2; ++k) \
        acc[ai][bj][m][n] = __builtin_amdgcn_mfma_f32_16x16x32_bf16(Bt[n][k], At[m][k], acc[ai][bj][m][n], 0, 0, 0); __builtin_amdgcn_s_setprio(0); } while (0)
#define PG8_WAIT_V(n) asm volatile("s_waitcnt vmcnt(" #n ")" ::: "memory")
#define PG8_WAIT_L(n) asm volatile("s_waitcnt lgkmcnt(" #n ")" ::: "memory")
#define PG8_BAR __builtin_amdgcn_s_barrier()
#define PG8_SCHED __builtin_amdgcn_sched_barrier(0)
    Unit cur, nxt; int ui = 0;
    if (!S.next(0, cur)) return;
    f32x4 acc[2][2][4][2];
#pragma unroll
    for (int a = 0; a < 2; ++a)
#pragma unroll
        for (int b = 0; b < 2; ++b)
#pragma unroll
            for (int m = 0; m < 4; ++m)
#pragma unroll
                for (int n = 0; n < 2; ++n) acc[a][b][m][n] = (f32x4){0.f, 0.f, 0.f, 0.f};
    bf16x8 At[4][2], B0[2][2], B1[2][2];
    const char* cA = (const char*)g.A + (size_t)cur.pm * tstep; const char* cB = (const char*)g.Bt + (size_t)cur.pn * tstep;
    S.a_ready(cur);
    PG8_STAGE(PG8_SB(0, 0), cB, voffB); PG8_STAGE(PG8_SA(0, 0), cA, voffA); PG8_STAGE(PG8_SB(0, 1), cB + hstep, voffB); PG8_STAGE(PG8_SA(0, 1), cA + hstep, voffA);
    if (wr == 1) PG8_BAR;
    PG8_WAIT_V(4); PG8_BAR;
    PG8_STAGE(PG8_SB(1, 0), cB + kstep, voffB); PG8_STAGE(PG8_SA(1, 0), cA + kstep, voffA); PG8_STAGE(PG8_SB(1, 1), cB + hstep + kstep, voffB);
    PG8_WAIT_V(6); PG8_BAR;
    for (;;) {
        const bool has_next = S.next(ui + 1, nxt);
        const char* nA = has_next ? (const char*)g.A + (size_t)nxt.pm * tstep : cA; const char* nB = has_next ? (const char*)g.Bt + (size_t)nxt.pn * tstep : cB;
        for (int t = 0; t < nt; t += 2) {
            const bool last = (t == nt - 2);
            const char* a1 = cA + (size_t)(t + 1) * kstep;
            const char* a2 = last ? nA : cA + (size_t)(t + 2) * kstep; const char* b2 = last ? nB : cB + (size_t)(t + 2) * kstep;
            const char* a3 = a2 + kstep; const char* b3 = b2 + kstep;
            if (last && has_next) S.a_ready(nxt);
            PG8_LDB(B0, 0, 0); PG8_SCHED; PG8_LDA(At, 0, 0); PG8_STAGE(PG8_SA(1, 1), a1 + hstep, voffA);
            PG8_WAIT_L(8); PG8_BAR; PG8_WAIT_L(0); PG8_MMA(0, 0, At, B0); PG8_BAR; PG8_SCHED;
            PG8_LDB(B1, 0, 1); PG8_STAGE(PG8_SB(0, 0), b2, voffB);
            PG8_BAR; PG8_WAIT_L(0); PG8_MMA(0, 1, At, B1); PG8_BAR;
            PG8_LDA(At, 0, 1); PG8_STAGE(PG8_SA(0, 0), a2, voffA);
            PG8_BAR; PG8_WAIT_L(0); PG8_MMA(1, 0, At, B0); PG8_BAR; PG8_SCHED;
            PG8_STAGE(PG8_SB(0, 1), b2 + hstep, voffB);
            PG8_WAIT_V(6); PG8_BAR; PG8_MMA(1, 1, At, B1); PG8_BAR;
            PG8_LDB(B0, 1, 0); PG8_SCHED; PG8_LDA(At, 1, 0); PG8_STAGE(PG8_SA(0, 1), a2 + hstep, voffA);
            PG8_WAIT_L(8); PG8_BAR; PG8_WAIT_L(0); PG8_MMA(0, 0, At, B0); PG8_BAR; PG8_SCHED;
            PG8_LDB(B1, 1, 1); PG8_STAGE(PG8_SB(1, 0), b3, voffB);
            PG8_BAR; PG8_WAIT_L(0); PG8_MMA(0, 1, At, B1); PG8_BAR;
            PG8_LDA(At, 1, 1); PG8_STAGE(PG8_SA(1, 0), a3, voffA);
            PG8_BAR; PG8_WAIT_L(0); PG8_MMA(1, 0, At, B0); PG8_BAR; PG8_SCHED;
            PG8_STAGE(PG8_SB(1, 1), b3 + hstep, voffB);
            PG8_WAIT_V(6); PG8_BAR; PG8_MMA(1, 1, At, B1); PG8_BAR;
        }
        E(acc, cur, wr, wc, fr, fq); S.done(cur);
        if (!has_next) break;
#pragma unroll
        for (int a = 0; a < 2; ++a)
#pragma unroll
            for (int b = 0; b < 2; ++b)
#pragma unroll
                for (int m = 0; m < 4; ++m)
#pragma unroll
                    for (int n = 0; n < 2; ++n) acc[a][b][m][n] = (f32x4){0.f, 0.f, 0.f, 0.f};
        cur = nxt; cA = nA; cB = nB; ++ui;
    }
    PG8_WAIT_V(0);
    if (wr == 0) PG8_BAR;
    PG8_BAR;
#undef PG8_SA
#undef PG8_SB
#undef PG8_STAGE
#undef PG8_LDA
#undef PG8_LDB
#undef PG8_MMA
#undef PG8_WAIT_V
#undef PG8_WAIT_L
#undef PG8_BAR
#undef PG8_SCHED
}
}
struct Args { const float* in[22]; float* out; unsigned char* ws; int ph_lo, ph_hi; };
constexpr int D = 1024, SEQ = 2048, NB = 8, MP = NB * SEQ, DB = 128, DSQ = 8, MS = DB * DSQ, M = MP + MS;
constexpr int NPANEL = 23, NPROJ = NPANEL * 256;
constexpr float NORM_EPS = 1e-6f;
constexpr int GLA_DK = 64, GLA_DV = 128, GDN_DK = 128, GDN_DV = 128, CONV_CH = 1536;

constexpr size_t MiB = 1u << 20;
constexpr size_t SZ_PANEL = (size_t)M * 256 * 2;
constexpr size_t WS_CTL = 0, CTL_ZERO_BYTES = 64 * 1024;
constexpr size_t WS_WIN = 1 * MiB;
constexpr size_t WS_WUA = WS_WIN + (size_t)NPROJ * 1024 * 2;
constexpr size_t WS_WUB = WS_WUA + 1 * MiB;
constexpr size_t WS_WO = WS_WUB + 1 * MiB;
constexpr size_t WS_WG = WS_WO + 2 * MiB;
constexpr size_t WS_WP = WS_WG + 2 * MiB;
constexpr size_t WS_SPEC = WS_WP + MiB / 2;
constexpr size_t WS_RSSP = WS_SPEC + (size_t)M * 32 * 2;
constexpr size_t WS_CDEC = WS_RSSP + (size_t)M * 16 * 4;
constexpr size_t WS_PB = WS_CDEC + 4096;
constexpr size_t WS_XN = WS_PB + SZ_PANEL;
constexpr size_t WS_PROJ = WS_XN + (size_t)M * 1024 * 2;
constexpr size_t WS_REC = WS_PROJ + 14 * SZ_PANEL;
constexpr size_t WS_END = WS_REC + (size_t)1024 * 73728;
static_assert(WS_END <= 256 * MiB, "workspace map exceeds 256 MiB");
static_assert(WS_WIN % 256 == 0 && WS_SPEC % 256 == 0 && WS_RSSP % 256 == 0 && WS_PB % 256 == 0 && WS_XN % 256 == 0 && WS_PROJ % 256 == 0 && WS_REC % 256 == 0, "alignment");
constexpr size_t WS_OA = WS_XN, WS_OB = WS_XN + (size_t)M * 512 * 2;
constexpr size_t WS_MERGED = WS_PROJ + 0 * SZ_PANEL;
constexpr size_t WS_H1B = WS_PROJ + 6 * SZ_PANEL;
constexpr size_t WS_PE = WS_PROJ + 10 * SZ_PANEL;
constexpr int PN_QA = 0, PN_KA = 1, PN_VA = 2, PN_ZA = 4, PN_QB = 6, PN_KB = 8, PN_VB = 10, PN_ZB = 12, PN_GA = 14, PN_GB = 18, PN_SPEC = 22;
constexpr size_t OUT_Y = 0, OUT_GLA_P = (size_t)M * D, OUT_GDN_P = OUT_GLA_P + 8 * 4 * 64 * 128, OUT_CONV_P = OUT_GDN_P + 8 * 4 * 128 * 128,
                 OUT_GLA_S = OUT_CONV_P + 8 * 3 * 1536, OUT_GDN_S = OUT_GLA_S + (size_t)128 * 4 * 64 * 128, OUT_CONV_S = OUT_GDN_S + (size_t)128 * 4 * 128 * 128,
                 OUT_TOTAL = OUT_CONV_S + 128 * 3 * 1536;
constexpr int CW_BAR = 1024;

constexpr int RING_OFF = 0, RING_BYTES = 131072;
constexpr int LDS_BYTES = 147456;
constexpr int LDSCTL_OFF = LDS_BYTES - 512, MISC_OFF = LDSCTL_OFF + 320;
constexpr int NWAVES = 8, NTHREADS = 512;

#define GAS __attribute__((address_space(1)))
#define LAS __attribute__((address_space(3)))
typedef unsigned short bf16;
typedef unsigned v4u __attribute__((ext_vector_type(4)));
typedef unsigned v2u __attribute__((ext_vector_type(2)));
typedef float f32x4 __attribute__((ext_vector_type(4)));
typedef GAS unsigned gu32;
#define RLX_AGENT __ATOMIC_RELAXED, __HIP_MEMORY_SCOPE_AGENT
#define LDS_WAIT() asm volatile("s_waitcnt lgkmcnt(0)" ::: "memory")
#define VM_WAIT() asm volatile("s_waitcnt vmcnt(0)" ::: "memory")
__device__ __forceinline__ unsigned f2bf(float f) { unsigned u = __builtin_bit_cast(unsigned, f); return (u + 0x7fffu + ((u >> 16) & 1u)) >> 16; }
__device__ __forceinline__ unsigned pk2(float lo, float hi) { return f2bf(lo) | (f2bf(hi) << 16); }
__device__ __forceinline__ float bf2f(unsigned short b) { return __builtin_bit_cast(float, (unsigned)b << 16); }
__device__ __forceinline__ float bflo(unsigned w) { return __builtin_bit_cast(float, w << 16); }
__device__ __forceinline__ float bfhi(unsigned w) { return __builtin_bit_cast(float, w & 0xffff0000u); }
__device__ __forceinline__ float sigmoidf_(float x) { return 1.f / (1.f + __expf(-x)); }
__device__ __forceinline__ float siluf_(float x) { return x / (1.f + __expf(-x)); }
__device__ __forceinline__ float softplusf_(float x) { return fmaxf(x, 0.f) + log1pf(__expf(-fabsf(x))); }
__device__ __forceinline__ float wave_sum(float v) {
#pragma unroll
    for (int o = 1; o < 64; o <<= 1) v += __shfl_xor(v, o);
    return v;
}

#define XB_TMO      128
#define XB_XCNT(j)  (256  + 64 * (j))
#define XB_XSUB(j)  (1280 + 64 * (j))
#define XB_XGEN(j)  (2304 + 64 * (j))
#define XB_TOP      3328
#define XB_TOPGEN   3392
#define XCD_BAR_WORDS 3456
#define XB_SPIN_CAP (1u << 18)
__device__ __forceinline__ unsigned xb_ld(unsigned* p)              { return __hip_atomic_load(p, __ATOMIC_RELAXED, __HIP_MEMORY_SCOPE_AGENT); }
__device__ __forceinline__ unsigned xb_add(unsigned* p, unsigned v) { return __hip_atomic_fetch_add(p, v, __ATOMIC_RELAXED, __HIP_MEMORY_SCOPE_AGENT); }
__device__ __forceinline__ unsigned xb_xcc_id() { return (unsigned)__builtin_amdgcn_s_getreg((3 << 11) | 20) & 0xFu; }
#define XB_SPIN(cond, bar) do { unsigned _sp = 0; while (cond) { __builtin_amdgcn_s_sleep(1); \
    if ((++_sp & 255u) == 0u) { if (xb_ld(&(bar)[XB_TMO])) break; if (_sp > XB_SPIN_CAP) { atomicAdd(&(bar)[XB_TMO], 1u); break; } } } } while (0)
struct XcdBarrier { unsigned* bar; unsigned x; volatile LAS unsigned* st; };
__device__ __forceinline__ XcdBarrier xcd_barrier_post(unsigned* bar, volatile LAS unsigned* st) {
    XcdBarrier b; b.bar = bar; b.x = xb_xcc_id(); b.st = st;
    if (threadIdx.x == 0) (void)xb_add(&bar[XB_XCNT(b.x)], 1u);
    return b;
}
__device__ __forceinline__ void xcd_barrier_complete(unsigned* bar, unsigned x, unsigned& nloc, unsigned& nx) {
    const unsigned G = gridDim.x * gridDim.y * gridDim.z;
    unsigned sum, cnt, mine, sp = 0u;
    for (;;) {
        sum = 0u; cnt = 0u; mine = 0u;
#pragma unroll
        for (unsigned j = 0; j < 16; ++j) { const unsigned c = xb_ld(&bar[XB_XCNT(j)]); sum += c; cnt += (c > 0u) ? 1u : 0u; mine = (j == x) ? c : mine; }
        if (sum == G) break;
        __builtin_amdgcn_s_sleep(1);
        if ((++sp & 255u) == 0u) { if (xb_ld(&bar[XB_TMO])) break; if (sp > XB_SPIN_CAP) { atomicAdd(&bar[XB_TMO], 1u); break; } }
    }
    nloc = mine > 0u ? mine : 1u; nx = cnt > 0u ? cnt : 1u;
}
__device__ __forceinline__ void xcd_barrier(const XcdBarrier& b) {
    asm volatile("s_waitcnt vmcnt(0)" ::: "memory");
    __syncthreads();
    if (threadIdx.x == 0) {
        unsigned* bar = b.bar;
        __builtin_amdgcn_s_waitcnt(0);
        unsigned nloc = b.st[0], nx = b.st[1];
        if (nloc == 0u) { xcd_barrier_complete(bar, b.x, nloc, nx); b.st[0] = nloc; b.st[1] = nx; }
        const unsigned old = xb_add(&bar[XB_XSUB(b.x)], 1u);
        const unsigned gen = old / nloc;
        if (old + 1u == (gen + 1u) * nloc) {
            __builtin_amdgcn_fence(__ATOMIC_RELEASE, "agent");
            asm volatile("s_waitcnt vmcnt(0)" ::: "memory");
            const unsigned og = xb_add(&bar[XB_TOP], 1u);
            const unsigned tg = og / nx;
            if (og + 1u == (tg + 1u) * nx) xb_add(&bar[XB_TOPGEN], 1u);
            else XB_SPIN(xb_ld(&bar[XB_TOPGEN]) == tg, bar);
            __builtin_amdgcn_fence(__ATOMIC_ACQUIRE, "agent");
            xb_add(&bar[XB_XGEN(b.x)], 1u);
            asm volatile("s_waitcnt vmcnt(0)" ::: "memory");
        } else {
            XB_SPIN(xb_ld(&bar[XB_XGEN(b.x)]) == gen, bar);
            __builtin_amdgcn_fence(__ATOMIC_ACQUIRE, "agent");
            asm volatile("s_waitcnt vmcnt(0)" ::: "memory");
        }
    }
    __syncthreads();
}

struct Frame {
    LAS unsigned char* lds;
    volatile LAS unsigned* MISC;
    int tid, lane, wave, G, vcu;
    const float* in[22];
    float* out;
    unsigned char* ws;
};
__device__ __forceinline__ int win_src_col(int n) {
    if (n < 1024) return n;
    if (n < 3072) return n + 16;
    if (n < 5632) return n + 24;
    if (n < 5648) return 1024 + (n - 5632);
    if (n < 5656) return 3088 + (n - 5648);
    return -1;
}
template <bool MAPCOL>
__device__ __forceinline__ void p0_transpose_item(const float* W, int K, int Nsrc, int Ndst, bf16* WT, LAS float* scr, int item, int lane) {
    const int nblk = Ndst / 32, kb = item / nblk, nb = item % nblk, k0 = 64 * kb, n0 = 32 * nb;
    int sc = n0 + (lane & 31); if (MAPCOL) sc = win_src_col(sc);
#pragma unroll 8
    for (int i = 0; i < 32; ++i) { const int kk = 2 * i + (lane >> 5); scr[kk * 33 + (lane & 31)] = (sc >= 0) ? W[(size_t)(k0 + kk) * Nsrc + sc] : 0.f; }
    LDS_WAIT(); asm volatile("" ::: "memory");
    const int c = lane & 7;
#pragma unroll
    for (int j = 0; j < 4; ++j) { const int n = (lane >> 3) + 8 * j; const LAS float* s = scr + (8 * c) * 33 + n;
        v4u o; o.x = pk2(s[0 * 33], s[1 * 33]); o.y = pk2(s[2 * 33], s[3 * 33]); o.z = pk2(s[4 * 33], s[5 * 33]); o.w = pk2(s[6 * 33], s[7 * 33]);
        *(GAS v4u*)(WT + (size_t)(n0 + n) * K + k0 + 8 * c) = o; }
    LDS_WAIT(); asm volatile("" ::: "memory");
}
__device__ __forceinline__ void rms_row_to_bf16(const float* xrow, const float* w, bf16* orow, int lane) {
    const GAS f32x4* xr = (const GAS f32x4*)xrow + lane;
    const GAS f32x4* wr = (const GAS f32x4*)w + lane;
    f32x4 v[4]; float s = 0.f;
#pragma unroll
    for (int j = 0; j < 4; ++j) { v[j] = xr[64 * j]; s += (v[j].x * v[j].x + v[j].y * v[j].y) + (v[j].z * v[j].z + v[j].w * v[j].w); }
    const float r = 1.f / sqrtf(wave_sum(s) * (1.f / D) + NORM_EPS);
    GAS unsigned long long* o8 = (GAS unsigned long long*)orow + lane;
#pragma unroll
    for (int j = 0; j < 4; ++j) { const f32x4 ww = wr[64 * j];
        o8[64 * j] = (unsigned long long)pk2(v[j].x * r * ww.x, v[j].y * r * ww.y) | ((unsigned long long)pk2(v[j].z * r * ww.z, v[j].w * r * ww.w) << 32); }
}
__device__ __forceinline__ void p0_prologue(const Args& A, LAS unsigned char* lds, int vcu, int G, int wave, int lane) {
    LAS float* scr = (LAS float*)(lds + RING_OFF + wave * 16384);
    const int gw = vcu * NWAVES + wave, NGW = G * NWAVES;
    unsigned char* ws = A.ws;
    constexpr int I_IN = (1024 / 64) * (NPROJ / 32), I_UP = (512 / 64) * (1024 / 32), I_SQ = (1024 / 64) * (1024 / 32), I_PL = (256 / 64) * (1024 / 32);
    constexpr int NITEMS = I_IN + 2 * I_UP + 2 * I_SQ + I_PL;
    for (int it = gw; it < NITEMS; it += NGW) {
        int r = it;
        if (r < I_IN) { p0_transpose_item<true>(A.in[8], 1024, 5656, NPROJ, (bf16*)(ws + WS_WIN), scr, r, lane); continue; } r -= I_IN;
        if (r < I_UP) { p0_transpose_item<false>(A.in[16], 512, 1024, 1024, (bf16*)(ws + WS_WUA), scr, r, lane); continue; } r -= I_UP;
        if (r < I_UP) { p0_transpose_item<false>(A.in[17], 512, 1024, 1024, (bf16*)(ws + WS_WUB), scr, r, lane); continue; } r -= I_UP;
        if (r < I_SQ) { p0_transpose_item<false>(A.in[18], 1024, 1024, 1024, (bf16*)(ws + WS_WO), scr, r, lane); continue; } r -= I_SQ;
        if (r < I_SQ) { p0_transpose_item<false>(A.in[19], 1024, 1024, 1024, (bf16*)(ws + WS_WG), scr, r, lane); continue; } r -= I_SQ;
        p0_transpose_item<false>(A.in[20], 256, 1024, 1024, (bf16*)(ws + WS_WP), scr, r, lane);
    }
    bf16* XN = (bf16*)(ws + WS_XN);
    for (int m = gw; m < M; m += NGW) {
        const float* xrow = (m < MP) ? A.in[0] + (size_t)m * D : A.in[1] + (size_t)(m - MP) * D;
        rms_row_to_bf16(xrow, A.in[7], XN + (size_t)m * D, lane);
    }
    bf16* PB = (bf16*)(ws + WS_PB);
    const int gt = gw * 64 + lane, NGT = NGW * 64;
    for (int i = gt; i < M * 256 / 8; i += NGT) {
        const size_t e = (size_t)i * 8; const int m = (int)(e >> 8), c = (int)(e & 255);
        const float* src = (m < MP) ? A.in[5] + (size_t)m * 256 + c : A.in[6] + (size_t)(m - MP) * 256 + c;
        const f32x4 a = *(const GAS f32x4*)src, b = *(const GAS f32x4*)(src + 4);
        v4u o; o.x = pk2(a.x, a.y); o.y = pk2(a.z, a.w); o.z = pk2(b.x, b.y); o.w = pk2(b.z, b.w);
        *(GAS v4u*)(PB + e) = o;
    }
}
__device__ __forceinline__ const bf16* panel(const unsigned char* ws, int pn) { return (const bf16*)(ws + WS_PROJ + (size_t)pn * SZ_PANEL); }

__device__ __forceinline__ void gla_item(const Args& A, LAS unsigned char* lds, int b, int h, int T, int m0, const float* S0, float* Sout) {
    constexpr int TB = 32;
    const int tid = threadIdx.x, lane = tid & 63, wave = tid >> 6;
    const unsigned char* ws = A.ws;
    LAS float* sq = (LAS float*)lds;
    LAS float* sk = sq + TB * 64;
    LAS float* sd = sk + TB * 64;
    LAS float* sv = sd + TB * 64;
    LAS float* part = sv + TB * 128;
    LAS float* oraw = part + 2 * 4 * 128;
    const int dv = tid & 127, g = tid >> 7;
    float S[16];
#pragma unroll
    for (int i = 0; i < 16; ++i) S[i] = S0 ? S0[(size_t)(g * 16 + i) * 128 + dv] : 0.f;
    const int gdk = tid & 63;
    float wg[16];
#pragma unroll
    for (int r = 0; r < 16; ++r) wg[r] = A.in[9][r * 256 + h * 64 + gdk];
    const float bgv = A.in[10][h * 64 + gdk];
    const bf16* PQ = panel(ws, PN_QA); const bf16* PK = panel(ws, PN_KA);
    const bf16* PV = panel(ws, PN_VA + (h >> 1)); const bf16* PZ = panel(ws, PN_ZA + (h >> 1));
    const bf16* SPEC = (const bf16*)(ws + WS_SPEC);
    bf16* OA = (bf16*)(A.ws + WS_OA);
    const float nw0 = A.in[11][lane], nw1 = A.in[11][lane + 64];
    for (int t0 = 0; t0 < T; t0 += TB) {
        const int nb = (T - t0) < TB ? (T - t0) : TB;
        __syncthreads();
        for (int idx = tid; idx < nb * 64; idx += NTHREADS) { const int tk = idx >> 6, dk = idx & 63; const size_t m = (size_t)(m0 + t0 + tk);
            sq[idx] = bf2f(PQ[m * 256 + h * 64 + dk]) * 0.125f; sk[idx] = bf2f(PK[m * 256 + h * 64 + dk]); }
        for (int idx = tid; idx < nb * 128; idx += NTHREADS) { const int tk = idx >> 7, c = idx & 127; const size_t m = (size_t)(m0 + t0 + tk);
            sv[idx] = bf2f(PV[m * 256 + (h & 1) * 128 + c]); }
        for (int tk = wave; tk < nb; tk += 8) { const size_t m = (size_t)(m0 + t0 + tk);
            float x = bgv;
#pragma unroll
            for (int r = 0; r < 16; ++r) x += bf2f(SPEC[m * 32 + r]) * wg[r];
            const float ls = fminf(x, 0.f) - log1pf(__expf(-fabsf(x)));
            sd[tk * 64 + gdk] = __expf(ls * (1.f / 16.f)); }
        __syncthreads();
        for (int tk = 0; tk < nb; ++tk) {
            const float vv = sv[tk * 128 + dv];
            float po = 0.f;
#pragma unroll
            for (int i = 0; i < 16; ++i) { const int dk = g * 16 + i;
                S[i] = sd[tk * 64 + dk] * S[i] + sk[tk * 64 + dk] * vv; po += sq[tk * 64 + dk] * S[i]; }
            part[((tk & 1) * 4 + g) * 128 + dv] = po;
            __syncthreads();
            if (g == 0) { const LAS float* pp = part + (tk & 1) * 512 + dv; oraw[tk * 128 + dv] = (pp[0] + pp[128]) + (pp[256] + pp[384]); }
        }
        __syncthreads();
        for (int tk = wave; tk < nb; tk += 8) { const size_t m = (size_t)(m0 + t0 + tk);
            const float o0 = oraw[tk * 128 + lane], o1 = oraw[tk * 128 + lane + 64];
            const float r = 1.f / sqrtf(wave_sum(o0 * o0 + o1 * o1) * (1.f / 128.f) + NORM_EPS);
            const float z0 = bf2f(PZ[m * 256 + (h & 1) * 128 + lane]), z1 = bf2f(PZ[m * 256 + (h & 1) * 128 + lane + 64]);
            OA[m * 512 + h * 128 + lane] = (bf16)f2bf(o0 * r * nw0 * siluf_(z0));
            OA[m * 512 + h * 128 + lane + 64] = (bf16)f2bf(o1 * r * nw1 * siluf_(z1)); }
    }
#pragma unroll
    for (int i = 0; i < 16; ++i) Sout[(size_t)(g * 16 + i) * 128 + dv] = S[i];
    __syncthreads();
}

__device__ __forceinline__ void gdn_item(const Args& A, LAS unsigned char* lds, int b, int h, int T, int m0, const float* S0, float* Sout, const float* convbuf) {
    constexpr int TB = 16;
    const int tid = threadIdx.x, lane = tid & 63, wave = tid >> 6;
    const unsigned char* ws = A.ws;
    LAS float* raw = (LAS float*)lds;
    LAS float* sq = raw + (TB + 3) * 384;
    LAS float* sk = sq + TB * 128;
    LAS float* sv = sk + TB * 128;
    LAS float* sbeta = sv + TB * 128;
    LAS float* sgd = sbeta + TB;
    LAS float* sqk = sgd + TB;
    LAS float* part = sqk + TB;
    LAS float* oraw = part + 2 * 2 * 4 * 128;
    const int dv = tid & 127, g = tid >> 7;
    float S[32];
#pragma unroll
    for (int i = 0; i < 32; ++i) S[i] = S0 ? S0[(size_t)(g * 32 + i) * 128 + dv] : 0.f;
    const bf16* PQ = panel(ws, PN_QB + (h >> 1)); const bf16* PK = panel(ws, PN_KB + (h >> 1)); const bf16* PV = panel(ws, PN_VB + (h >> 1));
    const bf16* PZ = panel(ws, PN_ZB + (h >> 1));
    const bf16* SPEC = (const bf16*)(ws + WS_SPEC);
    bf16* OB = (bf16*)(A.ws + WS_OB);
    const float nw0 = A.in[15][lane], nw1 = A.in[15][lane + 64];
    const float negA = -__expf(A.in[13][h]), dtb = A.in[14][h];
    const float* cw = A.in[12];
    for (int t0 = 0; t0 < T; t0 += TB) {
        const int nb = (T - t0) < TB ? (T - t0) : TB;
        __syncthreads();
        for (int idx = tid; idx < (nb + 3) * 384; idx += NTHREADS) { const int r = idx / 384, c = idx - r * 384, seg = c >> 7, cc = c & 127; const int t = t0 - 3 + r;
            float x;
            if (t >= 0) { const bf16* P = seg == 0 ? PQ : (seg == 1 ? PK : PV); x = bf2f(P[(size_t)(m0 + t) * 256 + (h & 1) * 128 + cc]); }
            else x = convbuf ? convbuf[(3 + t) * 1536 + seg * 512 + h * 128 + cc] : 0.f;
            raw[idx] = x; }
        if (tid < nb) { const size_t m = (size_t)(m0 + t0 + tid);
            sbeta[tid] = sigmoidf_(bf2f(SPEC[m * 32 + 20 + h]));
            sgd[tid] = __expf(negA * softplusf_(bf2f(SPEC[m * 32 + 16 + h]) + dtb)); }
        __syncthreads();
        for (int idx = tid; idx < nb * 384; idx += NTHREADS) { const int tk = idx / 384, c = idx - tk * 384, seg = c >> 7, cc = c & 127; const int ch = seg * 512 + h * 128 + cc;
            const float x = cw[ch] * raw[tk * 384 + c] + cw[1536 + ch] * raw[(tk + 1) * 384 + c] + cw[3072 + ch] * raw[(tk + 2) * 384 + c] + cw[4608 + ch] * raw[(tk + 3) * 384 + c];
            const float y = siluf_(x);
            LAS float* dst = seg == 0 ? sq : (seg == 1 ? sk : sv); dst[tk * 128 + cc] = y; }
        __syncthreads();
        for (int tk = wave; tk < nb; tk += 8) {
            float q0 = sq[tk * 128 + lane], q1 = sq[tk * 128 + lane + 64], k0 = sk[tk * 128 + lane], k1 = sk[tk * 128 + lane + 64];
            const float rq = 1.f / sqrtf(wave_sum(q0 * q0 + q1 * q1) + NORM_EPS) * 0.08838834764831845f;
            const float rk = 1.f / sqrtf(wave_sum(k0 * k0 + k1 * k1) + NORM_EPS);
            q0 *= rq; q1 *= rq; k0 *= rk; k1 *= rk;
            sq[tk * 128 + lane] = q0; sq[tk * 128 + lane + 64] = q1; sk[tk * 128 + lane] = k0; sk[tk * 128 + lane + 64] = k1;
            const float qk = wave_sum(q0 * k0 + q1 * k1);
            if (lane == 0) sqk[tk] = qk; }
        __syncthreads();
        for (int tk = 0; tk < nb; ++tk) {
            float pk = 0.f, pq = 0.f;
#pragma unroll
            for (int i = 0; i < 32; ++i) { const int dk = g * 32 + i; pk += sk[tk * 128 + dk] * S[i]; pq += sq[tk * 128 + dk] * S[i]; }
            LAS float* pp = part + (tk & 1) * 1024;
            pp[g * 128 + dv] = pk; pp[512 + g * 128 + dv] = pq;
            __syncthreads();
            const float gd = sgd[tk];
            const float kS = gd * ((pp[dv] + pp[128 + dv]) + (pp[256 + dv] + pp[384 + dv]));
            const float vnew = sbeta[tk] * (sv[tk * 128 + dv] - kS);
#pragma unroll
            for (int i = 0; i < 32; ++i) { const int dk = g * 32 + i; S[i] = gd * S[i] + sk[tk * 128 + dk] * vnew; }
            if (g == 0) { const float qS = gd * ((pp[512 + dv] + pp[640 + dv]) + (pp[768 + dv] + pp[896 + dv])); oraw[tk * 128 + dv] = qS + sqk[tk] * vnew; }
        }
        __syncthreads();
        for (int tk = wave; tk < nb; tk += 8) { const size_t m = (size_t)(m0 + t0 + tk);
            const float o0 = oraw[tk * 128 + lane], o1 = oraw[tk * 128 + lane + 64];
            const float r = 1.f / sqrtf(wave_sum(o0 * o0 + o1 * o1) * (1.f / 128.f) + NORM_EPS);
            const float z0 = bf2f(PZ[m * 256 + (h & 1) * 128 + lane]), z1 = bf2f(PZ[m * 256 + (h & 1) * 128 + lane + 64]);
            OB[m * 512 + h * 128 + lane] = (bf16)f2bf(o0 * r * nw0 * siluf_(z0));
            OB[m * 512 + h * 128 + lane + 64] = (bf16)f2bf(o1 * r * nw1 * siluf_(z1)); }
    }
#pragma unroll
    for (int i = 0; i < 32; ++i) Sout[(size_t)(g * 32 + i) * 128 + dv] = S[i];
    __syncthreads();
}

typedef short bf16x8 __attribute__((ext_vector_type(8)));
typedef float f32x16 __attribute__((ext_vector_type(16)));
typedef float f32x4v __attribute__((ext_vector_type(4)));
#define MFMA32(a, b, c) __builtin_amdgcn_mfma_f32_32x32x16_bf16((a), (b), (c), 0, 0, 0)
#define MFMA16(a, b, c) __builtin_amdgcn_mfma_f32_16x16x32_bf16((a), (b), (c), 0, 0, 0)
#define WG_BAR() do { asm volatile("s_waitcnt vmcnt(0) lgkmcnt(0)" ::: "memory"); __builtin_amdgcn_s_barrier(); asm volatile("" ::: "memory"); } while (0)
__device__ __forceinline__ int c32row(int lane, int reg) { return (reg & 3) + 8 * (reg >> 2) + 4 * (lane >> 5); }
__device__ __forceinline__ bf16x8 acc_frag(const f32x16& c, int s) {
    v4u w;
    if (s == 0) { w.x = pg8::cvt_pk_bf16(c[0], c[1]); w.y = pg8::cvt_pk_bf16(c[2], c[3]); w.z = pg8::cvt_pk_bf16(c[4], c[5]); w.w = pg8::cvt_pk_bf16(c[6], c[7]); }
    else { w.x = pg8::cvt_pk_bf16(c[8], c[9]); w.y = pg8::cvt_pk_bf16(c[10], c[11]); w.z = pg8::cvt_pk_bf16(c[12], c[13]); w.w = pg8::cvt_pk_bf16(c[14], c[15]); }
    return __builtin_bit_cast(bf16x8, w);
}
__device__ __forceinline__ bf16x8 lds_frag(const LAS bf16* rowp, int k0, int h) { return *(const LAS bf16x8*)(rowp + k0 + 8 * h); }
__device__ __forceinline__ bf16x8 lds_frag_perm(const LAS bf16* rowp, int s, int h) {
    const v2u a = *(const LAS v2u*)(rowp + 16 * s + 4 * h), b = *(const LAS v2u*)(rowp + 16 * s + 8 + 4 * h);
    v4u w; w.x = a.x; w.y = a.y; w.z = b.x; w.w = b.y; return __builtin_bit_cast(bf16x8, w);
}
__device__ __forceinline__ f32x16 zero16() { f32x16 z;
#pragma unroll
    for (int i = 0; i < 16; ++i) z[i] = 0.f; return z; }

__device__ __forceinline__ v4u pack8(const f32x4 a, const f32x4 b) { v4u w; w.x = pg8::cvt_pk_bf16(a.x, a.y); w.y = pg8::cvt_pk_bf16(a.z, a.w); w.z = pg8::cvt_pk_bf16(b.x, b.y); w.w = pg8::cvt_pk_bf16(b.z, b.w); return w; }
__device__ __forceinline__ void unpack8(const v4u w, f32x4& a, f32x4& b) { a = (f32x4){bflo(w.x), bfhi(w.x), bflo(w.y), bfhi(w.y)}; b = (f32x4){bflo(w.z), bfhi(w.z), bflo(w.w), bfhi(w.w)}; }
__device__ __forceinline__ f32x4 sig4(const f32x4 x) { return (f32x4){sigmoidf_(x.x), sigmoidf_(x.y), sigmoidf_(x.z), sigmoidf_(x.w)}; }
constexpr int GLA_QE = 0, GLA_KE = 9216, GLA_KENDT = 18432, GLA_VT = 27648, GLA_ATT = 46080, GLA_GA = 55296, GLA_SEG = 59392, GLA_DD = 61440, GLA_OBUF = 61696, GLA_LDS_END = GLA_OBUF + 64 * 132 * 4;
static_assert(GLA_LDS_END <= 131072, "GLA LDS");
struct GlaState { f32x16 S[2]; bf16x8 Sb[4]; };
__device__ __forceinline__ void gla_chunk(const Args& A, LAS unsigned char* lds, int b, int h, int n, GlaState& st, const float (&wg)[16], float bgv) {
    const int tid = threadIdx.x, lane = tid & 63, wave = __builtin_amdgcn_readfirstlane(tid >> 6), r = lane & 31, hh = lane >> 5;
    const unsigned char* ws = A.ws;
    const size_t m0 = (size_t)b * SEQ + (size_t)n * 64;
    LAS bf16* QE = (LAS bf16*)(lds + GLA_QE); LAS bf16* KE = (LAS bf16*)(lds + GLA_KE); LAS bf16* KENDT = (LAS bf16*)(lds + GLA_KENDT);
    LAS bf16* VT = (LAS bf16*)(lds + GLA_VT); LAS bf16* ATT = (LAS bf16*)(lds + GLA_ATT);
    LAS float* GA = (LAS float*)(lds + GLA_GA); LAS float* SEG = (LAS float*)(lds + GLA_SEG); LAS float* DD = (LAS float*)(lds + GLA_DD); LAS float* OBUF = (LAS float*)(lds + GLA_OBUF);
    const bf16* PQ = panel(ws, PN_QA); const bf16* PK = panel(ws, PN_KA); const bf16* PV = panel(ws, PN_VA + (h >> 1)); const bf16* PZ = panel(ws, PN_ZA + (h >> 1));
    const bf16* SPEC = (const bf16*)(ws + WS_SPEC);
    { const int t = tid >> 3, c2 = (tid & 7) * 2; const unsigned w = *(const GAS unsigned*)(SPEC + (m0 + t) * 32 + c2); GA[t * 16 + c2] = bflo(w); GA[t * 16 + c2 + 1] = bfhi(w); }
    { unsigned vv[8];
#pragma unroll
      for (int i = 0; i < 8; ++i) vv[i] = *(const GAS unsigned*)(PV + (m0 + wave * 8 + i) * 256 + (h & 1) * 128 + 2 * lane);
      v4u lo, hi; lo.x = (vv[0] & 0xffffu) | (vv[1] << 16); lo.y = (vv[2] & 0xffffu) | (vv[3] << 16); lo.z = (vv[4] & 0xffffu) | (vv[5] << 16); lo.w = (vv[6] & 0xffffu) | (vv[7] << 16);
      hi.x = (vv[0] >> 16) | (vv[1] & 0xffff0000u); hi.y = (vv[2] >> 16) | (vv[3] & 0xffff0000u); hi.z = (vv[4] >> 16) | (vv[5] & 0xffff0000u); hi.w = (vv[6] >> 16) | (vv[7] & 0xffff0000u);
      *(LAS v4u*)(VT + (2 * lane) * 72 + wave * 8) = lo; *(LAS v4u*)(VT + (2 * lane + 1) * 72 + wave * 8) = hi; }
    WG_BAR();
    const int dk = tid & 63, seg = tid >> 6;
    float cs[8];
    { float run = 0.f;
#pragma unroll
      for (int i = 0; i < 8; ++i) { const int t = seg * 8 + i; float x = bgv;
#pragma unroll
          for (int q = 0; q < 16; ++q) x += GA[t * 16 + q] * wg[q];
          const float ls = fminf(x, 0.f) - log1pf(__expf(-fabsf(x)));
          run += ls * (1.f / 16.f); cs[i] = run; }
      SEG[seg * 64 + dk] = run; }
    WG_BAR();
    { float off = 0.f, tot = 0.f;
#pragma unroll
      for (int s = 0; s < 8; ++s) { const float v = SEG[s * 64 + dk]; tot += v; if (s < seg) off += v; }
      unsigned kend[4];
#pragma unroll
      for (int i = 0; i < 8; ++i) { const int t = seg * 8 + i; const float bb = off + cs[i];
          const float q = bf2f(PQ[(m0 + t) * 256 + h * 64 + dk]), k = bf2f(PK[(m0 + t) * 256 + h * 64 + dk]);
          QE[t * 72 + dk] = (bf16)f2bf(q * 0.125f * __expf(bb)); KE[t * 72 + dk] = (bf16)f2bf(k * __expf(-bb));
          const unsigned ke = f2bf(k * __expf(tot - bb)); if (i & 1) kend[i >> 1] |= ke << 16; else kend[i >> 1] = ke; }
      v4u kw; kw.x = kend[0]; kw.y = kend[1]; kw.z = kend[2]; kw.w = kend[3];
      *(LAS v4u*)(KENDT + dk * 72 + seg * 8) = kw;
      if (seg == 0) DD[dk] = __expf(tot); }
    WG_BAR();
    if (wave < 3) { const int tp = (wave == 2) ? 1 : 0, mt = (wave == 0) ? 0 : 1;
        f32x16 acc = zero16();
#pragma unroll
        for (int s = 0; s < 4; ++s) acc = MFMA32(lds_frag(KE + (32 * tp + r) * 72, 16 * s, hh), lds_frag(QE + (32 * mt + r) * 72, 16 * s, hh), acc);
        const int t = 32 * mt + r;
#pragma unroll
        for (int q = 0; q < 4; ++q) { const int tq = 32 * tp + 8 * q + 4 * hh; float v[4];
#pragma unroll
            for (int e = 0; e < 4; ++e) v[e] = (tq + e <= t) ? acc[4 * q + e] : 0.f;
            v2u w; w.x = pg8::cvt_pk_bf16(v[0], v[1]); w.y = pg8::cvt_pk_bf16(v[2], v[3]); *(LAS v2u*)(ATT + t * 72 + tq) = w; } }
    WG_BAR();
    if (wave < 4) {
        const LAS bf16* vrow = VT + (32 * wave + r) * 72;
        bf16x8 vb[4];
#pragma unroll
        for (int s = 0; s < 4; ++s) vb[s] = lds_frag(vrow, 16 * s, hh);
        f32x16 O0 = zero16(), O1 = zero16();
#pragma unroll
        for (int s = 0; s < 2; ++s) O0 = MFMA32(lds_frag(ATT + r * 72, 16 * s, hh), vb[s], O0);
#pragma unroll
        for (int s = 0; s < 4; ++s) O1 = MFMA32(lds_frag(ATT + (32 + r) * 72, 16 * s, hh), vb[s], O1);
#pragma unroll
        for (int s = 0; s < 4; ++s) { O0 = MFMA32(lds_frag_perm(QE + r * 72, s, hh), st.Sb[s], O0); O1 = MFMA32(lds_frag_perm(QE + (32 + r) * 72, s, hh), st.Sb[s], O1); }
#pragma unroll
        for (int g = 0; g < 16; ++g) { OBUF[c32row(lane, g) * 132 + 32 * wave + r] = O0[g]; OBUF[(32 + c32row(lane, g)) * 132 + 32 * wave + r] = O1[g]; }
#pragma unroll
        for (int mk = 0; mk < 2; ++mk) {
#pragma unroll
            for (int g = 0; g < 16; ++g) st.S[mk][g] *= DD[32 * mk + c32row(lane, g)];
#pragma unroll
            for (int s = 0; s < 4; ++s) st.S[mk] = MFMA32(lds_frag(KENDT + (32 * mk + r) * 72, 16 * s, hh), vb[s], st.S[mk]);
        }
        st.Sb[0] = acc_frag(st.S[0], 0); st.Sb[1] = acc_frag(st.S[0], 1); st.Sb[2] = acc_frag(st.S[1], 0); st.Sb[3] = acc_frag(st.S[1], 1);
    }
    WG_BAR();
    { bf16* OA = (bf16*)(A.ws + WS_OA); const float nw0 = A.in[11][2 * lane], nw1 = A.in[11][2 * lane + 1];
#pragma unroll
      for (int i = 0; i < 8; ++i) { const int t = wave * 8 + i; const size_t m = m0 + t;
          const float o0 = OBUF[t * 132 + 2 * lane], o1 = OBUF[t * 132 + 2 * lane + 1];
          const float rr = 1.f / sqrtf(wave_sum(o0 * o0 + o1 * o1) * (1.f / 128.f) + NORM_EPS);
          const unsigned zw = *(const GAS unsigned*)(PZ + m * 256 + (h & 1) * 128 + 2 * lane);
          *(GAS unsigned*)(OA + m * 512 + h * 128 + 2 * lane) = pk2(o0 * rr * nw0 * siluf_(bflo(zw)), o1 * rr * nw1 * siluf_(bfhi(zw))); } }
    WG_BAR();
}
__device__ __forceinline__ void gla_final(const Args& A, int c, const GlaState& st) {
    const int tid = threadIdx.x, lane = tid & 63, wave = tid >> 6, r = lane & 31;
    if (wave < 4) { float* So = A.out + OUT_GLA_P + (size_t)c * 64 * 128;
#pragma unroll
        for (int mk = 0; mk < 2; ++mk)
#pragma unroll
            for (int g = 0; g < 16; ++g) So[(size_t)(32 * mk + c32row(lane, g)) * 128 + 32 * wave + r] = st.S[mk][g]; }
}
constexpr size_t REC_BYTES = 73728; constexpr int REC_W = 0, REC_QE = 16384, REC_QK = 32768, REC_KT = 40960, REC_U = 57344, REC_LDS = 57344;
constexpr int R1_KN = 0, R1_QN = 17408, R1_KNT = 34816, R1_VT = 53248, R1_AM = 71680, R1_ANEG = 89088, R1_DINV = 98304, R1_TB = 101376, R1_TBD = 110592, R1_TAB = 119808, R1_END = R1_TAB + 1024;
static_assert(R1_END <= 131072, "R1 LDS");
__device__ __forceinline__ void st_frag(unsigned char* g, int frag, int lane, const v4u w) { *(GAS v4u*)(g + (size_t)frag * 1024 + lane * 16) = w; }

__device__ __forceinline__ void gdn_r1_unit(const Args& A, LAS unsigned char* lds, int u) {
    const int tid = threadIdx.x, lane = tid & 63, wave = __builtin_amdgcn_readfirstlane(tid >> 6), r = lane & 31, hh = lane >> 5;
    const int bh = u >> 5, n = u & 31, b = bh >> 2, h = bh & 3;
    const unsigned char* ws = A.ws;
    unsigned char* rec = A.ws + WS_REC + (size_t)u * REC_BYTES;
    const size_t m0 = (size_t)b * SEQ + (size_t)n * 64;
    LAS bf16* KN = (LAS bf16*)(lds + R1_KN); LAS bf16* QN = (LAS bf16*)(lds + R1_QN); LAS bf16* KNT = (LAS bf16*)(lds + R1_KNT); LAS bf16* VT = (LAS bf16*)(lds + R1_VT);
    LAS float* AM = (LAS float*)(lds + R1_AM); LAS bf16* ANEG = (LAS bf16*)(lds + R1_ANEG); LAS bf16* DINV = (LAS bf16*)(lds + R1_DINV);
    LAS bf16* TB = (LAS bf16*)(lds + R1_TB); LAS bf16* TBD = (LAS bf16*)(lds + R1_TBD);
    LAS float* DEC = (LAS float*)(lds + R1_TAB); LAS float* BETA = DEC + 64; LAS float* EDEC = DEC + 128; LAS float* EEND = DEC + 192;
    const bf16* SPEC = (const bf16*)(ws + WS_SPEC);
    { const size_t m = m0 + lane;
      const float gg = -__expf(A.in[13][h]) * softplusf_(bf2f(SPEC[m * 32 + 16 + h]) + A.in[14][h]);
      float d = gg;
#pragma unroll
      for (int o = 1; o < 64; o <<= 1) { const float v = __shfl_up(d, o); if (lane >= o) d += v; }
      const float dl = __shfl(d, 63);
      if (wave == 0) { DEC[lane] = d; BETA[lane] = sigmoidf_(bf2f(SPEC[m * 32 + 20 + h])); EDEC[lane] = __expf(d); EEND[lane] = __expf(dl - d);
          if (lane == 0) ((float*)(A.ws + WS_CDEC))[u] = __expf(dl); } }
    { const int t0 = wave * 8;
      float raw[11][3][2];
#pragma unroll
      for (int rr = 0; rr < 11; ++rr) { const int t = n * 64 + t0 - 3 + rr;
#pragma unroll
          for (int sg = 0; sg < 3; ++sg) { unsigned w = 0u;
              if (t >= 0) w = *(const GAS unsigned*)(panel(ws, PN_QB + 2 * sg + (h >> 1)) + ((size_t)b * SEQ + t) * 256 + (h & 1) * 128 + 2 * lane);
              raw[rr][sg][0] = bflo(w); raw[rr][sg][1] = bfhi(w); } }
      float cw[4][3][2];
#pragma unroll
      for (int j = 0; j < 4; ++j)
#pragma unroll
          for (int sg = 0; sg < 3; ++sg) { cw[j][sg][0] = A.in[12][j * 1536 + sg * 512 + h * 128 + 2 * lane]; cw[j][sg][1] = A.in[12][j * 1536 + sg * 512 + h * 128 + 2 * lane + 1]; }
      unsigned kt0[4], kt1[4], vt0[4], vt1[4];
#pragma unroll
      for (int i = 0; i < 8; ++i) { float o[3][2];
#pragma unroll
          for (int sg = 0; sg < 3; ++sg)
#pragma unroll
              for (int e = 0; e < 2; ++e) o[sg][e] = siluf_(cw[0][sg][e] * raw[i][sg][e] + cw[1][sg][e] * raw[i + 1][sg][e] + cw[2][sg][e] * raw[i + 2][sg][e] + cw[3][sg][e] * raw[i + 3][sg][e]);
          const float rq = 0.08838834764831845f / sqrtf(wave_sum(o[0][0] * o[0][0] + o[0][1] * o[0][1]) + NORM_EPS);
          const float rk = 1.f / sqrtf(wave_sum(o[1][0] * o[1][0] + o[1][1] * o[1][1]) + NORM_EPS);
          const unsigned qw = pk2(o[0][0] * rq, o[0][1] * rq), kw = pk2(o[1][0] * rk, o[1][1] * rk), vw = pk2(o[2][0], o[2][1]);
          *(LAS unsigned*)(QN + (t0 + i) * 136 + 2 * lane) = qw; *(LAS unsigned*)(KN + (t0 + i) * 136 + 2 * lane) = kw;
          if (i & 1) { kt0[i >> 1] |= kw << 16; kt1[i >> 1] |= kw & 0xffff0000u; vt0[i >> 1] |= vw << 16; vt1[i >> 1] |= vw & 0xffff0000u; }
          else { kt0[i >> 1] = kw & 0xffffu; kt1[i >> 1] = kw >> 16; vt0[i >> 1] = vw & 0xffffu; vt1[i >> 1] = vw >> 16; } }
      v4u x; x.x = kt0[0]; x.y = kt0[1]; x.z = kt0[2]; x.w = kt0[3]; *(LAS v4u*)(KNT + (2 * lane) * 72 + t0) = x;
      x.x = kt1[0]; x.y = kt1[1]; x.z = kt1[2]; x.w = kt1[3]; *(LAS v4u*)(KNT + (2 * lane + 1) * 72 + t0) = x;
      x.x = vt0[0]; x.y = vt0[1]; x.z = vt0[2]; x.w = vt0[3]; *(LAS v4u*)(VT + (2 * lane) * 72 + t0) = x;
      x.x = vt1[0]; x.y = vt1[1]; x.z = vt1[2]; x.w = vt1[3]; *(LAS v4u*)(VT + (2 * lane + 1) * 72 + t0) = x; }
    WG_BAR();
    if (wave < 3) { const int tp = (wave == 2) ? 1 : 0, mt = (wave == 0) ? 0 : 1;
        f32x16 kk = zero16(), qk = zero16();
#pragma unroll
        for (int s = 0; s < 8; ++s) { const bf16x8 a = lds_frag(KN + (32 * tp + r) * 136, 16 * s, hh);
            kk = MFMA32(a, lds_frag(KN + (32 * mt + r) * 136, 16 * s, hh), kk); qk = MFMA32(a, lds_frag(QN + (32 * mt + r) * 136, 16 * s, hh), qk); }
        const int t = 32 * mt + r; const float dect = DEC[t], bet = BETA[t];
#pragma unroll
        for (int q = 0; q < 4; ++q) { const int tq = 32 * tp + 8 * q + 4 * hh; float av[4], qv[4];
#pragma unroll
            for (int e = 0; e < 4; ++e) { const int tpp = tq + e; const float gam = (tpp <= t) ? __expf(dect - DEC[tpp]) : 0.f;
                av[e] = (tpp < t) ? bet * kk[4 * q + e] * gam : 0.f; qv[e] = qk[4 * q + e] * gam; qk[4 * q + e] = qv[e]; }
            *(LAS f32x4v*)(AM + t * 68 + tq) = (f32x4v){av[0], av[1], av[2], av[3]};
            v2u w; w.x = pg8::cvt_pk_bf16(-av[0], -av[1]); w.y = pg8::cvt_pk_bf16(-av[2], -av[3]); *(LAS v2u*)(ANEG + t * 72 + tq) = w; }
        st_frag(rec + REC_QK, mt * 4 + 2 * tp + 0, lane, __builtin_bit_cast(v4u, acc_frag(qk, 0)));
        st_frag(rec + REC_QK, mt * 4 + 2 * tp + 1, lane, __builtin_bit_cast(v4u, acc_frag(qk, 1)));
    } else {
        for (int f = wave - 3; f < 32; f += 5) {
            if (f < 16) { const int mt = f >> 3, s = f & 7, t = 32 * mt + r; const float e = EDEC[t];
                const LAS bf16* rp = QN + t * 136; const v2u a = *(const LAS v2u*)(rp + 16 * s + 4 * hh), c = *(const LAS v2u*)(rp + 16 * s + 8 + 4 * hh);
                v4u w; w.x = pk2(bflo(a.x) * e, bfhi(a.x) * e); w.y = pk2(bflo(a.y) * e, bfhi(a.y) * e); w.z = pk2(bflo(c.x) * e, bfhi(c.x) * e); w.w = pk2(bflo(c.y) * e, bfhi(c.y) * e);
                st_frag(rec + REC_QE, f, lane, w); }
            else { const int g = f - 16, mk = g >> 2, sp = g & 3; const LAS bf16* rp = KNT + (32 * mk + r) * 72; const int ta = 16 * sp + 4 * hh, tb = ta + 8;
                const v2u a = *(const LAS v2u*)(rp + ta), c = *(const LAS v2u*)(rp + tb);
                v4u w; w.x = pk2(bflo(a.x) * EEND[ta], bfhi(a.x) * EEND[ta + 1]); w.y = pk2(bflo(a.y) * EEND[ta + 2], bfhi(a.y) * EEND[ta + 3]);
                w.z = pk2(bflo(c.x) * EEND[tb], bfhi(c.x) * EEND[tb + 1]); w.w = pk2(bflo(c.y) * EEND[tb + 2], bfhi(c.y) * EEND[tb + 3]);
                st_frag(rec + REC_KT, g, lane, w); }
        }
    }
    WG_BAR();
    if (wave == 0) { const int I = lane >> 4, c = lane & 15; float x[16];
#pragma unroll
        for (int i = 0; i < 16; ++i) { float acc = (i == c) ? 1.f : 0.f; const LAS float* nr = AM + (16 * I + i) * 68 + 16 * I;
#pragma unroll
            for (int j = 0; j < i; ++j) acc -= nr[j] * x[j];
            x[i] = acc; DINV[(I * 16 + i) * 24 + c] = (bf16)f2bf(acc); } }
    WG_BAR();
    if (wave < 4) { const int Jc = wave, c = lane & 15, g = lane >> 4; f32x4v X[4];
#pragma unroll
        for (int I = 0; I < 4; ++I) { X[I] = (f32x4v){0.f, 0.f, 0.f, 0.f};
            if (I >= Jc) { f32x4v R;
#pragma unroll
                for (int e = 0; e < 4; ++e) R[e] = (I == Jc && 4 * g + e == c) ? 1.f : 0.f;
#pragma unroll
                for (int p = 0; p < 2; ++p) { const int J0 = 2 * p, J1 = 2 * p + 1; if (J0 < I) {
                    const LAS bf16* ar = ANEG + (16 * I + c) * 72;
                    const v2u a0 = *(const LAS v2u*)(ar + 16 * J0 + 4 * g); v2u a1; a1.x = 0u; a1.y = 0u; if (J1 < I) a1 = *(const LAS v2u*)(ar + 16 * J1 + 4 * g);
                    v4u aw; aw.x = a0.x; aw.y = a0.y; aw.z = a1.x; aw.w = a1.y;
                    v4u bw; bw.x = pg8::cvt_pk_bf16(X[J0][0], X[J0][1]); bw.y = pg8::cvt_pk_bf16(X[J0][2], X[J0][3]); bw.z = 0u; bw.w = 0u;
                    if (J1 < I) { bw.z = pg8::cvt_pk_bf16(X[J1][0], X[J1][1]); bw.w = pg8::cvt_pk_bf16(X[J1][2], X[J1][3]); }
                    R = MFMA16(__builtin_bit_cast(bf16x8, aw), __builtin_bit_cast(bf16x8, bw), R); } }
                const v2u d0 = *(const LAS v2u*)(DINV + (I * 16 + c) * 24 + 4 * g);
                v4u aw; aw.x = d0.x; aw.y = d0.y; aw.z = 0u; aw.w = 0u;
                v4u bw; bw.x = pg8::cvt_pk_bf16(R[0], R[1]); bw.y = pg8::cvt_pk_bf16(R[2], R[3]); bw.z = 0u; bw.w = 0u;
                const f32x4v z4 = {0.f, 0.f, 0.f, 0.f}; X[I] = MFMA16(__builtin_bit_cast(bf16x8, aw), __builtin_bit_cast(bf16x8, bw), z4); } }
        const int cc = 16 * Jc + c; const float bet = BETA[cc], bed = bet * EDEC[cc];
#pragma unroll
        for (int I = 0; I < 4; ++I)
#pragma unroll
            for (int e = 0; e < 4; ++e) { const int t = 16 * I + 4 * g + e; TB[t * 72 + cc] = (bf16)f2bf(X[I][e] * bet); TBD[t * 72 + cc] = (bf16)f2bf(X[I][e] * bed); } }
    WG_BAR();
    { const int mt = wave & 1, cb = wave >> 1; const int ns = mt ? 4 : 2;
      f32x16 ua = zero16(), wa = zero16();
      for (int s = 0; s < ns; ++s) {
          ua = MFMA32(lds_frag(TB + (32 * mt + r) * 72, 16 * s, hh), lds_frag(VT + (32 * cb + r) * 72, 16 * s, hh), ua);
          wa = MFMA32(lds_frag(KNT + (32 * cb + r) * 72, 16 * s, hh), lds_frag(TBD + (32 * mt + r) * 72, 16 * s, hh), wa); }
      { v4u lo = __builtin_bit_cast(v4u, acc_frag(ua, 0)), hi = __builtin_bit_cast(v4u, acc_frag(ua, 1));
        unsigned char* up = rec + REC_U + (size_t)((cb * 2 + mt) * 64 + lane) * 32; *(GAS v4u*)up = lo; *(GAS v4u*)(up + 16) = hi; }
#pragma unroll
      for (int g = 0; g < 16; ++g) wa[g] = -wa[g];
      st_frag(rec + REC_W, mt * 8 + 2 * cb + 0, lane, __builtin_bit_cast(v4u, acc_frag(wa, 0)));
      st_frag(rec + REC_W, mt * 8 + 2 * cb + 1, lane, __builtin_bit_cast(v4u, acc_frag(wa, 1))); }
    WG_BAR();
}

constexpr int R2_BUF0 = 0, R2_BUF1 = REC_LDS, R2_OBUF = 2 * REC_LDS, R2_END = R2_OBUF + 64 * 136 * 2;
static_assert(R2_END <= LDS_BYTES - 512, "R2 LDS");
#define RAW_BAR() do { asm volatile("" ::: "memory"); __builtin_amdgcn_s_barrier(); asm volatile("" ::: "memory"); } while (0)
__device__ __forceinline__ void gdn_r2_item(const Args& A, LAS unsigned char* lds, int bh) {
    const int tid = threadIdx.x, lane = tid & 63, wave = __builtin_amdgcn_readfirstlane(tid >> 6), r = lane & 31, hh = lane >> 5;
    const int b = bh >> 2, h = bh & 3;
    const unsigned char* recs = A.ws + WS_REC + (size_t)bh * 32 * REC_BYTES;
    const float* CDEC = (const float*)(A.ws + WS_CDEC) + bh * 32;
    LAS bf16* OBUF = (LAS bf16*)(lds + R2_OBUF);
    if (wave >= 4) { const int wl = wave - 4;
        for (int p = wl; p < 56; p += 4) __builtin_amdgcn_global_load_lds((const unsigned*)(recs + (size_t)p * 1024 + lane * 16), (LAS unsigned*)(lds + R2_BUF0 + p * 1024), 16, 0, 0);
        asm volatile("s_waitcnt vmcnt(0)" ::: "memory"); }
    RAW_BAR();
    if (wave < 4) {
        f32x16 S[4]; bf16x8 Sb[8];
#pragma unroll
        for (int i = 0; i < 4; ++i) S[i] = zero16();
#pragma unroll
        for (int i = 0; i < 8; ++i) Sb[i] = (bf16x8){0, 0, 0, 0, 0, 0, 0, 0};
        v4u un[2][2];
#pragma unroll
        for (int mt = 0; mt < 2; ++mt) { const unsigned char* up = recs + REC_U + (size_t)((wave * 2 + mt) * 64 + lane) * 32; un[mt][0] = *(const GAS v4u*)up; un[mt][1] = *(const GAS v4u*)(up + 16); }
        for (int n = 0; n < 32; ++n) {
            const LAS unsigned char* buf = lds + ((n & 1) ? R2_BUF1 : R2_BUF0);
            const float cdec = CDEC[n];
            f32x16 V[2];
#pragma unroll
            for (int mt = 0; mt < 2; ++mt) { const v4u lo = un[mt][0], hi = un[mt][1];
                V[mt][0] = bflo(lo.x); V[mt][1] = bfhi(lo.x); V[mt][2] = bflo(lo.y); V[mt][3] = bfhi(lo.y); V[mt][4] = bflo(lo.z); V[mt][5] = bfhi(lo.z); V[mt][6] = bflo(lo.w); V[mt][7] = bfhi(lo.w);
                V[mt][8] = bflo(hi.x); V[mt][9] = bfhi(hi.x); V[mt][10] = bflo(hi.y); V[mt][11] = bfhi(hi.y); V[mt][12] = bflo(hi.z); V[mt][13] = bfhi(hi.z); V[mt][14] = bflo(hi.w); V[mt][15] = bfhi(hi.w); }
            if (n + 1 < 32) {
#pragma unroll
                for (int mt = 0; mt < 2; ++mt) { const unsigned char* up = recs + (size_t)(n + 1) * REC_BYTES + REC_U + (size_t)((wave * 2 + mt) * 64 + lane) * 32; un[mt][0] = *(const GAS v4u*)up; un[mt][1] = *(const GAS v4u*)(up + 16); } }
#pragma unroll
            for (int s = 0; s < 8; ++s) {
                V[0] = MFMA32(*(const LAS bf16x8*)(buf + REC_W + (0 * 8 + s) * 1024 + lane * 16), Sb[s], V[0]);
                V[1] = MFMA32(*(const LAS bf16x8*)(buf + REC_W + (1 * 8 + s) * 1024 + lane * 16), Sb[s], V[1]); }
            bf16x8 Vb[4]; Vb[0] = acc_frag(V[0], 0); Vb[1] = acc_frag(V[0], 1); Vb[2] = acc_frag(V[1], 0); Vb[3] = acc_frag(V[1], 1);
            asm volatile("s_waitcnt lgkmcnt(0)" ::: "memory");
            RAW_BAR();
            f32x16 O0 = zero16(), O1 = zero16();
#pragma unroll
            for (int s = 0; s < 8; ++s) {
                O0 = MFMA32(*(const LAS bf16x8*)(buf + REC_QE + (0 * 8 + s) * 1024 + lane * 16), Sb[s], O0);
                O1 = MFMA32(*(const LAS bf16x8*)(buf + REC_QE + (1 * 8 + s) * 1024 + lane * 16), Sb[s], O1); }
#pragma unroll
            for (int s = 0; s < 2; ++s) O0 = MFMA32(*(const LAS bf16x8*)(buf + REC_QK + (0 * 4 + s) * 1024 + lane * 16), Vb[s], O0);
#pragma unroll
            for (int s = 0; s < 4; ++s) O1 = MFMA32(*(const LAS bf16x8*)(buf + REC_QK + (1 * 4 + s) * 1024 + lane * 16), Vb[s], O1);
#pragma unroll
            for (int g = 0; g < 16; ++g) { OBUF[c32row(lane, g) * 136 + 32 * wave + r] = (bf16)f2bf(O0[g]); OBUF[(32 + c32row(lane, g)) * 136 + 32 * wave + r] = (bf16)f2bf(O1[g]); }
#pragma unroll
            for (int mk = 0; mk < 4; ++mk) {
#pragma unroll
                for (int g = 0; g < 16; ++g) S[mk][g] *= cdec;
#pragma unroll
                for (int s = 0; s < 4; ++s) S[mk] = MFMA32(*(const LAS bf16x8*)(buf + REC_KT + (mk * 4 + s) * 1024 + lane * 16), Vb[s], S[mk]);
                Sb[2 * mk] = acc_frag(S[mk], 0); Sb[2 * mk + 1] = acc_frag(S[mk], 1); }
            asm volatile("s_waitcnt lgkmcnt(0)" ::: "memory");
            RAW_BAR();
        }
        RAW_BAR();
        float* So = A.out + OUT_GDN_P + (size_t)bh * 128 * 128;
#pragma unroll
        for (int mk = 0; mk < 4; ++mk)
#pragma unroll
            for (int g = 0; g < 16; ++g) So[(size_t)(32 * mk + c32row(lane, g)) * 128 + 32 * wave + r] = S[mk][g];
    } else {
        const int wl = wave - 4, lt = tid - 256, t = lt >> 2, qd = lt & 3;
        const bf16* PZ = panel(A.ws, PN_ZB + (h >> 1)); bf16* OB = (bf16*)(A.ws + WS_OB);
        f32x4 nw[8];
#pragma unroll
        for (int i = 0; i < 8; ++i) nw[i] = *(const GAS f32x4*)(A.in[15] + 32 * qd + 4 * i);
        for (int n = 0; n <= 32; ++n) {
            if (n + 1 < 32) { const unsigned char* src = recs + (size_t)(n + 1) * REC_BYTES; LAS unsigned char* dst = lds + (((n + 1) & 1) ? R2_BUF1 : R2_BUF0);
                for (int p = wl; p < 56; p += 4) __builtin_amdgcn_global_load_lds((const unsigned*)(src + (size_t)p * 1024 + lane * 16), (LAS unsigned*)(dst + p * 1024), 16, 0, 0); }
            if (n >= 1) { const size_t m = (size_t)b * SEQ + (size_t)(n - 1) * 64 + t;
                v4u ow[4]; float ss = 0.f; f32x4 ov[8];
#pragma unroll
                for (int i = 0; i < 4; ++i) { ow[i] = *(const LAS v4u*)(OBUF + t * 136 + 32 * qd + 8 * i); unpack8(ow[i], ov[2 * i], ov[2 * i + 1]); }
#pragma unroll
                for (int i = 0; i < 8; ++i) ss += (ov[i].x * ov[i].x + ov[i].y * ov[i].y) + (ov[i].z * ov[i].z + ov[i].w * ov[i].w);
                ss += __shfl_xor(ss, 1); ss += __shfl_xor(ss, 2);
                const float rr = 1.f / sqrtf(ss * (1.f / 128.f) + NORM_EPS);
                asm volatile("s_waitcnt lgkmcnt(0)" ::: "memory");
                RAW_BAR();
#pragma unroll
                for (int i = 0; i < 4; ++i) { f32x4 z0, z1; unpack8(*(const GAS v4u*)(PZ + m * 256 + (h & 1) * 128 + 32 * qd + 8 * i), z0, z1);
                    f32x4 a = ov[2 * i] * rr * nw[2 * i], c = ov[2 * i + 1] * rr * nw[2 * i + 1];
                    a.x *= siluf_(z0.x); a.y *= siluf_(z0.y); a.z *= siluf_(z0.z); a.w *= siluf_(z0.w); c.x *= siluf_(z1.x); c.y *= siluf_(z1.y); c.z *= siluf_(z1.z); c.w *= siluf_(z1.w);
                    *(GAS v4u*)(OB + m * 512 + h * 128 + 32 * qd + 8 * i) = pack8(a, c); }
            } else { RAW_BAR(); }
            if (n < 32) { asm volatile("s_waitcnt vmcnt(0)" ::: "memory"); RAW_BAR(); }
        }
    }
}
constexpr int GLA_SPLIT = 10;
__device__ __forceinline__ void p2_recurrences(const Args& A, LAS unsigned char* lds, int c, int G, const XcdBarrier& bar) {
    float* out = A.out;
    if (c < 32) {
        const int b = c >> 2, h = c & 3, lane = threadIdx.x & 63;
        float wg[16];
#pragma unroll
        for (int r = 0; r < 16; ++r) wg[r] = A.in[9][r * 256 + h * 64 + lane];
        const float bgv = A.in[10][h * 64 + lane];
        GlaState st; st.S[0] = zero16(); st.S[1] = zero16();
#pragma unroll
        for (int i = 0; i < 4; ++i) st.Sb[i] = (bf16x8){0, 0, 0, 0, 0, 0, 0, 0};
        for (int n = 0; n < 32; ++n) { if (n == GLA_SPLIT && MK_N_LAUNCHES == 1) xcd_barrier(bar); gla_chunk(A, lds, b, h, n, st, wg, bgv); }
        gla_final(A, c, st);
    } else {
        for (int u = c - 32; u < 1024; u += G - 32) gdn_r1_unit(A, lds, u);
        if (MK_N_LAUNCHES == 1) xcd_barrier(bar);
        if (c < 64) gdn_r2_item(A, lds, c - 32);
        else { const int nw = G - 64;
            for (int it = c - 64; it < 1024; it += nw) {
                if (it < 512) { const int b = it >> 2, h = it & 3; gla_item(A, lds, b, h, DSQ, MP + b * DSQ, A.in[2] + (size_t)it * 64 * 128, out + OUT_GLA_S + (size_t)it * 64 * 128); }
                else { const int i = it - 512, b = i >> 2, h = i & 3; gdn_item(A, lds, b, h, DSQ, MP + b * DSQ, A.in[3] + (size_t)i * 128 * 128, out + OUT_GDN_S + (size_t)i * 128 * 128, A.in[4] + (size_t)b * 3 * 1536); }
            } }
    }
    const int gt = c * NTHREADS + threadIdx.x, NGT = G * NTHREADS;
    for (int i = gt; i < 8 * 3 * 1536; i += NGT) { const int ch = i % 1536, j = (i / 1536) % 3, b = i / (3 * 1536); const size_t m = (size_t)b * SEQ + SEQ - 3 + j;
        out[OUT_CONV_P + i] = bf2f(panel(A.ws, PN_QB + (ch >> 8))[m * 256 + (ch & 255)]); }
    for (int i = gt; i < 128 * 3 * 1536; i += NGT) { const int ch = i % 1536, j = (i / 1536) % 3, b = i / (3 * 1536); const size_t m = (size_t)MP + b * DSQ + DSQ - 3 + j;
        out[OUT_CONV_S + i] = bf2f(panel(A.ws, PN_QB + (ch >> 8))[m * 256 + (ch & 255)]); }
}
typedef pg8::f32x4 (&AccRef)[2][2][4][2];
typedef const pg8::f32x4 (&CAccRef)[2][2][4][2];

#define EPI_LOOP_BEGIN  const int row0 = u.pm * 256 + wr * 64 + fr, cin = wc * 32 + 8 * fq; \
    _Pragma("unroll") for (int ai = 0; ai < 2; ++ai) _Pragma("unroll") for (int m = 0; m < 4; ++m) { const size_t row = (size_t)(row0 + ai * 128 + m * 16); \
    _Pragma("unroll") for (int bj = 0; bj < 2; ++bj) { const int cp = bj * 128 + cin;   const f32x4 a0 = acc[ai][bj][m][0], a1 = acc[ai][bj][m][1];
#define EPI_LOOP_END } }

__device__ __forceinline__ bf16* panel_rw(unsigned char* ws, float* out, int pn) { return (pn < 14) ? (bf16*)(ws + WS_PROJ + (size_t)pn * SZ_PANEL) : (bf16*)((unsigned char*)out + (size_t)(pn - 14) * SZ_PANEL); }
struct EpiProj { static constexpr bool PERM = true; unsigned char* ws; float* out;
    __device__ __forceinline__ void operator()(CAccRef acc, const pg8::Unit& u, int wr, int wc, int fr, int fq) const {
        if (u.pn < PN_SPEC) { bf16* P = panel_rw(ws, out, u.pn);
            EPI_LOOP_BEGIN *(GAS v4u*)(P + row * 256 + cp) = pack8(a0, a1); EPI_LOOP_END }
        else { bf16* P = (bf16*)(ws + WS_SPEC);
            EPI_LOOP_BEGIN if (cp < 32) *(GAS v4u*)(P + row * 32 + cp) = pack8(a0, a1); EPI_LOOP_END }
    } };
struct EpiUpA { static constexpr bool PERM = true; unsigned char* ws; float* out;
    __device__ __forceinline__ void operator()(CAccRef acc, const pg8::Unit& u, int wr, int wc, int fr, int fq) const {
        const bf16* Gp = panel_rw(ws, out, PN_GA + u.pn); bf16* O = (bf16*)(ws + WS_MERGED);
        EPI_LOOP_BEGIN f32x4 g0, g1; unpack8(*(const GAS v4u*)(Gp + row * 256 + cp), g0, g1);
            *(GAS v4u*)(O + row * 1024 + u.pn * 256 + cp) = pack8(sig4(g0) * a0, sig4(g1) * a1); EPI_LOOP_END
    } };
struct EpiUpB { static constexpr bool PERM = true; unsigned char* ws; float* out;
    __device__ __forceinline__ void operator()(CAccRef acc, const pg8::Unit& u, int wr, int wc, int fr, int fq) const {
        const bf16* Gp = panel_rw(ws, out, PN_GB + u.pn); bf16* O = (bf16*)(ws + WS_MERGED);
        EPI_LOOP_BEGIN f32x4 g0, g1, y0, y1; unpack8(*(const GAS v4u*)(Gp + row * 256 + cp), g0, g1);
            GAS v4u* op = (GAS v4u*)(O + row * 1024 + u.pn * 256 + cp); unpack8(*op, y0, y1);
            *op = pack8(y0 + sig4(g0) * a0, y1 + sig4(g1) * a1); EPI_LOOP_END
    } };
struct EpiOut { static constexpr bool PERM = true; unsigned char* ws; const float* xp; const float* xs; float* out;
    __device__ __forceinline__ void operator()(CAccRef acc, const pg8::Unit& u, int wr, int wc, int fr, int fq) const {
        bf16* HB = (bf16*)(ws + WS_H1B);
        EPI_LOOP_BEGIN const size_t col = (size_t)u.pn * 256 + cp;
            const float* xr = (row < (size_t)MP) ? xp + row * 1024 + col : xs + (row - MP) * 1024 + col;
            const f32x4 h0 = *(const GAS f32x4*)xr + a0, h1 = *(const GAS f32x4*)(xr + 4) + a1;
            float* o = out + row * 1024 + col; *(GAS f32x4*)o = h0; *(GAS f32x4*)(o + 4) = h1;
            *(GAS v4u*)(HB + row * 1024 + col) = pack8(h0, h1); EPI_LOOP_END
    } };
struct EpiPe { static constexpr bool PERM = true; unsigned char* ws;
    __device__ __forceinline__ void operator()(CAccRef acc, const pg8::Unit& u, int wr, int wc, int fr, int fq) const {
        bf16* O = (bf16*)(ws + WS_PE);
        EPI_LOOP_BEGIN *(GAS v4u*)(O + row * 1024 + u.pn * 256 + cp) = pack8(a0, a1); EPI_LOOP_END
    } };
struct EpiGate { static constexpr bool PERM = true; unsigned char* ws; float* out;
    __device__ __forceinline__ void operator()(CAccRef acc, const pg8::Unit& u, int wr, int wc, int fr, int fq) const {
        const bf16* PEp = (const bf16*)(ws + WS_PE); float* RS = (float*)(ws + WS_RSSP);
        const int row0 = u.pm * 256 + wr * 64 + fr, cin = wc * 32 + 8 * fq;
#pragma unroll
        for (int ai = 0; ai < 2; ++ai)
#pragma unroll
            for (int m = 0; m < 4; ++m) { const size_t row = (size_t)(row0 + ai * 128 + m * 16); float ss = 0.f;
#pragma unroll
                for (int bj = 0; bj < 2; ++bj) { const size_t col = (size_t)u.pn * 256 + bj * 128 + cin; const f32x4 a0 = acc[ai][bj][m][0], a1 = acc[ai][bj][m][1];
                    f32x4 p0, p1; unpack8(*(const GAS v4u*)(PEp + row * 1024 + col), p0, p1);
                    float* o = out + row * 1024 + col;
                    const f32x4 h0 = *(const GAS f32x4*)o + sig4(a0) * p0, h1 = *(const GAS f32x4*)(o + 4) + sig4(a1) * p1;
                    *(GAS f32x4*)o = h0; *(GAS f32x4*)(o + 4) = h1;
                    ss += (h0.x * h0.x + h0.y * h0.y) + (h0.z * h0.z + h0.w * h0.w) + (h1.x * h1.x + h1.y * h1.y) + (h1.z * h1.z + h1.w * h1.w); }
                ss += __shfl_xor(ss, 16); ss += __shfl_xor(ss, 32);
                if (fq == 0) RS[row * 16 + u.pn * 4 + wc] = ss; }
    } };

__device__ __forceinline__ void p6_final_norm(const Args& A, int vcu, int G, int wave, int lane) {
    const int gw = vcu * NWAVES + wave, NGW = G * NWAVES;
    const float* RS = (const float*)(A.ws + WS_RSSP);
    const GAS f32x4* fw = (const GAS f32x4*)A.in[21] + lane;
    for (int m = gw; m < M; m += NGW) {
        float ss = 0.f;
#pragma unroll
        for (int i = 0; i < 16; ++i) ss += RS[(size_t)m * 16 + i];
        const float r = 1.f / sqrtf(ss * (1.f / D) + NORM_EPS);
        GAS f32x4* o = (GAS f32x4*)(A.out + (size_t)m * D) + lane;
#pragma unroll
        for (int j = 0; j < 4; ++j) { const f32x4 v = o[64 * j], w = fw[64 * j]; o[64 * j] = v * r * w; }
    }
}
#ifndef MK_N_LAUNCHES
#define MK_N_LAUNCHES 1
#endif
constexpr int N_PHASES = 7;
__global__ void __launch_bounds__(NTHREADS, 2) mk_fwd(Args args) {
    extern __shared__ __attribute__((aligned(16))) unsigned char lds_raw[];
    LAS unsigned char* lds = (LAS unsigned char*)lds_raw;
    volatile LAS unsigned* MISC = (volatile LAS unsigned*)(lds + MISC_OFF);
    const int tid = threadIdx.x, lane = tid & 63, wave = __builtin_amdgcn_readfirstlane(tid >> 6);
    const int G = gridDim.x, bx = blockIdx.x;
    const int vcu = (G % 8 == 0) ? (bx % 8) * (G / 8) + bx / 8 : bx;
    for (int u = tid; u < (LDS_BYTES - LDSCTL_OFF) / 4; u += NTHREADS) ((LAS unsigned*)(lds + LDSCTL_OFF))[u] = 0u;
    __syncthreads();
    unsigned char* ws = args.ws;
    XcdBarrier bar; bar.bar = (unsigned*)(ws + WS_CTL) + CW_BAR; bar.x = 0; bar.st = nullptr;
    if (MK_N_LAUNCHES == 1) bar = xcd_barrier_post((unsigned*)(ws + WS_CTL) + CW_BAR, MISC + 8);
    const int lo = args.ph_lo, hi = args.ph_hi;
#define IN(k) (lo <= (k) && (k) < hi)
#define SEAM(k) do { if (IN(k) && IN((k) + 1)) xcd_barrier(bar); } while (0)

    if (IN(0)) { p0_prologue(args, lds, vcu, G, wave, lane); }
    SEAM(0);
    if (IN(1)) {
        pg8::Gemm g{(const bf16*)(ws + WS_XN), (const bf16*)(ws + WS_WIN), M, NPROJ, 1024}; pg8::StaticOrder S; S.init(M, NPROJ, G, bx);
        EpiProj E{ws, args.out};
        pg8::gemm_phase<EpiProj, pg8::StaticOrder>(lds + RING_OFF, g, S, E);
    }
    SEAM(1);
    if (IN(2)) { p2_recurrences(args, lds, bx, G, bar); }
    SEAM(2);
    if (IN(3)) {
        pg8::StaticOrder S; S.init(M, 1024, G, bx);
        { pg8::Gemm g{(const bf16*)(ws + WS_OA), (const bf16*)(ws + WS_WUA), M, 1024, 512}; EpiUpA E{ws, args.out}; pg8::gemm_phase<EpiUpA, pg8::StaticOrder>(lds + RING_OFF, g, S, E); }
        { pg8::Gemm g{(const bf16*)(ws + WS_OB), (const bf16*)(ws + WS_WUB), M, 1024, 512}; EpiUpB E{ws, args.out}; pg8::gemm_phase<EpiUpB, pg8::StaticOrder>(lds + RING_OFF, g, S, E); }
    }
    SEAM(3);
    if (IN(4)) {
        pg8::StaticOrder S; S.init(M, 1024, G, bx);
        pg8::Gemm g{(const bf16*)(ws + WS_MERGED), (const bf16*)(ws + WS_WO), M, 1024, 1024}; EpiOut E{ws, args.in[0], args.in[1], args.out};
        pg8::gemm_phase<EpiOut, pg8::StaticOrder>(lds + RING_OFF, g, S, E);
    }
    SEAM(4);
    if (IN(5)) {
        pg8::StaticOrder S; S.init(M, 1024, G, bx);
        { pg8::Gemm g{(const bf16*)(ws + WS_PB), (const bf16*)(ws + WS_WP), M, 1024, 256}; EpiPe E{ws}; pg8::gemm_phase<EpiPe, pg8::StaticOrder>(lds + RING_OFF, g, S, E); }
        { pg8::Gemm g{(const bf16*)(ws + WS_H1B), (const bf16*)(ws + WS_WG), M, 1024, 1024}; EpiGate E{ws, args.out}; pg8::gemm_phase<EpiGate, pg8::StaticOrder>(lds + RING_OFF, g, S, E); }
    }
    SEAM(5);
    if (IN(6)) { p6_final_norm(args, vcu, G, wave, lane); }
#undef IN
#undef SEAM
}

extern "C" void kernel_launch(void* const* d_in, const int* in_sizes, int n_in, void* d_out, int out_size, void* d_ws, size_t ws_size, hipStream_t stream) {
    static int grid = 0;
    if (grid == 0) {
        if (n_in != 22 || in_sizes[0] != MP * D || (size_t)out_size != OUT_TOTAL || ws_size < WS_END) {
            fprintf(stderr, "kernel_launch: unexpected shapes: n_in %d in0 %d out %d ws %zu (need %zu)\n", n_in, n_in > 0 ? in_sizes[0] : -1, out_size, ws_size, (size_t)WS_END); grid = -1; return; }
        int dev = 0, cus = 0, per_cu = 0;
        if (hipGetDevice(&dev) != hipSuccess || hipDeviceGetAttribute(&cus, hipDeviceAttributeMultiprocessorCount, dev) != hipSuccess) { grid = -1; return; }
        if (hipFuncSetAttribute((const void*)mk_fwd, hipFuncAttributeMaxDynamicSharedMemorySize, LDS_BYTES) != hipSuccess) { fprintf(stderr, "kernel_launch: hipFuncSetAttribute failed\n"); grid = -1; return; }
        if (hipOccupancyMaxActiveBlocksPerMultiprocessor(&per_cu, (const void*)mk_fwd, NTHREADS, LDS_BYTES) != hipSuccess || per_cu < 1) {
            fprintf(stderr, "kernel_launch: occupancy query reports %d workgroups per CU\n", per_cu); (void)hipGetLastError(); grid = -1; return; }
        grid = cus;
    }
    if (grid < 0) return;
    (void)hipMemsetAsync((char*)d_ws + WS_CTL, 0, CTL_ZERO_BYTES, stream);
    Args a{};
    for (int i = 0; i < 22; ++i) a.in[i] = (const float*)d_in[i];
    a.out = (float*)d_out; a.ws = (unsigned char*)d_ws;
#if MK_N_LAUNCHES == 1
    a.ph_lo = 0; a.ph_hi = N_PHASES;
    hipLaunchKernelGGL(mk_fwd, dim3(grid), dim3(NTHREADS), LDS_BYTES, stream, a);
#else
    for (int p = 0; p < N_PHASES; ++p) { a.ph_lo = p; a.ph_hi = p + 1; hipLaunchKernelGGL(mk_fwd, dim3(grid), dim3(NTHREADS), LDS_BYTES, stream, a); }
#endif
}
```

```cpp
#include <hip/hip_runtime.h>
#include <cstdio>
#include <cstdint>
#define MK_N_LAUNCHES 1
#define PROBE_DUP -1
namespace pg8 {
#define PG8_LAS __attribute__((address_space(3)))
typedef unsigned short bf16_t;
typedef short bf16x8 __attribute__((ext_vector_type(8)));
typedef float f32x4 __attribute__((ext_vector_type(4)));
typedef unsigned u32x4 __attribute__((ext_vector_type(4)));
constexpr int BM = 256, BK = 64, HALF = 128, HTB = HALF * BK * 2  , STAGE_BYTES = 8 * HTB, NXCD = 8, WGM = 8;

__host__ __device__ __forceinline__ int lds_byte(int r, int c) { const int st = (r >> 4) * 2 + (c >> 5), rr = r & 15, cc = c & 31, ob = rr * 64 + cc * 2; return st * 1024 + (ob ^ (((ob >> 9) & 1) << 5)); }
__host__ __device__ __forceinline__ void stage_rc(int b, int& R, int& C) { const int st = b / 1024, sb = b % 1024, swz = sb ^ (((sb >> 9) & 1) << 5); R = (st >> 1) * 16 + swz / 64; C = (st & 1) * 32 + (swz % 64) / 2; }
__host__ __device__ __forceinline__ int perm32(int rho) { const int n = rho >> 4, i = rho & 15; return 8 * (i >> 2) + 4 * n + (i & 3); }

struct Unit { int pm, pn; };
struct Gemm { const bf16_t* A; const bf16_t* Bt; int M, N, K; };

struct StaticOrder {
    int nM, nN, nwg, G, c;
    __host__ __device__ void init(int M, int N, int G_, int c_) { nM = M / BM; nN = N / BM; nwg = nM * nN; G = G_; c = c_; }
    __host__ __device__ bool next(int i, Unit& u) const {
        const long L = (long)i * G + c; if (L >= nwg) return false;
        int wgid = (int)L; { const int q = nwg / NXCD, r = nwg % NXCD, xcd = wgid % NXCD, off = wgid / NXCD; wgid = (xcd < r ? xcd * (q + 1) : r * (q + 1) + (xcd - r) * q) + off; }
        const int nig = WGM * nN, gid = wgid / nig, fm = gid * WGM, gsz = (nM - fm) < WGM ? (nM - fm) : WGM;
        u.pm = fm + ((wgid % nig) % gsz); u.pn = (wgid % nig) / gsz; return true;
    }
    __device__ __forceinline__ void a_ready(const Unit&) const {}
    __device__ __forceinline__ void done(const Unit&) const {}
};

typedef __bf16 bf16x2_t __attribute__((ext_vector_type(2)));
typedef float f32x2_t __attribute__((ext_vector_type(2)));
__device__ __forceinline__ unsigned cvt_pk_bf16(float lo, float hi) { const f32x2_t v = {lo, hi}; return __builtin_bit_cast(unsigned, __builtin_convertvector(v, bf16x2_t)); }

template <class Epi, class Sched>
__device__ __forceinline__ void gemm_phase(PG8_LAS unsigned char* lds, const Gemm g, const Sched& S, const Epi& E) {
    const int tid = threadIdx.x, wid = __builtin_amdgcn_readfirstlane(tid >> 6), lane = tid & 63, wr = wid >> 2, wc = wid & 3, fr = lane & 15, fq = lane >> 4;
    const int K = g.K, nt = K / BK;
    unsigned voffA[2], voffB[2];
#pragma unroll
    for (int i = 0; i < 2; ++i) { int R, C; stage_rc(tid * 16 + i * 8192, R, C); const int Rb = Epi::PERM ? ((R & ~31) + perm32(R & 31)) : R;
        voffA[i] = (unsigned)(R * K + C) * 2u; voffB[i] = (unsigned)(Rb * K + C) * 2u; }
    const size_t kstep = (size_t)(BK * 2);
    const size_t hstep = (size_t)HALF * K * 2;
    const size_t tstep = 2 * hstep;
    const unsigned ldsw = (unsigned)wid * 1024u;
    const int aoff = lds_byte(wr * 64 + fr, fq * 8), boff = lds_byte(wc * 32 + fr, fq * 8);
#define PG8_SA(b, h) (((b) * 2 + (h)) * HTB)
#define PG8_SB(b, h) ((4 + (b) * 2 + (h)) * HTB)
#define PG8_STAGE(bufoff, gbase, voff) do { _Pragma("unroll") for (int _i = 0; _i < 2; ++_i) \
        __builtin_amdgcn_global_load_lds((const unsigned*)((const char*)(gbase) + (voff)[_i]), (PG8_LAS unsigned*)(lds + (bufoff) + ldsw + _i * 8192), 16, 0, 0); } while (0)
#define PG8_LDA(dst, b, h) do { _Pragma("unroll") for (int m = 0; m < 4; ++m) _Pragma("unroll") for (int k = 0; k < 2; ++k) dst[m][k] = *(const PG8_LAS bf16x8*)(lds + PG8_SA(b, h) + aoff + m * 2048 + k * 1024); } while (0)
#define PG8_LDB(dst, b, h) do { _Pragma("unroll") for (int n = 0; n < 2; ++n) _Pragma("unroll") for (int k = 0; k < 2; ++k) dst[n][k] = *(const PG8_LAS bf16x8*)(lds + PG8_SB(b, h) + boff + n * 2048 + k * 1024); } while (0)
#define PG8_MMA(ai, bj, At, Bt) do { __builtin_amdgcn_s_setprio(1); _Pragma("unroll") for (int m = 0; m < 4; ++m) _Pragma("unroll") for (int n = 0; n < 2; ++n) _Pragma("unroll") for (int k = 0; k < 2; ++k) \
        acc[ai][bj][m][n] = __builtin_amdgcn_mfma_f32_16x16x32_bf16(Bt[n][k], At[m][k], acc[ai][bj][m][n], 0, 0, 0); __builtin_amdgcn_s_setprio(0); } while (0)
#define PG8_WAIT_V(n) asm volatile("s_waitcnt vmcnt(" #n ")" ::: "memory")
#define PG8_WAIT_L(n) asm volatile("s_waitcnt lgkmcnt(" #n ")" ::: "memory")
#define PG8_BAR __builtin_amdgcn_s_barrier()
#define PG8_SCHED __builtin_amdgcn_sched_barrier(0)
    Unit cur, nxt; int ui = 0;
    if (!S.next(0, cur)) return;
    f32x4 acc[2][2][4][2];
#pragma unroll
    for (int a = 0; a < 2; ++a)
#pragma unroll
        for (int b = 0; b < 2; ++b)
#pragma unroll
            for (int m = 0; m < 4; ++m)
#pragma unroll
                for (int n = 0; n < 2; ++n) acc[a][b][m][n] = (f32x4){0.f, 0.f, 0.f, 0.f};
    bf16x8 At[4][2], B0[2][2], B1[2][2];
    const char* cA = (const char*)g.A + (size_t)cur.pm * tstep; const char* cB = (const char*)g.Bt + (size_t)cur.pn * tstep;
    S.a_ready(cur);
    PG8_STAGE(PG8_SB(0, 0), cB, voffB); PG8_STAGE(PG8_SA(0, 0), cA, voffA); PG8_STAGE(PG8_SB(0, 1), cB + hstep, voffB); PG8_STAGE(PG8_SA(0, 1), cA + hstep, voffA);
    if (wr == 1) PG8_BAR;
    PG8_WAIT_V(4); PG8_BAR;
    PG8_STAGE(PG8_SB(1, 0), cB + kstep, voffB); PG8_STAGE(PG8_SA(1, 0), cA + kstep, voffA); PG8_STAGE(PG8_SB(1, 1), cB + hstep + kstep, voffB);
    PG8_WAIT_V(6); PG8_BAR;
    for (;;) {
        const bool has_next = S.next(ui + 1, nxt);
        const char* nA = has_next ? (const char*)g.A + (size_t)nxt.pm * tstep : cA; const char* nB = has_next ? (const char*)g.Bt + (size_t)nxt.pn * tstep : cB;
        for (int t = 0; t < nt; t += 2) {
            const bool last = (t == nt - 2);
            const char* a1 = cA + (size_t)(t + 1) * kstep;
            const char* a2 = last ? nA : cA + (size_t)(t + 2) * kstep; const char* b2 = last ? nB : cB + (size_t)(t + 2) * kstep;
            const char* a3 = a2 + kstep; const char* b3 = b2 + kstep;
            if (last && has_next) S.a_ready(nxt);
            PG8_LDB(B0, 0, 0); PG8_SCHED; PG8_LDA(At, 0, 0); PG8_STAGE(PG8_SA(1, 1), a1 + hstep, voffA);
            PG8_WAIT_L(8); PG8_BAR; PG8_WAIT_L(0); PG8_MMA(0, 0, At, B0); PG8_BAR; PG8_SCHED;
            PG8_LDB(B1, 0, 1); PG8_STAGE(PG8_SB(0, 0), b2, voffB);
            PG8_BAR; PG8_WAIT_L(0); PG8_MMA(0, 1, At, B1); PG8_BAR;
            PG8_LDA(At, 0, 1); PG8_STAGE(PG8_SA(0, 0), a2, voffA);
            PG8_BAR; PG8_WAIT_L(0); PG8_MMA(1, 0, At, B0); PG8_BAR; PG8_SCHED;
            PG8_STAGE(PG8_SB(0, 1), b2 + hstep, voffB);
            PG8_WAIT_V(6); PG8_BAR; PG8_MMA(1, 1, At, B1); PG8_BAR;
            PG8_LDB(B0, 1, 0); PG8_SCHED; PG8_LDA(At, 1, 0); PG8_STAGE(PG8_SA(0, 1), a2 + hstep, voffA);
            PG8_WAIT_L(8); PG8_BAR; PG8_WAIT_L(0); PG8_MMA(0, 0, At, B0); PG8_BAR; PG8_SCHED;
            PG8_LDB(B1, 1, 1); PG8_STAGE(PG8_SB(1, 0), b3, voffB);
            PG8_BAR; PG8_WAIT_L(0); PG8_MMA(0, 1, At, B1); PG8_BAR;
            PG8_LDA(At, 1, 1); PG8_STAGE(PG8_SA(1, 0), a3, voffA);
            PG8_BAR; PG8_WAIT_L(0); PG8_MMA(1, 0, At, B0); PG8_BAR; PG8_SCHED;
            PG8_STAGE(PG8_SB(1, 1), b3 + hstep, voffB);
            PG8_WAIT_V(6); PG8_BAR; PG8_MMA(1, 1, At, B1); PG8_BAR;
        }
        E(acc, cur, wr, wc, fr, fq); S.done(cur);
        if (!has_next) break;
#pragma unroll
        for (int a = 0; a < 2; ++a)
#pragma unroll
            for (int b = 0; b < 2; ++b)
#pragma unroll
                for (int m = 0; m < 4; ++m)
#pragma unroll
                    for (int n = 0; n < 2; ++n) acc[a][b][m][n] = (f32x4){0.f, 0.f, 0.f, 0.f};
        cur = nxt; cA = nA; cB = nB; ++ui;
    }
    PG8_WAIT_V(0);
    if (wr == 0) PG8_BAR;
    PG8_BAR;
#undef PG8_SA
#undef PG8_SB
#undef PG8_STAGE
#undef PG8_LDA
#undef PG8_LDB
#undef PG8_MMA
#undef PG8_WAIT_V
#undef PG8_WAIT_L
#undef PG8_BAR
#undef PG8_SCHED
}
}
struct Args { const float* in[22]; float* out; unsigned char* ws; int ph_lo, ph_hi; };
constexpr int D = 1024, SEQ = 2048, NB = 8, MP = NB * SEQ, DB = 128, DSQ = 8, MS = DB * DSQ, M = MP + MS;
constexpr int NPANEL = 23, NPROJ = NPANEL * 256;
constexpr float NORM_EPS = 1e-6f;
constexpr int GLA_DK = 64, GLA_DV = 128, GDN_DK = 128, GDN_DV = 128, CONV_CH = 1536;

constexpr size_t MiB = 1u << 20;
constexpr size_t SZ_PANEL = (size_t)M * 256 * 2;
constexpr size_t WS_CTL = 0, CTL_ZERO_BYTES = 128 * 1024;
constexpr size_t WS_WIN = 1 * MiB;
constexpr size_t WS_WUA = WS_WIN + (size_t)NPROJ * 1024 * 2;
constexpr size_t WS_WUB = WS_WUA + 1 * MiB;
constexpr size_t WS_WO = WS_WUB + 1 * MiB;
constexpr size_t WS_WG = WS_WO + 2 * MiB;
constexpr size_t WS_WP = WS_WG + 2 * MiB;
constexpr size_t WS_SPEC = WS_WP + MiB / 2;
constexpr size_t WS_RSSP = WS_SPEC + (size_t)M * 32 * 2;
constexpr size_t WS_CDEC = WS_RSSP + (size_t)M * 16 * 4;
constexpr size_t WS_PB = WS_CDEC + 4096;
constexpr size_t WS_XN = WS_PB + SZ_PANEL;
constexpr size_t WS_PROJ = WS_XN + (size_t)M * 1024 * 2;
constexpr size_t WS_REC = WS_PROJ + 14 * SZ_PANEL;
constexpr size_t WS_END = WS_REC + (size_t)1024 * 73728;
static_assert(WS_END <= 256 * MiB, "workspace map exceeds 256 MiB");
static_assert(WS_WIN % 256 == 0 && WS_SPEC % 256 == 0 && WS_RSSP % 256 == 0 && WS_PB % 256 == 0 && WS_XN % 256 == 0 && WS_PROJ % 256 == 0 && WS_REC % 256 == 0, "alignment");
constexpr size_t WS_OA = WS_XN, WS_OB = WS_XN + (size_t)M * 512 * 2;
constexpr size_t WS_MERGED = WS_PROJ + 0 * SZ_PANEL;
constexpr size_t WS_H1B = WS_PROJ + 6 * SZ_PANEL;
constexpr size_t WS_PE = WS_PROJ + 10 * SZ_PANEL;
constexpr int PN_QA = 0, PN_KA = 1, PN_VA = 2, PN_ZA = 4, PN_QB = 6, PN_KB = 8, PN_VB = 10, PN_ZB = 12, PN_GA = 14, PN_GB = 18, PN_SPEC = 22;
constexpr size_t OUT_Y = 0, OUT_GLA_P = (size_t)M * D, OUT_GDN_P = OUT_GLA_P + 8 * 4 * 64 * 128, OUT_CONV_P = OUT_GDN_P + 8 * 4 * 128 * 128,
                 OUT_GLA_S = OUT_CONV_P + 8 * 3 * 1536, OUT_GDN_S = OUT_GLA_S + (size_t)128 * 4 * 64 * 128, OUT_CONV_S = OUT_GDN_S + (size_t)128 * 4 * 128 * 128,
                 OUT_TOTAL = OUT_CONV_S + 128 * 3 * 1536;
constexpr int CW_BAR = 1024;

constexpr int RING_OFF = 0, RING_BYTES = 131072;
constexpr int LDS_BYTES = 147456;
constexpr int LDSCTL_OFF = LDS_BYTES - 512, MISC_OFF = LDSCTL_OFF + 320;
constexpr int NWAVES = 8, NTHREADS = 512;

#define GAS __attribute__((address_space(1)))
#define LAS __attribute__((address_space(3)))
typedef unsigned short bf16;
typedef unsigned v4u __attribute__((ext_vector_type(4)));
typedef unsigned v2u __attribute__((ext_vector_type(2)));
typedef float f32x4 __attribute__((ext_vector_type(4)));
typedef GAS unsigned gu32;
#define RLX_AGENT __ATOMIC_RELAXED, __HIP_MEMORY_SCOPE_AGENT
#define LDS_WAIT() asm volatile("s_waitcnt lgkmcnt(0)" ::: "memory")
#define VM_WAIT() asm volatile("s_waitcnt vmcnt(0)" ::: "memory")
__device__ __forceinline__ unsigned f2bf(float f) { unsigned u = __builtin_bit_cast(unsigned, f); return (u + 0x7fffu + ((u >> 16) & 1u)) >> 16; }
__device__ __forceinline__ unsigned pk2(float lo, float hi) { return f2bf(lo) | (f2bf(hi) << 16); }
__device__ __forceinline__ float bf2f(unsigned short b) { return __builtin_bit_cast(float, (unsigned)b << 16); }
__device__ __forceinline__ float bflo(unsigned w) { return __builtin_bit_cast(float, w << 16); }
__device__ __forceinline__ float bfhi(unsigned w) { return __builtin_bit_cast(float, w & 0xffff0000u); }
__device__ __forceinline__ float sigmoidf_(float x) { return 1.f / (1.f + __expf(-x)); }
__device__ __forceinline__ float siluf_(float x) { return x / (1.f + __expf(-x)); }
__device__ __forceinline__ float softplusf_(float x) { return fmaxf(x, 0.f) + log1pf(__expf(-fabsf(x))); }
__device__ __forceinline__ float wave_sum(float v) {
#pragma unroll
    for (int o = 1; o < 64; o <<= 1) v += __shfl_xor(v, o);
    return v;
}

#define XB_TMO      128
#define XB_XCNT(j)  (256  + 64 * (j))
#define XB_XSUB(j)  (1280 + 64 * (j))
#define XB_XGEN(j)  (2304 + 64 * (j))
#define XB_TOP      3328
#define XB_TOPGEN   3392
#define XCD_BAR_WORDS 3456
#define XB_SPIN_CAP (1u << 18)
__device__ __forceinline__ unsigned xb_ld(unsigned* p)              { return __hip_atomic_load(p, __ATOMIC_RELAXED, __HIP_MEMORY_SCOPE_AGENT); }
__device__ __forceinline__ unsigned xb_add(unsigned* p, unsigned v) { return __hip_atomic_fetch_add(p, v, __ATOMIC_RELAXED, __HIP_MEMORY_SCOPE_AGENT); }
__device__ __forceinline__ unsigned xb_xcc_id() { return (unsigned)__builtin_amdgcn_s_getreg((3 << 11) | 20) & 0xFu; }
#define XB_SPIN(cond, bar) do { unsigned _sp = 0; while (cond) { __builtin_amdgcn_s_sleep(1); \
    if ((++_sp & 255u) == 0u) { if (xb_ld(&(bar)[XB_TMO])) break; if (_sp > XB_SPIN_CAP) { atomicAdd(&(bar)[XB_TMO], 1u); break; } } } } while (0)
struct XcdBarrier { unsigned* bar; unsigned x; volatile LAS unsigned* st; };
__device__ __forceinline__ XcdBarrier xcd_barrier_post(unsigned* bar, volatile LAS unsigned* st) {
    XcdBarrier b; b.bar = bar; b.x = xb_xcc_id(); b.st = st;
    if (threadIdx.x == 0) (void)xb_add(&bar[XB_XCNT(b.x)], 1u);
    return b;
}
__device__ __forceinline__ void xcd_barrier_complete(unsigned* bar, unsigned x, unsigned& nloc, unsigned& nx) {
    const unsigned G = gridDim.x * gridDim.y * gridDim.z;
    unsigned sum, cnt, mine, sp = 0u;
    for (;;) {
        sum = 0u; cnt = 0u; mine = 0u;
#pragma unroll
        for (unsigned j = 0; j < 16; ++j) { const unsigned c = xb_ld(&bar[XB_XCNT(j)]); sum += c; cnt += (c > 0u) ? 1u : 0u; mine = (j == x) ? c : mine; }
        if (sum == G) break;
        __builtin_amdgcn_s_sleep(1);
        if ((++sp & 255u) == 0u) { if (xb_ld(&bar[XB_TMO])) break; if (sp > XB_SPIN_CAP) { atomicAdd(&bar[XB_TMO], 1u); break; } }
    }
    nloc = mine > 0u ? mine : 1u; nx = cnt > 0u ? cnt : 1u;
}
__device__ __forceinline__ void xcd_barrier(const XcdBarrier& b) {
    asm volatile("s_waitcnt vmcnt(0)" ::: "memory");
    __syncthreads();
    if (threadIdx.x == 0) {
        unsigned* bar = b.bar;
        __builtin_amdgcn_s_waitcnt(0);
        unsigned nloc = b.st[0], nx = b.st[1];
        if (nloc == 0u) { xcd_barrier_complete(bar, b.x, nloc, nx); b.st[0] = nloc; b.st[1] = nx; }
        const unsigned old = xb_add(&bar[XB_XSUB(b.x)], 1u);
        const unsigned gen = old / nloc;
        if (old + 1u == (gen + 1u) * nloc) {
            __builtin_amdgcn_fence(__ATOMIC_RELEASE, "agent");
            asm volatile("s_waitcnt vmcnt(0)" ::: "memory");
            const unsigned og = xb_add(&bar[XB_TOP], 1u);
            const unsigned tg = og / nx;
            if (og + 1u == (tg + 1u) * nx) xb_add(&bar[XB_TOPGEN], 1u);
            else XB_SPIN(xb_ld(&bar[XB_TOPGEN]) == tg, bar);
            __builtin_amdgcn_fence(__ATOMIC_ACQUIRE, "agent");
            xb_add(&bar[XB_XGEN(b.x)], 1u);
            asm volatile("s_waitcnt vmcnt(0)" ::: "memory");
        } else {
            XB_SPIN(xb_ld(&bar[XB_XGEN(b.x)]) == gen, bar);
            __builtin_amdgcn_fence(__ATOMIC_ACQUIRE, "agent");
            asm volatile("s_waitcnt vmcnt(0)" ::: "memory");
        }
    }
    __syncthreads();
}

struct Frame {
    LAS unsigned char* lds;
    volatile LAS unsigned* MISC;
    int tid, lane, wave, G, vcu;
    const float* in[22];
    float* out;
    unsigned char* ws;
};
__device__ __forceinline__ int win_src_col(int n) {
    if (n < 1024) return n;
    if (n < 3072) return n + 16;
    if (n < 5632) return n + 24;
    if (n < 5648) return 1024 + (n - 5632);
    if (n < 5656) return 3088 + (n - 5648);
    return -1;
}
template <bool MAPCOL>
__device__ __forceinline__ void p0_transpose_item(const float* W, int K, int Nsrc, int Ndst, bf16* WT, LAS float* scr, int item, int lane) {
    const int nblk = Ndst / 32, kb = item / nblk, nb = item % nblk, k0 = 64 * kb, n0 = 32 * nb;
    int sc = n0 + (lane & 31); if (MAPCOL) sc = win_src_col(sc);
#pragma unroll 8
    for (int i = 0; i < 32; ++i) { const int kk = 2 * i + (lane >> 5); scr[kk * 33 + (lane & 31)] = (sc >= 0) ? W[(size_t)(k0 + kk) * Nsrc + sc] : 0.f; }
    LDS_WAIT(); asm volatile("" ::: "memory");
    const int c = lane & 7;
#pragma unroll
    for (int j = 0; j < 4; ++j) { const int n = (lane >> 3) + 8 * j; const LAS float* s = scr + (8 * c) * 33 + n;
        v4u o; o.x = pk2(s[0 * 33], s[1 * 33]); o.y = pk2(s[2 * 33], s[3 * 33]); o.z = pk2(s[4 * 33], s[5 * 33]); o.w = pk2(s[6 * 33], s[7 * 33]);
        *(GAS v4u*)(WT + (size_t)(n0 + n) * K + k0 + 8 * c) = o; }
    LDS_WAIT(); asm volatile("" ::: "memory");
}
__device__ __forceinline__ void rms_row_to_bf16(const float* xrow, const float* w, bf16* orow, int lane) {
    const GAS f32x4* xr = (const GAS f32x4*)xrow + lane;
    const GAS f32x4* wr = (const GAS f32x4*)w + lane;
    f32x4 v[4]; float s = 0.f;
#pragma unroll
    for (int j = 0; j < 4; ++j) { v[j] = xr[64 * j]; s += (v[j].x * v[j].x + v[j].y * v[j].y) + (v[j].z * v[j].z + v[j].w * v[j].w); }
    const float r = 1.f / sqrtf(wave_sum(s) * (1.f / D) + NORM_EPS);
    GAS unsigned long long* o8 = (GAS unsigned long long*)orow + lane;
#pragma unroll
    for (int j = 0; j < 4; ++j) { const f32x4 ww = wr[64 * j];
        o8[64 * j] = (unsigned long long)pk2(v[j].x * r * ww.x, v[j].y * r * ww.y) | ((unsigned long long)pk2(v[j].z * r * ww.z, v[j].w * r * ww.w) << 32); }
}
__device__ __forceinline__ void p0_prologue(const Args& A, LAS unsigned char* lds, int vcu, int G, int wave, int lane) {
    LAS float* scr = (LAS float*)(lds + RING_OFF + wave * 16384);
    const int gw = vcu * NWAVES + wave, NGW = G * NWAVES;
    unsigned char* ws = A.ws;
    constexpr int I_IN = (1024 / 64) * (NPROJ / 32), I_UP = (512 / 64) * (1024 / 32), I_SQ = (1024 / 64) * (1024 / 32), I_PL = (256 / 64) * (1024 / 32);
    constexpr int NITEMS = I_IN + 2 * I_UP + 2 * I_SQ + I_PL;
    for (int it = gw; it < NITEMS; it += NGW) {
        int r = it;
        if (r < I_IN) { p0_transpose_item<true>(A.in[8], 1024, 5656, NPROJ, (bf16*)(ws + WS_WIN), scr, r, lane); continue; } r -= I_IN;
        if (r < I_UP) { p0_transpose_item<false>(A.in[16], 512, 1024, 1024, (bf16*)(ws + WS_WUA), scr, r, lane); continue; } r -= I_UP;
        if (r < I_UP) { p0_transpose_item<false>(A.in[17], 512, 1024, 1024, (bf16*)(ws + WS_WUB), scr, r, lane); continue; } r -= I_UP;
        if (r < I_SQ) { p0_transpose_item<false>(A.in[18], 1024, 1024, 1024, (bf16*)(ws + WS_WO), scr, r, lane); continue; } r -= I_SQ;
        if (r < I_SQ) { p0_transpose_item<false>(A.in[19], 1024, 1024, 1024, (bf16*)(ws + WS_WG), scr, r, lane); continue; } r -= I_SQ;
        p0_transpose_item<false>(A.in[20], 256, 1024, 1024, (bf16*)(ws + WS_WP), scr, r, lane);
    }
    bf16* XN = (bf16*)(ws + WS_XN);
    for (int m = gw; m < M; m += NGW) {
        const float* xrow = (m < MP) ? A.in[0] + (size_t)m * D : A.in[1] + (size_t)(m - MP) * D;
        rms_row_to_bf16(xrow, A.in[7], XN + (size_t)m * D, lane);
    }
    bf16* PB = (bf16*)(ws + WS_PB);
    const int gt = gw * 64 + lane, NGT = NGW * 64;
    for (int i = gt; i < M * 256 / 8; i += NGT) {
        const size_t e = (size_t)i * 8; const int m = (int)(e >> 8), c = (int)(e & 255);
        const float* src = (m < MP) ? A.in[5] + (size_t)m * 256 + c : A.in[6] + (size_t)(m - MP) * 256 + c;
        const f32x4 a = *(const GAS f32x4*)src, b = *(const GAS f32x4*)(src + 4);
        v4u o; o.x = pk2(a.x, a.y); o.y = pk2(a.z, a.w); o.z = pk2(b.x, b.y); o.w = pk2(b.z, b.w);
        *(GAS v4u*)(PB + e) = o;
    }
}
__device__ __forceinline__ const bf16* panel(const unsigned char* ws, int pn) { return (const bf16*)(ws + WS_PROJ + (size_t)pn * SZ_PANEL); }
#ifdef PROBE_WG
#define STAMP3(k) do { if (threadIdx.x == 0) ((unsigned long long*)(A.ws + WS_CTL + 65536))[(size_t)blockIdx.x * 16 + (k)] = __builtin_amdgcn_s_memrealtime(); } while (0)
#else
#define STAMP3(k) do { } while (0)
#endif
#define LBAR() do { asm volatile("s_waitcnt lgkmcnt(0)" ::: "memory"); __builtin_amdgcn_s_barrier(); asm volatile("" ::: "memory"); } while (0)
template <int CTRL> __device__ __forceinline__ float dpp_f(float v) { return __builtin_bit_cast(float, __builtin_amdgcn_update_dpp(0, __builtin_bit_cast(int, v), CTRL, 0xf, 0xf, true)); }
__device__ __forceinline__ float rl_f(float v, int l) { return __builtin_bit_cast(float, __builtin_amdgcn_readlane(__builtin_bit_cast(int, v), l)); }
__device__ __forceinline__ float wsum(float v) {
    v += dpp_f<0xB1>(v); v += dpp_f<0x4E>(v); v += dpp_f<0x141>(v); v += dpp_f<0x140>(v);
    return (rl_f(v, 0) + rl_f(v, 16)) + (rl_f(v, 32) + rl_f(v, 48));
}
__device__ __forceinline__ float quad_sum(float v) { v += dpp_f<0xB1>(v); v += dpp_f<0x4E>(v); return v; }

__device__ __forceinline__ void gla_item_s(const Args& A, LAS unsigned char* lds, int h, int m0, const float* S0, float* Sout) {
    const int tid = threadIdx.x, lane = tid & 63, wave = tid >> 6;
    const unsigned char* ws = A.ws;
    LAS float* sq = (LAS float*)lds; LAS float* sk = sq + 512; LAS float* sd = sk + 512; LAS float* sv = sd + 512; LAS float* part = sv + 1024; LAS float* oraw = part + 1024;
    const int dv = tid & 127, g = tid >> 7;
    float S[16];
#pragma unroll
    for (int i = 0; i < 16; ++i) S[i] = S0[(size_t)(g * 16 + i) * 128 + dv];
    const bf16* PQ = panel(ws, PN_QA); const bf16* PK = panel(ws, PN_KA); const bf16* PV = panel(ws, PN_VA + (h >> 1)); const bf16* PZ = panel(ws, PN_ZA + (h >> 1));
    const bf16* SPEC = (const bf16*)(ws + WS_SPEC);
    const size_t mt = (size_t)m0 + wave;
    const unsigned short qh = PQ[mt * 256 + h * 64 + lane], kh = PK[mt * 256 + h * 64 + lane];
    const unsigned vw = *(const GAS unsigned*)(PV + mt * 256 + (h & 1) * 128 + 2 * lane);
    const unsigned zw = *(const GAS unsigned*)(PZ + mt * 256 + (h & 1) * 128 + 2 * lane);
    const v4u ga0 = *(const GAS v4u*)(SPEC + mt * 32), ga1 = *(const GAS v4u*)(SPEC + mt * 32 + 8);
    float wg[16];
#pragma unroll
    for (int r = 0; r < 16; ++r) wg[r] = A.in[9][r * 256 + h * 64 + lane];
    const float bgv = A.in[10][h * 64 + lane];
    const float nw0 = A.in[11][2 * lane], nw1 = A.in[11][2 * lane + 1];
    { float x = bgv; const unsigned gw[8] = {ga0.x, ga0.y, ga0.z, ga0.w, ga1.x, ga1.y, ga1.z, ga1.w};
#pragma unroll
      for (int r = 0; r < 8; ++r) x += bflo(gw[r]) * wg[2 * r] + bfhi(gw[r]) * wg[2 * r + 1];
      const float ls = fminf(x, 0.f) - log1pf(__expf(-fabsf(x)));
      sd[wave * 64 + lane] = __expf(ls * (1.f / 16.f)); sq[wave * 64 + lane] = bf2f(qh) * 0.125f; sk[wave * 64 + lane] = bf2f(kh);
      sv[wave * 128 + 2 * lane] = bflo(vw); sv[wave * 128 + 2 * lane + 1] = bfhi(vw); }
    LBAR();
#pragma unroll 1
    for (int tk = 0; tk < 8; ++tk) {
        const float vv = sv[tk * 128 + dv];
        float po = 0.f;
#pragma unroll
        for (int i = 0; i < 16; ++i) { const int dk = g * 16 + i; S[i] = sd[tk * 64 + dk] * S[i] + sk[tk * 64 + dk] * vv; po += sq[tk * 64 + dk] * S[i]; }
        part[((tk & 1) * 4 + g) * 128 + dv] = po;
        LBAR();
        if (g == 0) { const LAS float* pp = part + (tk & 1) * 512 + dv; oraw[tk * 128 + dv] = (pp[0] + pp[128]) + (pp[256] + pp[384]); }
    }
#pragma unroll
    for (int i = 0; i < 16; ++i) Sout[(size_t)(g * 16 + i) * 128 + dv] = S[i];
    LBAR();
    { bf16* OA = (bf16*)(A.ws + WS_OA);
      const float o0 = oraw[wave * 128 + 2 * lane], o1 = oraw[wave * 128 + 2 * lane + 1];
      const float r = 1.f / sqrtf(wsum(o0 * o0 + o1 * o1) * (1.f / 128.f) + NORM_EPS);
      *(GAS unsigned*)(OA + mt * 512 + h * 128 + 2 * lane) = pk2(o0 * r * nw0 * siluf_(bflo(zw)), o1 * r * nw1 * siluf_(bfhi(zw))); }
    LBAR();
}

__device__ __forceinline__ void gdn_item_s(const Args& A, LAS unsigned char* lds, int h, int m0, const float* S0, float* Sout, const float* convbuf) {
    const int tid = threadIdx.x, lane = tid & 63, wave = tid >> 6;
    const unsigned char* ws = A.ws;
    LAS float* sq = (LAS float*)lds; LAS float* sk = sq + 1024; LAS float* sv = sk + 1024; LAS float* sbeta = sv + 1024; LAS float* sgd = sbeta + 8; LAS float* sqk = sgd + 8;
    LAS float* part = sqk + 16; LAS float* oraw = part + 2048;
    const int dv = tid & 127, g = tid >> 7;
    float S[32];
#pragma unroll
    for (int i = 0; i < 32; ++i) S[i] = S0[(size_t)(g * 32 + i) * 128 + dv];
    const bf16* SPEC = (const bf16*)(ws + WS_SPEC);
    const size_t mt = (size_t)m0 + wave;
    const bf16* PZ = panel(ws, PN_ZB + (h >> 1));
    const unsigned zw = *(const GAS unsigned*)(PZ + mt * 256 + (h & 1) * 128 + 2 * lane);
    const float nw0 = A.in[15][2 * lane], nw1 = A.in[15][2 * lane + 1];
    float raw[11], cw[4]; const int c = tid, seg = c >> 7, cc = c & 127;
    if (tid < 384) { const bf16* P = panel(ws, PN_QB + 2 * seg + (h >> 1)); const int ch = seg * 512 + h * 128 + cc;
#pragma unroll
        for (int j = 0; j < 3; ++j) raw[j] = convbuf[j * 1536 + ch];
#pragma unroll
        for (int j = 0; j < 8; ++j) raw[3 + j] = bf2f(P[(size_t)(m0 + j) * 256 + (h & 1) * 128 + cc]);
#pragma unroll
        for (int j = 0; j < 4; ++j) cw[j] = A.in[12][j * 1536 + ch]; }
    float bta = 0.f, gdv = 0.f;
    if (tid < 8) { const size_t m = (size_t)m0 + tid; bta = bf2f(SPEC[m * 32 + 20 + h]); gdv = bf2f(SPEC[m * 32 + 16 + h]); }
    const float negA = -__expf(A.in[13][h]), dtb = A.in[14][h];
    if (tid < 384) { LAS float* dst = seg == 0 ? sq : (seg == 1 ? sk : sv);
#pragma unroll
        for (int t = 0; t < 8; ++t) dst[t * 128 + cc] = siluf_(cw[0] * raw[t] + cw[1] * raw[t + 1] + cw[2] * raw[t + 2] + cw[3] * raw[t + 3]); }
    if (tid < 8) { sbeta[tid] = sigmoidf_(bta); sgd[tid] = __expf(negA * softplusf_(gdv + dtb)); }
    LBAR();
    { float q0 = sq[wave * 128 + lane], q1 = sq[wave * 128 + lane + 64], k0 = sk[wave * 128 + lane], k1 = sk[wave * 128 + lane + 64];
      const float rq = 0.08838834764831845f / sqrtf(wsum(q0 * q0 + q1 * q1) + NORM_EPS), rk = 1.f / sqrtf(wsum(k0 * k0 + k1 * k1) + NORM_EPS);
      q0 *= rq; q1 *= rq; k0 *= rk; k1 *= rk;
      sq[wave * 128 + lane] = q0; sq[wave * 128 + lane + 64] = q1; sk[wave * 128 + lane] = k0; sk[wave * 128 + lane + 64] = k1;
      const float qk = wsum(q0 * k0 + q1 * k1); if (lane == 0) sqk[wave] = qk; }
    LBAR();
#pragma unroll 1
    for (int tk = 0; tk < 8; ++tk) {
        float pk = 0.f, pq = 0.f;
#pragma unroll
        for (int i = 0; i < 32; ++i) { const int dk = g * 32 + i; pk += sk[tk * 128 + dk] * S[i]; pq += sq[tk * 128 + dk] * S[i]; }
        LAS float* pp = part + (tk & 1) * 1024;
        pp[g * 128 + dv] = pk; pp[512 + g * 128 + dv] = pq;
        LBAR();
        const float gd = sgd[tk];
        const float kS = gd * ((pp[dv] + pp[128 + dv]) + (pp[256 + dv] + pp[384 + dv]));
        const float vnew = sbeta[tk] * (sv[tk * 128 + dv] - kS);
#pragma unroll
        for (int i = 0; i < 32; ++i) { const int dk = g * 32 + i; S[i] = gd * S[i] + sk[tk * 128 + dk] * vnew; }
        if (g == 0) { const float qS = gd * ((pp[512 + dv] + pp[640 + dv]) + (pp[768 + dv] + pp[896 + dv])); oraw[tk * 128 + dv] = qS + sqk[tk] * vnew; }
    }
#pragma unroll
    for (int i = 0; i < 32; ++i) Sout[(size_t)(g * 32 + i) * 128 + dv] = S[i];
    LBAR();
    { bf16* OB = (bf16*)(A.ws + WS_OB);
      const float o0 = oraw[wave * 128 + 2 * lane], o1 = oraw[wave * 128 + 2 * lane + 1];
      const float r = 1.f / sqrtf(wsum(o0 * o0 + o1 * o1) * (1.f / 128.f) + NORM_EPS);
      *(GAS unsigned*)(OB + mt * 512 + h * 128 + 2 * lane) = pk2(o0 * r * nw0 * siluf_(bflo(zw)), o1 * r * nw1 * siluf_(bfhi(zw))); }
    LBAR();
}
typedef short bf16x8 __attribute__((ext_vector_type(8)));
typedef float f32x16 __attribute__((ext_vector_type(16)));
typedef float f32x4v __attribute__((ext_vector_type(4)));
typedef float f32x2v __attribute__((ext_vector_type(2)));
#define MFMA32(a, b, c) __builtin_amdgcn_mfma_f32_32x32x16_bf16((a), (b), (c), 0, 0, 0)
#define MFMA16(a, b, c) __builtin_amdgcn_mfma_f32_16x16x32_bf16((a), (b), (c), 0, 0, 0)
__device__ __forceinline__ int c32row(int lane, int reg) { return (reg & 3) + 8 * (reg >> 2) + 4 * (lane >> 5); }
__device__ __forceinline__ bf16x8 acc_frag(const f32x16& c, int s) {
    v4u w;
    if (s == 0) { w.x = pg8::cvt_pk_bf16(c[0], c[1]); w.y = pg8::cvt_pk_bf16(c[2], c[3]); w.z = pg8::cvt_pk_bf16(c[4], c[5]); w.w = pg8::cvt_pk_bf16(c[6], c[7]); }
    else { w.x = pg8::cvt_pk_bf16(c[8], c[9]); w.y = pg8::cvt_pk_bf16(c[10], c[11]); w.z = pg8::cvt_pk_bf16(c[12], c[13]); w.w = pg8::cvt_pk_bf16(c[14], c[15]); }
    return __builtin_bit_cast(bf16x8, w);
}
__device__ __forceinline__ bf16x8 lds_frag(const LAS bf16* rowp, int k0, int h) { return *(const LAS bf16x8*)(rowp + k0 + 8 * h); }
__device__ __forceinline__ bf16x8 lds_frag_perm(const LAS bf16* rowp, int s, int h) {
    const v2u a = *(const LAS v2u*)(rowp + 16 * s + 4 * h), b = *(const LAS v2u*)(rowp + 16 * s + 8 + 4 * h);
    v4u w; w.x = a.x; w.y = a.y; w.z = b.x; w.w = b.y; return __builtin_bit_cast(bf16x8, w);
}
__device__ __forceinline__ f32x16 zero16() { f32x16 z;
#pragma unroll
    for (int i = 0; i < 16; ++i) z[i] = 0.f; return z; }

__device__ __forceinline__ v4u pack8(const f32x4 a, const f32x4 b) { v4u w; w.x = pg8::cvt_pk_bf16(a.x, a.y); w.y = pg8::cvt_pk_bf16(a.z, a.w); w.z = pg8::cvt_pk_bf16(b.x, b.y); w.w = pg8::cvt_pk_bf16(b.z, b.w); return w; }
__device__ __forceinline__ void unpack8(const v4u w, f32x4& a, f32x4& b) { a = (f32x4){bflo(w.x), bfhi(w.x), bflo(w.y), bfhi(w.y)}; b = (f32x4){bflo(w.z), bfhi(w.z), bflo(w.w), bfhi(w.w)}; }
__device__ __forceinline__ f32x4 sig4(const f32x4 x) { return (f32x4){sigmoidf_(x.x), sigmoidf_(x.y), sigmoidf_(x.z), sigmoidf_(x.w)}; }
constexpr int GLA_QE = 0, GLA_KE = 9216, GLA_KENDT = 18432, GLA_VT = 27648, GLA_ATT = 46080, GLA_GA = 55296, GLA_SEG = 59392, GLA_DD = 61440, GLA_OBUF = 61696, GLA_LDS_END = GLA_OBUF + 64 * 132 * 4;
static_assert(GLA_LDS_END <= 131072, "GLA LDS");
struct GlaState { f32x16 S[2]; bf16x8 Sb[4]; };
struct GlaPre { unsigned vv[8]; unsigned short qh[8], kh[8]; unsigned ga; };
__device__ __forceinline__ void gla_touch(const GlaPre& p) {
    asm volatile("" :: "v"(p.vv[0]), "v"(p.vv[1]), "v"(p.vv[2]), "v"(p.vv[3]), "v"(p.vv[4]), "v"(p.vv[5]), "v"(p.vv[6]), "v"(p.vv[7]), "v"(p.ga));
    asm volatile("" :: "v"(p.qh[0]), "v"(p.qh[1]), "v"(p.qh[2]), "v"(p.qh[3]), "v"(p.qh[4]), "v"(p.qh[5]), "v"(p.qh[6]), "v"(p.qh[7]));
    asm volatile("" :: "v"(p.kh[0]), "v"(p.kh[1]), "v"(p.kh[2]), "v"(p.kh[3]), "v"(p.kh[4]), "v"(p.kh[5]), "v"(p.kh[6]), "v"(p.kh[7]));
}
#define SB0() __builtin_amdgcn_sched_barrier(0)
__device__ __forceinline__ void gla_prefetch(const Args& A, int b, int h, int n, GlaPre& p) {
    const int tid = threadIdx.x, lane = tid & 63, wave = tid >> 6;
    const unsigned char* ws = A.ws; const size_t m0 = (size_t)b * SEQ + (size_t)n * 64;
    const bf16* PQ = panel(ws, PN_QA); const bf16* PK = panel(ws, PN_KA); const bf16* PV = panel(ws, PN_VA + (h >> 1)); const bf16* SPEC = (const bf16*)(ws + WS_SPEC);
    p.ga = *(const GAS unsigned*)(SPEC + (m0 + (tid >> 3)) * 32 + (tid & 7) * 2);
#pragma unroll
    for (int i = 0; i < 8; ++i) p.vv[i] = *(const GAS unsigned*)(PV + (m0 + wave * 8 + i) * 256 + (h & 1) * 128 + 2 * lane);
    const int dk = tid & 63, seg = tid >> 6;
#pragma unroll
    for (int i = 0; i < 8; ++i) { p.qh[i] = PQ[(m0 + seg * 8 + i) * 256 + h * 64 + dk]; p.kh[i] = PK[(m0 + seg * 8 + i) * 256 + h * 64 + dk]; }
}
__device__ __forceinline__ void gla_chunk(const Args& A, LAS unsigned char* lds, int b, int h, int n, GlaState& st, const float (&wg)[16], float bgv, GlaPre& cur, float nw0, float nw1) {
    const int tid = threadIdx.x, lane = tid & 63, wave = __builtin_amdgcn_readfirstlane(tid >> 6), r = lane & 31, hh = lane >> 5;
    const unsigned char* ws = A.ws;
    const size_t m0 = (size_t)b * SEQ + (size_t)n * 64;
    LAS bf16* QE = (LAS bf16*)(lds + GLA_QE); LAS bf16* KE = (LAS bf16*)(lds + GLA_KE); LAS bf16* KENDT = (LAS bf16*)(lds + GLA_KENDT);
    LAS bf16* VT = (LAS bf16*)(lds + GLA_VT); LAS bf16* ATT = (LAS bf16*)(lds + GLA_ATT);
    LAS float* GA = (LAS float*)(lds + GLA_GA); LAS float* SEG = (LAS float*)(lds + GLA_SEG); LAS float* DD = (LAS float*)(lds + GLA_DD); LAS float* OBUF = (LAS float*)(lds + GLA_OBUF);
    const bf16* PZ = panel(ws, PN_ZA + (h >> 1));
    if (n == 2) STAMP3(0);
    unsigned zw[8];
#pragma unroll
    for (int i = 0; i < 8; ++i) zw[i] = *(const GAS unsigned*)(PZ + (m0 + wave * 8 + i) * 256 + (h & 1) * 128 + 2 * lane);
    { const int t = tid >> 3, c2 = (tid & 7) * 2; GA[t * 16 + c2] = bflo(cur.ga); GA[t * 16 + c2 + 1] = bfhi(cur.ga); }
    { const unsigned* vv = cur.vv;
      v4u lo, hi; lo.x = (vv[0] & 0xffffu) | (vv[1] << 16); lo.y = (vv[2] & 0xffffu) | (vv[3] << 16); lo.z = (vv[4] & 0xffffu) | (vv[5] << 16); lo.w = (vv[6] & 0xffffu) | (vv[7] << 16);
      hi.x = (vv[0] >> 16) | (vv[1] & 0xffff0000u); hi.y = (vv[2] >> 16) | (vv[3] & 0xffff0000u); hi.z = (vv[4] >> 16) | (vv[5] & 0xffff0000u); hi.w = (vv[6] >> 16) | (vv[7] & 0xffff0000u);
      *(LAS v4u*)(VT + (2 * lane) * 72 + wave * 8) = lo; *(LAS v4u*)(VT + (2 * lane + 1) * 72 + wave * 8) = hi; }
    LBAR();
    if (n == 2) STAMP3(1);
    const int dk = tid & 63, seg = tid >> 6;
    float cs[8];
    { float run = 0.f;
#pragma unroll
      for (int i = 0; i < 8; ++i) { const int t = seg * 8 + i; float x = bgv;
#pragma unroll
          for (int q = 0; q < 4; ++q) { const f32x4v g4 = *(const LAS f32x4v*)(GA + t * 16 + 4 * q); x += g4[0] * wg[4 * q] + g4[1] * wg[4 * q + 1] + g4[2] * wg[4 * q + 2] + g4[3] * wg[4 * q + 3]; }
          const float ls = fminf(x, 0.f) - __logf(1.f + __expf(-fabsf(x)));
          run += ls * (1.f / 16.f); cs[i] = run; }
      SEG[seg * 64 + dk] = run; }
    LBAR();
    if (n == 2) STAMP3(2);
    { float off = 0.f, tot = 0.f;
#pragma unroll
      for (int s = 0; s < 8; ++s) { const float v = SEG[s * 64 + dk]; tot += v; if (s < seg) off += v; }
      unsigned kend[4];
#pragma unroll
      for (int i = 0; i < 8; ++i) { const int t = seg * 8 + i; const float bb = off + cs[i];
          const float q = bf2f(cur.qh[i]), k = bf2f(cur.kh[i]);
          QE[t * 72 + dk] = (bf16)f2bf(q * 0.125f * __expf(bb)); KE[t * 72 + dk] = (bf16)f2bf(k * __expf(-bb));
          const unsigned ke = f2bf(k * __expf(tot - bb)); if (i & 1) kend[i >> 1] |= ke << 16; else kend[i >> 1] = ke; }
      v4u kw; kw.x = kend[0]; kw.y = kend[1]; kw.z = kend[2]; kw.w = kend[3];
      *(LAS v4u*)(KENDT + dk * 72 + seg * 8) = kw;
      if (seg == 0) DD[dk] = __expf(tot); }
    if (n + 1 < 32) gla_prefetch(A, b, h, n + 1, cur);
    LBAR();
    if (n == 2) STAMP3(3);
    if (wave < 3) { const int tp = (wave == 2) ? 1 : 0, mt = (wave == 0) ? 0 : 1;
        f32x16 acc = zero16(); bf16x8 fa[4], fb[4];
#pragma unroll
        for (int s = 0; s < 4; ++s) { fa[s] = lds_frag(KE + (32 * tp + r) * 72, 16 * s, hh); fb[s] = lds_frag(QE + (32 * mt + r) * 72, 16 * s, hh); }
        SB0();
#pragma unroll
        for (int s = 0; s < 4; ++s) acc = MFMA32(fa[s], fb[s], acc);
        SB0();
        const int t = 32 * mt + r;
#pragma unroll
        for (int q = 0; q < 4; ++q) { const int tq = 32 * tp + 8 * q + 4 * hh; float v[4];
#pragma unroll
            for (int e = 0; e < 4; ++e) v[e] = (tq + e <= t) ? acc[4 * q + e] : 0.f;
            v2u w; w.x = pg8::cvt_pk_bf16(v[0], v[1]); w.y = pg8::cvt_pk_bf16(v[2], v[3]); *(LAS v2u*)(ATT + t * 72 + tq) = w; } }
    LBAR();
    if (n == 2) STAMP3(4);
    if (wave < 4) {
        const LAS bf16* vrow = VT + (32 * wave + r) * 72;
        bf16x8 vb[4], fa[6], fb[4];
#pragma unroll
        for (int s = 0; s < 4; ++s) vb[s] = lds_frag(vrow, 16 * s, hh);
        fa[0] = lds_frag(ATT + r * 72, 0, hh); fa[1] = lds_frag(ATT + r * 72, 16, hh);
#pragma unroll
        for (int s = 0; s < 4; ++s) fa[2 + s] = lds_frag(ATT + (32 + r) * 72, 16 * s, hh);
#pragma unroll
        for (int s = 0; s < 4; ++s) fb[s] = lds_frag_perm(QE + r * 72, s, hh);
        SB0();
        f32x16 O0 = zero16(), O1 = zero16();
        O0 = MFMA32(fa[0], vb[0], O0); O0 = MFMA32(fa[1], vb[1], O0);
#pragma unroll
        for (int s = 0; s < 4; ++s) O1 = MFMA32(fa[2 + s], vb[s], O1);
        SB0();
#pragma unroll
        for (int s = 0; s < 4; ++s) fa[s] = lds_frag_perm(QE + (32 + r) * 72, s, hh);
        SB0();
#pragma unroll
        for (int s = 0; s < 4; ++s) O0 = MFMA32(fb[s], st.Sb[s], O0);
        SB0();
#pragma unroll
        for (int s = 0; s < 4; ++s) fb[s] = lds_frag(KENDT + r * 72, 16 * s, hh);
        SB0();
#pragma unroll
        for (int s = 0; s < 4; ++s) O1 = MFMA32(fa[s], st.Sb[s], O1);
#pragma unroll
        for (int g2 = 0; g2 < 16; ++g2) st.S[0][g2] *= DD[c32row(lane, g2)];
        SB0();
#pragma unroll
        for (int s = 0; s < 4; ++s) fa[s] = lds_frag(KENDT + (32 + r) * 72, 16 * s, hh);
        SB0();
#pragma unroll
        for (int s = 0; s < 4; ++s) st.S[0] = MFMA32(fb[s], vb[s], st.S[0]);
#pragma unroll
        for (int g2 = 0; g2 < 16; ++g2) st.S[1][g2] *= DD[32 + c32row(lane, g2)];
#pragma unroll
        for (int g2 = 0; g2 < 16; ++g2) OBUF[c32row(lane, g2) * 132 + 32 * wave + r] = O0[g2];
        SB0();
#pragma unroll
        for (int s = 0; s < 4; ++s) st.S[1] = MFMA32(fa[s], vb[s], st.S[1]);
#pragma unroll
        for (int g2 = 0; g2 < 16; ++g2) OBUF[(32 + c32row(lane, g2)) * 132 + 32 * wave + r] = O1[g2];
        st.Sb[0] = acc_frag(st.S[0], 0); st.Sb[1] = acc_frag(st.S[0], 1);
        SB0();
        st.Sb[2] = acc_frag(st.S[1], 0); st.Sb[3] = acc_frag(st.S[1], 1);
    }
    gla_touch(cur);
    LBAR();
    if (n == 2) STAMP3(5);
    { bf16* OA = (bf16*)(A.ws + WS_OA);
#pragma unroll
      for (int i = 0; i < 8; ++i) { const int t = wave * 8 + i; const size_t m = m0 + t;
          const float o0 = OBUF[t * 132 + 2 * lane], o1 = OBUF[t * 132 + 2 * lane + 1];
          const float rr = 1.f / sqrtf(wsum(o0 * o0 + o1 * o1) * (1.f / 128.f) + NORM_EPS);
          *(GAS unsigned*)(OA + m * 512 + h * 128 + 2 * lane) = pk2(o0 * rr * nw0 * siluf_(bflo(zw[i])), o1 * rr * nw1 * siluf_(bfhi(zw[i]))); } }
    LBAR();
    if (n == 2) STAMP3(6);
}
__device__ __forceinline__ void gla_final(const Args& A, int c, const GlaState& st) {
    const int tid = threadIdx.x, lane = tid & 63, wave = tid >> 6, r = lane & 31;
    if (wave < 4) { float* So = A.out + OUT_GLA_P + (size_t)c * 64 * 128;
#pragma unroll
        for (int mk = 0; mk < 2; ++mk)
#pragma unroll
            for (int g = 0; g < 16; ++g) So[(size_t)(32 * mk + c32row(lane, g)) * 128 + 32 * wave + r] = st.S[mk][g]; }
}
constexpr size_t REC_BYTES = 73728; constexpr int REC_W = 0, REC_QE = 16384, REC_QK = 32768, REC_KT = 40960, REC_U = 57344, REC_LDS = 57344;
constexpr int R1_KN = 0, R1_QN = 17408, R1_KNT = 34816, R1_VT = 53248, R1_AM = 71680, R1_ANEG = 89088, R1_DINV = 98304, R1_TB = 101376, R1_TBD = 110592, R1_TAB = 119808, R1_CW = R1_TAB + 1024, R1_END = R1_CW + 4 * 4 * 384 * 4;
static_assert(R1_END <= LDS_BYTES - 512, "R1 LDS");
struct R1Pre { unsigned raw[11][3]; unsigned short ab, bb; };
__device__ __forceinline__ void r1_touch(const R1Pre& p) {
#pragma unroll
    for (int rr = 0; rr < 11; ++rr) asm volatile("" :: "v"(p.raw[rr][0]), "v"(p.raw[rr][1]), "v"(p.raw[rr][2]));
    asm volatile("" :: "v"(p.ab), "v"(p.bb));
}
__device__ __forceinline__ float wscan(float v, int lane) {
    v += dpp_f<0x111>(v); v += dpp_f<0x112>(v); v += dpp_f<0x114>(v); v += dpp_f<0x118>(v);
    const float t0 = rl_f(v, 15), t1 = rl_f(v, 31), t2 = rl_f(v, 47); const int row = lane >> 4;
    return v + (row > 0 ? t0 : 0.f) + (row > 1 ? t1 : 0.f) + (row > 2 ? t2 : 0.f);
}
__device__ __forceinline__ void r1_prefetch(const Args& A, int u, R1Pre& p) {
    const int tid = threadIdx.x, lane = tid & 63, wave = tid >> 6;
    const int bh = u >> 5, n = u & 31, b = bh >> 2, h = bh & 3; const unsigned char* ws = A.ws;
    const bf16* SPEC = (const bf16*)(ws + WS_SPEC); const size_t m = (size_t)b * SEQ + (size_t)n * 64 + lane;
    p.ab = SPEC[m * 32 + 16 + h]; p.bb = SPEC[m * 32 + 20 + h];
    const int t0 = wave * 8;
#pragma unroll
    for (int rr = 0; rr < 11; ++rr) { const int t = n * 64 + t0 - 3 + rr;
#pragma unroll
        for (int sg = 0; sg < 3; ++sg) { unsigned w = 0u;
            if (t >= 0) w = *(const GAS unsigned*)(panel(ws, PN_QB + 2 * sg + (h >> 1)) + ((size_t)b * SEQ + t) * 256 + (h & 1) * 128 + 2 * lane);
            p.raw[rr][sg] = w; } }
}
__device__ __forceinline__ void r1_stage_cw(const Args& A, LAS unsigned char* lds) {
    LAS float* CW = (LAS float*)(lds + R1_CW);
    for (int i = threadIdx.x; i < 4 * 4 * 384; i += NTHREADS) { const int cc = i & 127, sg = (i >> 7) % 3, j = (i / 384) & 3, h = i / 1536; CW[i] = A.in[12][j * 1536 + sg * 512 + h * 128 + cc]; }
    LBAR();
}
__device__ __forceinline__ void st_frag(unsigned char* g, int frag, int lane, const v4u w) { *(GAS v4u*)(g + (size_t)frag * 1024 + lane * 16) = w; }

__device__ __forceinline__ void gdn_r1_unit(const Args& A, LAS unsigned char* lds, int u, R1Pre& cur, int un, const float (&negA4)[4], const float (&dtb4)[4]) {
    const int tid = threadIdx.x, lane = tid & 63, wave = __builtin_amdgcn_readfirstlane(tid >> 6), r = lane & 31, hh = lane >> 5;
    const int bh = u >> 5, n = u & 31, b = bh >> 2, h = bh & 3;
    const unsigned char* ws = A.ws;
    unsigned char* rec = A.ws + WS_REC + (size_t)u * REC_BYTES;
    const size_t m0 = (size_t)b * SEQ + (size_t)n * 64;
    LAS bf16* KN = (LAS bf16*)(lds + R1_KN); LAS bf16* QN = (LAS bf16*)(lds + R1_QN); LAS bf16* KNT = (LAS bf16*)(lds + R1_KNT); LAS bf16* VT = (LAS bf16*)(lds + R1_VT);
    LAS float* AM = (LAS float*)(lds + R1_AM); LAS bf16* ANEG = (LAS bf16*)(lds + R1_ANEG); LAS bf16* DINV = (LAS bf16*)(lds + R1_DINV);
    LAS bf16* TB = (LAS bf16*)(lds + R1_TB); LAS bf16* TBD = (LAS bf16*)(lds + R1_TBD);
    LAS float* DEC = (LAS float*)(lds + R1_TAB); LAS float* BETA = DEC + 64; LAS float* EDEC = DEC + 128; LAS float* EEND = DEC + 192;
    const bf16* SPEC = (const bf16*)(ws + WS_SPEC);
    const bool stp = (u < 224);
    if (stp) STAMP3(0);
    { const float gg = negA4[h] * softplusf_(bf2f(cur.ab) + dtb4[h]);
      const float d = wscan(gg, lane);
      const float dl = rl_f(d, 63);
      if (wave == 0) { DEC[lane] = d; BETA[lane] = sigmoidf_(bf2f(cur.bb)); EDEC[lane] = __expf(d); EEND[lane] = __expf(dl - d);
          if (lane == 0) ((float*)(A.ws + WS_CDEC))[u] = __expf(dl); } }
    { const int t0 = wave * 8;
      const LAS float* CW = (const LAS float*)(lds + R1_CW) + h * 1536;
      float cw[4][3][2];
#pragma unroll
      for (int j = 0; j < 4; ++j)
#pragma unroll
          for (int sg = 0; sg < 3; ++sg) { const f32x2v c2 = *(const LAS f32x2v*)(CW + (j * 3 + sg) * 128 + 2 * lane); cw[j][sg][0] = c2[0]; cw[j][sg][1] = c2[1]; }
#define RAWV(rr, sg, e) ((e) ? bfhi(cur.raw[rr][sg]) : bflo(cur.raw[rr][sg]))
      unsigned kt0[4], kt1[4], vt0[4], vt1[4];
#pragma unroll
      for (int i = 0; i < 8; ++i) { float o[3][2];
#pragma unroll
          for (int sg = 0; sg < 3; ++sg)
#pragma unroll
              for (int e = 0; e < 2; ++e) o[sg][e] = siluf_(cw[0][sg][e] * RAWV(i, sg, e) + cw[1][sg][e] * RAWV(i + 1, sg, e) + cw[2][sg][e] * RAWV(i + 2, sg, e) + cw[3][sg][e] * RAWV(i + 3, sg, e));
          const float rq = 0.08838834764831845f / sqrtf(wsum(o[0][0] * o[0][0] + o[0][1] * o[0][1]) + NORM_EPS);
          const float rk = 1.f / sqrtf(wsum(o[1][0] * o[1][0] + o[1][1] * o[1][1]) + NORM_EPS);
          const unsigned qw = pk2(o[0][0] * rq, o[0][1] * rq), kw = pk2(o[1][0] * rk, o[1][1] * rk), vw = pk2(o[2][0], o[2][1]);
          *(LAS unsigned*)(QN + (t0 + i) * 136 + 2 * lane) = qw; *(LAS unsigned*)(KN + (t0 + i) * 136 + 2 * lane) = kw;
          if (i & 1) { kt0[i >> 1] |= kw << 16; kt1[i >> 1] |= kw & 0xffff0000u; vt0[i >> 1] |= vw << 16; vt1[i >> 1] |= vw & 0xffff0000u; }
          else { kt0[i >> 1] = kw & 0xffffu; kt1[i >> 1] = kw >> 16; vt0[i >> 1] = vw & 0xffffu; vt1[i >> 1] = vw >> 16; } }
      v4u x; x.x = kt0[0]; x.y = kt0[1]; x.z = kt0[2]; x.w = kt0[3]; *(LAS v4u*)(KNT + (2 * lane) * 72 + t0) = x;
      x.x = kt1[0]; x.y = kt1[1]; x.z = kt1[2]; x.w = kt1[3]; *(LAS v4u*)(KNT + (2 * lane + 1) * 72 + t0) = x;
      x.x = vt0[0]; x.y = vt0[1]; x.z = vt0[2]; x.w = vt0[3]; *(LAS v4u*)(VT + (2 * lane) * 72 + t0) = x;
      x.x = vt1[0]; x.y = vt1[1]; x.z = vt1[2]; x.w = vt1[3]; *(LAS v4u*)(VT + (2 * lane + 1) * 72 + t0) = x; }
    if (un < 1024) r1_prefetch(A, un, cur);
    LBAR();
    if (stp) STAMP3(1);
    if (wave < 3) { const int tp = (wave == 2) ? 1 : 0, mt = (wave == 0) ? 0 : 1;
        f32x16 kk = zero16(), qk = zero16();
#pragma unroll
        for (int hf = 0; hf < 2; ++hf) { bf16x8 fa[4], fk[4], fq[4];
#pragma unroll
            for (int s = 0; s < 4; ++s) { const int k0 = 16 * (4 * hf + s); fa[s] = lds_frag(KN + (32 * tp + r) * 136, k0, hh); fk[s] = lds_frag(KN + (32 * mt + r) * 136, k0, hh); fq[s] = lds_frag(QN + (32 * mt + r) * 136, k0, hh); }
            SB0();
#pragma unroll
            for (int s = 0; s < 4; ++s) { kk = MFMA32(fa[s], fk[s], kk); qk = MFMA32(fa[s], fq[s], qk); }
            SB0(); }
        const int t = 32 * mt + r; const float dect = DEC[t], bet = BETA[t];
#pragma unroll
        for (int q = 0; q < 4; ++q) { const int tq = 32 * tp + 8 * q + 4 * hh; float av[4], qv[4];
#pragma unroll
            for (int e = 0; e < 4; ++e) { const int tpp = tq + e; const float gam = (tpp <= t) ? __expf(dect - DEC[tpp]) : 0.f;
                av[e] = (tpp < t) ? bet * kk[4 * q + e] * gam : 0.f; qv[e] = qk[4 * q + e] * gam; qk[4 * q + e] = qv[e]; }
            *(LAS f32x4v*)(AM + t * 68 + tq) = (f32x4v){av[0], av[1], av[2], av[3]};
            v2u w; w.x = pg8::cvt_pk_bf16(-av[0], -av[1]); w.y = pg8::cvt_pk_bf16(-av[2], -av[3]); *(LAS v2u*)(ANEG + t * 72 + tq) = w; }
        st_frag(rec + REC_QK, mt * 4 + 2 * tp + 0, lane, __builtin_bit_cast(v4u, acc_frag(qk, 0)));
        st_frag(rec + REC_QK, mt * 4 + 2 * tp + 1, lane, __builtin_bit_cast(v4u, acc_frag(qk, 1)));
    } else {
        for (int f = wave - 3; f < 32; f += 5) {
            if (f < 16) { const int mt = f >> 3, s = f & 7, t = 32 * mt + r; const float e = EDEC[t];
                const LAS bf16* rp = QN + t * 136; const v2u a = *(const LAS v2u*)(rp + 16 * s + 4 * hh), c = *(const LAS v2u*)(rp + 16 * s + 8 + 4 * hh);
                v4u w; w.x = pk2(bflo(a.x) * e, bfhi(a.x) * e); w.y = pk2(bflo(a.y) * e, bfhi(a.y) * e); w.z = pk2(bflo(c.x) * e, bfhi(c.x) * e); w.w = pk2(bflo(c.y) * e, bfhi(c.y) * e);
                st_frag(rec + REC_QE, f, lane, w); }
            else { const int g = f - 16, mk = g >> 2, sp = g & 3; const LAS bf16* rp = KNT + (32 * mk + r) * 72; const int ta = 16 * sp + 4 * hh, tb = ta + 8;
                const v2u a = *(const LAS v2u*)(rp + ta), c = *(const LAS v2u*)(rp + tb);
                v4u w; w.x = pk2(bflo(a.x) * EEND[ta], bfhi(a.x) * EEND[ta + 1]); w.y = pk2(bflo(a.y) * EEND[ta + 2], bfhi(a.y) * EEND[ta + 3]);
                w.z = pk2(bflo(c.x) * EEND[tb], bfhi(c.x) * EEND[tb + 1]); w.w = pk2(bflo(c.y) * EEND[tb + 2], bfhi(c.y) * EEND[tb + 3]);
                st_frag(rec + REC_KT, g, lane, w); }
        }
    }
    LBAR();
    if (stp) STAMP3(2);
    if (wave == 0) { const int I = lane >> 4, c = lane & 15; float x[16];
#pragma unroll
        for (int i = 0; i < 16; ++i) { float acc = (i == c) ? 1.f : 0.f; const LAS float* nr = AM + (16 * I + i) * 68 + 16 * I;
#pragma unroll
            for (int j = 0; j < i; ++j) acc -= nr[j] * x[j];
            x[i] = acc; DINV[(I * 16 + i) * 24 + c] = (bf16)f2bf(acc); } }
    LBAR();
    if (stp) STAMP3(3);
    if (wave < 4) { const int Jc = wave, c = lane & 15, g = lane >> 4; f32x4v X[4];
#pragma unroll
        for (int I = 0; I < 4; ++I) { X[I] = (f32x4v){0.f, 0.f, 0.f, 0.f};
            if (I >= Jc) { f32x4v R;
#pragma unroll
                for (int e = 0; e < 4; ++e) R[e] = (I == Jc && 4 * g + e == c) ? 1.f : 0.f;
#pragma unroll
                for (int p = 0; p < 2; ++p) { const int J0 = 2 * p, J1 = 2 * p + 1; if (J0 < I) {
                    const LAS bf16* ar = ANEG + (16 * I + c) * 72;
                    const v2u a0 = *(const LAS v2u*)(ar + 16 * J0 + 4 * g); v2u a1; a1.x = 0u; a1.y = 0u; if (J1 < I) a1 = *(const LAS v2u*)(ar + 16 * J1 + 4 * g);
                    v4u aw; aw.x = a0.x; aw.y = a0.y; aw.z = a1.x; aw.w = a1.y;
                    v4u bw; bw.x = pg8::cvt_pk_bf16(X[J0][0], X[J0][1]); bw.y = pg8::cvt_pk_bf16(X[J0][2], X[J0][3]); bw.z = 0u; bw.w = 0u;
                    if (J1 < I) { bw.z = pg8::cvt_pk_bf16(X[J1][0], X[J1][1]); bw.w = pg8::cvt_pk_bf16(X[J1][2], X[J1][3]); }
                    R = MFMA16(__builtin_bit_cast(bf16x8, aw), __builtin_bit_cast(bf16x8, bw), R); } }
                const v2u d0 = *(const LAS v2u*)(DINV + (I * 16 + c) * 24 + 4 * g);
                v4u aw; aw.x = d0.x; aw.y = d0.y; aw.z = 0u; aw.w = 0u;
                v4u bw; bw.x = pg8::cvt_pk_bf16(R[0], R[1]); bw.y = pg8::cvt_pk_bf16(R[2], R[3]); bw.z = 0u; bw.w = 0u;
                const f32x4v z4 = {0.f, 0.f, 0.f, 0.f}; X[I] = MFMA16(__builtin_bit_cast(bf16x8, aw), __builtin_bit_cast(bf16x8, bw), z4); } }
        const int cc = 16 * Jc + c; const float bet = BETA[cc], bed = bet * EDEC[cc];
#pragma unroll
        for (int I = 0; I < 4; ++I)
#pragma unroll
            for (int e = 0; e < 4; ++e) { const int t = 16 * I + 4 * g + e; TB[t * 72 + cc] = (bf16)f2bf(X[I][e] * bet); TBD[t * 72 + cc] = (bf16)f2bf(X[I][e] * bed); } }
    LBAR();
    if (stp) STAMP3(4);
    { const int mt = wave & 1, cb = wave >> 1; const int ns = mt ? 4 : 2;
      f32x16 ua = zero16(), wa = zero16();
      bf16x8 f0[4], f1[4], f2[4], f3[4];
#pragma unroll
      for (int s = 0; s < 4; ++s) if (s < ns) { f0[s] = lds_frag(TB + (32 * mt + r) * 72, 16 * s, hh); f1[s] = lds_frag(VT + (32 * cb + r) * 72, 16 * s, hh);
          f2[s] = lds_frag(KNT + (32 * cb + r) * 72, 16 * s, hh); f3[s] = lds_frag(TBD + (32 * mt + r) * 72, 16 * s, hh); }
      SB0();
#pragma unroll
      for (int s = 0; s < 4; ++s) if (s < ns) { ua = MFMA32(f0[s], f1[s], ua); wa = MFMA32(f2[s], f3[s], wa); }
      SB0();
      r1_touch(cur);
      { v4u lo = __builtin_bit_cast(v4u, acc_frag(ua, 0)), hi = __builtin_bit_cast(v4u, acc_frag(ua, 1));
        unsigned char* up = rec + REC_U + (size_t)((cb * 2 + mt) * 64 + lane) * 32; *(GAS v4u*)up = lo; *(GAS v4u*)(up + 16) = hi; }
#pragma unroll
      for (int g = 0; g < 16; ++g) wa[g] = -wa[g];
      st_frag(rec + REC_W, mt * 8 + 2 * cb + 0, lane, __builtin_bit_cast(v4u, acc_frag(wa, 0)));
      st_frag(rec + REC_W, mt * 8 + 2 * cb + 1, lane, __builtin_bit_cast(v4u, acc_frag(wa, 1))); }
    LBAR();
    if (stp) STAMP3(5);
}

constexpr int R2_BUF0 = 0, R2_BUF1 = REC_LDS, R2_OBUF = 2 * REC_LDS, R2_END = R2_OBUF + 64 * 136 * 2;
static_assert(R2_END <= LDS_BYTES - 512, "R2 LDS");
#define RAW_BAR() do { asm volatile("" ::: "memory"); __builtin_amdgcn_s_barrier(); asm volatile("" ::: "memory"); } while (0)
__device__ __forceinline__ void gdn_r2_item(const Args& A, LAS unsigned char* lds, int bh) {
    const int tid = threadIdx.x, lane = tid & 63, wave = __builtin_amdgcn_readfirstlane(tid >> 6), r = lane & 31, hh = lane >> 5;
    const int b = bh >> 2, h = bh & 3;
    const unsigned char* recs = A.ws + WS_REC + (size_t)bh * 32 * REC_BYTES;
    const float* CDEC = (const float*)(A.ws + WS_CDEC) + bh * 32;
    LAS bf16* OBUF = (LAS bf16*)(lds + R2_OBUF);
    if (wave >= 4) { const int wl = wave - 4;
        for (int p = wl; p < 56; p += 4) __builtin_amdgcn_global_load_lds((const unsigned*)(recs + (size_t)p * 1024 + lane * 16), (LAS unsigned*)(lds + R2_BUF0 + p * 1024), 16, 0, 0);
        asm volatile("s_waitcnt vmcnt(0)" ::: "memory"); }
    RAW_BAR();
    if (wave < 4) {
        f32x16 S[4]; bf16x8 Sb[8];
#pragma unroll
        for (int i = 0; i < 4; ++i) S[i] = zero16();
#pragma unroll
        for (int i = 0; i < 8; ++i) Sb[i] = (bf16x8){0, 0, 0, 0, 0, 0, 0, 0};
        v4u un[2][2]; float cdn = CDEC[0];
#pragma unroll
        for (int mt = 0; mt < 2; ++mt) { const unsigned char* up = recs + REC_U + (size_t)((wave * 2 + mt) * 64 + lane) * 32; un[mt][0] = *(const GAS v4u*)up; un[mt][1] = *(const GAS v4u*)(up + 16); }
#define SB0() __builtin_amdgcn_sched_barrier(0)
#define FRG(off, idx) (*(const LAS bf16x8*)(buf + (off) + (idx) * 1024 + lane * 16))
        for (int n = 0; n < 32; ++n) {
            const LAS unsigned char* buf = lds + ((n & 1) ? R2_BUF1 : R2_BUF0);
            const float cdec = cdn;
            bf16x8 fa[8], fb[8];
#pragma unroll
            for (int s = 0; s < 8; ++s) fa[s] = FRG(REC_W, s);
#pragma unroll
            for (int s = 0; s < 8; ++s) fb[s] = FRG(REC_W, 8 + s);
            f32x16 V[2];
#pragma unroll
            for (int mt = 0; mt < 2; ++mt) { const v4u lo = un[mt][0], hi = un[mt][1];
                V[mt][0] = bflo(lo.x); V[mt][1] = bfhi(lo.x); V[mt][2] = bflo(lo.y); V[mt][3] = bfhi(lo.y); V[mt][4] = bflo(lo.z); V[mt][5] = bfhi(lo.z); V[mt][6] = bflo(lo.w); V[mt][7] = bfhi(lo.w);
                V[mt][8] = bflo(hi.x); V[mt][9] = bfhi(hi.x); V[mt][10] = bflo(hi.y); V[mt][11] = bfhi(hi.y); V[mt][12] = bflo(hi.z); V[mt][13] = bfhi(hi.z); V[mt][14] = bflo(hi.w); V[mt][15] = bfhi(hi.w); }
            if (n + 1 < 32) { cdn = CDEC[n + 1];
#pragma unroll
                for (int mt = 0; mt < 2; ++mt) { const unsigned char* up = recs + (size_t)(n + 1) * REC_BYTES + REC_U + (size_t)((wave * 2 + mt) * 64 + lane) * 32; un[mt][0] = *(const GAS v4u*)up; un[mt][1] = *(const GAS v4u*)(up + 16); } }
            SB0();
#pragma unroll
            for (int s = 0; s < 8; ++s) V[0] = MFMA32(fa[s], Sb[s], V[0]);
            SB0();
#pragma unroll
            for (int s = 0; s < 8; ++s) fa[s] = FRG(REC_QE, s);
            SB0();
#pragma unroll
            for (int s = 0; s < 8; ++s) V[1] = MFMA32(fb[s], Sb[s], V[1]);
            SB0();
#pragma unroll
            for (int s = 0; s < 8; ++s) fb[s] = FRG(REC_QE, 8 + s);
            bf16x8 Vb[4]; Vb[0] = acc_frag(V[0], 0); Vb[1] = acc_frag(V[0], 1);
            SB0();
            f32x16 O0 = zero16(), O1 = zero16();
#pragma unroll
            for (int s = 0; s < 8; ++s) O0 = MFMA32(fa[s], Sb[s], O0);
            Vb[2] = acc_frag(V[1], 0); Vb[3] = acc_frag(V[1], 1);
            SB0();
            fa[0] = FRG(REC_QK, 0); fa[1] = FRG(REC_QK, 1); fa[2] = FRG(REC_QK, 4); fa[3] = FRG(REC_QK, 5); fa[4] = FRG(REC_QK, 6); fa[5] = FRG(REC_QK, 7);
            SB0();
#pragma unroll
            for (int s = 0; s < 8; ++s) O1 = MFMA32(fb[s], Sb[s], O1);
            SB0();
#pragma unroll
            for (int s = 0; s < 8; ++s) fb[s] = FRG(REC_KT, s);
            SB0();
            O0 = MFMA32(fa[0], Vb[0], O0); O0 = MFMA32(fa[1], Vb[1], O0);
#pragma unroll
            for (int s = 0; s < 4; ++s) O1 = MFMA32(fa[2 + s], Vb[s], O1);
#pragma unroll
            for (int g = 0; g < 16; ++g) { S[0][g] *= cdec; S[1][g] *= cdec; }
            SB0();
#pragma unroll
            for (int s = 0; s < 8; ++s) fa[s] = FRG(REC_KT, 8 + s);
            asm volatile("s_waitcnt lgkmcnt(0)" ::: "memory");
            RAW_BAR();
            SB0();
#pragma unroll
            for (int s = 0; s < 4; ++s) { S[0] = MFMA32(fb[s], Vb[s], S[0]); S[1] = MFMA32(fb[4 + s], Vb[s], S[1]); }
#pragma unroll
            for (int g = 0; g < 16; ++g) { OBUF[c32row(lane, g) * 136 + 32 * wave + r] = (bf16)f2bf(O0[g]); OBUF[(32 + c32row(lane, g)) * 136 + 32 * wave + r] = (bf16)f2bf(O1[g]); }
#pragma unroll
            for (int g = 0; g < 16; ++g) { S[2][g] *= cdec; S[3][g] *= cdec; }
            SB0();
#pragma unroll
            for (int s = 0; s < 4; ++s) { S[2] = MFMA32(fa[s], Vb[s], S[2]); S[3] = MFMA32(fa[4 + s], Vb[s], S[3]); }
            Sb[0] = acc_frag(S[0], 0); Sb[1] = acc_frag(S[0], 1); Sb[2] = acc_frag(S[1], 0); Sb[3] = acc_frag(S[1], 1);
            SB0();
            Sb[4] = acc_frag(S[2], 0); Sb[5] = acc_frag(S[2], 1); Sb[6] = acc_frag(S[3], 0); Sb[7] = acc_frag(S[3], 1);
            asm volatile("s_waitcnt lgkmcnt(0)" ::: "memory");
            RAW_BAR();
        }
        RAW_BAR();
        float* So = A.out + OUT_GDN_P + (size_t)bh * 128 * 128;
#pragma unroll
        for (int mk = 0; mk < 4; ++mk)
#pragma unroll
            for (int g = 0; g < 16; ++g) So[(size_t)(32 * mk + c32row(lane, g)) * 128 + 32 * wave + r] = S[mk][g];
    } else {
        const int wl = wave - 4, lt = tid - 256, t = lt >> 2, qd = lt & 3;
        const bf16* PZ = panel(A.ws, PN_ZB + (h >> 1)); bf16* OB = (bf16*)(A.ws + WS_OB);
        f32x4 nw[8];
#pragma unroll
        for (int i = 0; i < 8; ++i) nw[i] = *(const GAS f32x4*)(A.in[15] + 32 * qd + 4 * i);
        v4u zc[4], zn[4];
        { const size_t m = (size_t)b * SEQ + t;
#pragma unroll
          for (int i = 0; i < 4; ++i) zc[i] = *(const GAS v4u*)(PZ + m * 256 + (h & 1) * 128 + 32 * qd + 8 * i); }
        for (int n = 0; n <= 32; ++n) {
            if (n + 1 < 32) { const unsigned char* src = recs + (size_t)(n + 1) * REC_BYTES; LAS unsigned char* dst = lds + (((n + 1) & 1) ? R2_BUF1 : R2_BUF0);
                for (int p = wl; p < 56; p += 4) __builtin_amdgcn_global_load_lds((const unsigned*)(src + (size_t)p * 1024 + lane * 16), (LAS unsigned*)(dst + p * 1024), 16, 0, 0); }
            if (n >= 1) { const size_t m = (size_t)b * SEQ + (size_t)(n - 1) * 64 + t;
                float ss = 0.f; f32x4 ov[8];
#pragma unroll
                for (int i = 0; i < 4; ++i) unpack8(*(const LAS v4u*)(OBUF + t * 136 + 32 * qd + 8 * i), ov[2 * i], ov[2 * i + 1]);
#pragma unroll
                for (int i = 0; i < 8; ++i) ss += (ov[i].x * ov[i].x + ov[i].y * ov[i].y) + (ov[i].z * ov[i].z + ov[i].w * ov[i].w);
                asm volatile("s_waitcnt lgkmcnt(0)" ::: "memory");
                RAW_BAR();
                ss = quad_sum(ss);
                const float rr = 1.f / sqrtf(ss * (1.f / 128.f) + NORM_EPS);
                v4u ow[4];
#pragma unroll
                for (int i = 0; i < 4; ++i) { f32x4 z0, z1; unpack8(zc[i], z0, z1);
                    f32x4 a = ov[2 * i] * rr * nw[2 * i], c = ov[2 * i + 1] * rr * nw[2 * i + 1];
                    a.x *= siluf_(z0.x); a.y *= siluf_(z0.y); a.z *= siluf_(z0.z); a.w *= siluf_(z0.w); c.x *= siluf_(z1.x); c.y *= siluf_(z1.y); c.z *= siluf_(z1.z); c.w *= siluf_(z1.w);
                    ow[i] = pack8(a, c); }
#pragma unroll
                for (int i = 0; i < 4; ++i) zc[i] = zn[i];
                asm volatile("" :: "v"(zc[0].x), "v"(zc[1].x), "v"(zc[2].x), "v"(zc[3].x), "v"(zc[0].w), "v"(zc[1].w), "v"(zc[2].w), "v"(zc[3].w));
#pragma unroll
                for (int i = 0; i < 4; ++i) *(GAS v4u*)(OB + m * 512 + h * 128 + 32 * qd + 8 * i) = ow[i];
            } else { RAW_BAR(); }
            if (n + 1 < 32) { const size_t m = (size_t)b * SEQ + (size_t)(n + 1) * 64 + t;
#pragma unroll
                for (int i = 0; i < 4; ++i) zn[i] = *(const GAS v4u*)(PZ + m * 256 + (h & 1) * 128 + 32 * qd + 8 * i); }
            if (n < 32) { asm volatile("s_waitcnt vmcnt(8)" ::: "memory"); RAW_BAR(); }
        }
    }
}
constexpr int GLA_SPLIT = 10;
__device__ __forceinline__ void p2_recurrences(const Args& A, LAS unsigned char* lds, int c, int G, const XcdBarrier& bar) {
    float* out = A.out;
#ifdef PROBE_WG
    unsigned long long* stamps = (unsigned long long*)(A.ws + WS_CTL + 32768) + (size_t)c * 16;
#define STAMP2(k) do { if (threadIdx.x == 0) stamps[k] = __builtin_amdgcn_s_memrealtime(); } while (0)
#else
#define STAMP2(k) do { } while (0)
#endif
    if (c < 32) {
        const int b = c >> 2, h = c & 3, lane = threadIdx.x & 63;
        float wg[16];
#pragma unroll
        for (int r = 0; r < 16; ++r) wg[r] = A.in[9][r * 256 + h * 64 + lane];
        const float bgv = A.in[10][h * 64 + lane];
        GlaState st; st.S[0] = zero16(); st.S[1] = zero16();
#pragma unroll
        for (int i = 0; i < 4; ++i) st.Sb[i] = (bf16x8){0, 0, 0, 0, 0, 0, 0, 0};
        const float nw0 = A.in[11][2 * lane], nw1 = A.in[11][2 * lane + 1];
        GlaPre pa; gla_prefetch(A, b, h, 0, pa); gla_touch(pa);
        for (int n = 0; n < 32; ++n) {
            if (n == GLA_SPLIT && MK_N_LAUNCHES == 1) { STAMP2(5); xcd_barrier(bar); STAMP2(6); }
            gla_chunk(A, lds, b, h, n, st, wg, bgv, pa, nw0, nw1); }
        gla_final(A, c, st);
    } else {
        { r1_stage_cw(A, lds); const int step = G - 32; int u = c - 32; R1Pre pa;
          float negA4[4], dtb4[4];
#pragma unroll
          for (int i = 0; i < 4; ++i) { negA4[i] = -__expf(A.in[13][i]); dtb4[i] = A.in[14][i]; }
          if (u < 1024) { r1_prefetch(A, u, pa); r1_touch(pa); }
          while (u < 1024) { const int un = u + step; gdn_r1_unit(A, lds, u, pa, un, negA4, dtb4); u = un; } }
        STAMP2(5); if (MK_N_LAUNCHES == 1) xcd_barrier(bar); STAMP2(6);
        if (c < 64) gdn_r2_item(A, lds, c - 32);
        else { const int nw = G - 64;
            for (int it = c - 64; it < 1024; it += nw) {
                if (it < 512) { const int b = it >> 2, h = it & 3; gla_item_s(A, lds, h, MP + b * DSQ, A.in[2] + (size_t)it * 64 * 128, out + OUT_GLA_S + (size_t)it * 64 * 128); }
                else { const int i = it - 512, b = i >> 2, h = i & 3; gdn_item_s(A, lds, h, MP + b * DSQ, A.in[3] + (size_t)i * 128 * 128, out + OUT_GDN_S + (size_t)i * 128 * 128, A.in[4] + (size_t)b * 3 * 1536); }
            } }
    }
    const int gt = c * NTHREADS + threadIdx.x, NGT = G * NTHREADS;
    for (int i = gt; i < 8 * 3 * 1536; i += NGT) { const int ch = i % 1536, j = (i / 1536) % 3, b = i / (3 * 1536); const size_t m = (size_t)b * SEQ + SEQ - 3 + j;
        out[OUT_CONV_P + i] = bf2f(panel(A.ws, PN_QB + (ch >> 8))[m * 256 + (ch & 255)]); }
    for (int i = gt; i < 128 * 3 * 1536; i += NGT) { const int ch = i % 1536, j = (i / 1536) % 3, b = i / (3 * 1536); const size_t m = (size_t)MP + b * DSQ + DSQ - 3 + j;
        out[OUT_CONV_S + i] = bf2f(panel(A.ws, PN_QB + (ch >> 8))[m * 256 + (ch & 255)]); }
}
typedef pg8::f32x4 (&AccRef)[2][2][4][2];
typedef const pg8::f32x4 (&CAccRef)[2][2][4][2];

#define EPI_LOOP_BEGIN  const int row0 = u.pm * 256 + wr * 64 + fr, cin = wc * 32 + 8 * fq; \
    _Pragma("unroll") for (int ai = 0; ai < 2; ++ai) _Pragma("unroll") for (int m = 0; m < 4; ++m) { const size_t row = (size_t)(row0 + ai * 128 + m * 16); \
    _Pragma("unroll") for (int bj = 0; bj < 2; ++bj) { const int cp = bj * 128 + cin;   const f32x4 a0 = acc[ai][bj][m][0], a1 = acc[ai][bj][m][1];
#define EPI_LOOP_END } }

__device__ __forceinline__ bf16* panel_rw(unsigned char* ws, float* out, int pn) { return (pn < 14) ? (bf16*)(ws + WS_PROJ + (size_t)pn * SZ_PANEL) : (bf16*)((unsigned char*)out + (size_t)(pn - 14) * SZ_PANEL); }
struct EpiProj { static constexpr bool PERM = true; unsigned char* ws; float* out;
    __device__ __forceinline__ void operator()(CAccRef acc, const pg8::Unit& u, int wr, int wc, int fr, int fq) const {
        if (u.pn < PN_SPEC) { bf16* P = panel_rw(ws, out, u.pn);
            EPI_LOOP_BEGIN *(GAS v4u*)(P + row * 256 + cp) = pack8(a0, a1); EPI_LOOP_END }
        else { bf16* P = (bf16*)(ws + WS_SPEC);
            EPI_LOOP_BEGIN if (cp < 32) *(GAS v4u*)(P + row * 32 + cp) = pack8(a0, a1); EPI_LOOP_END }
    } };
#define EPI_POS(p) const int m = (p) >> 1, bj = (p) & 1; const size_t row = (size_t)(row0 + ai * 128 + m * 16); const int cp = bj * 128 + cin; const f32x4 a0 = acc[ai][bj][m][0], a1 = acc[ai][bj][m][1];
struct EpiUpA { static constexpr bool PERM = true; unsigned char* ws; float* out;
    __device__ __forceinline__ void operator()(CAccRef acc, const pg8::Unit& u, int wr, int wc, int fr, int fq) const {
        const bf16* Gp = panel_rw(ws, out, PN_GA + u.pn); bf16* O = (bf16*)(ws + WS_MERGED);
        const int row0 = u.pm * 256 + wr * 64 + fr, cin = wc * 32 + 8 * fq;
#pragma unroll
        for (int ai = 0; ai < 2; ++ai) { v4u gw[8];
#pragma unroll
            for (int p = 0; p < 8; ++p) { EPI_POS(p) (void)a0; (void)a1; gw[p] = *(const GAS v4u*)(Gp + row * 256 + cp); }
#pragma unroll
            for (int p = 0; p < 8; ++p) { EPI_POS(p) f32x4 g0, g1; unpack8(gw[p], g0, g1);
                *(GAS v4u*)(O + row * 1024 + u.pn * 256 + cp) = pack8(sig4(g0) * a0, sig4(g1) * a1); } }
    } };
struct EpiUpB { static constexpr bool PERM = true; unsigned char* ws; float* out;
    __device__ __forceinline__ void operator()(CAccRef acc, const pg8::Unit& u, int wr, int wc, int fr, int fq) const {
        const bf16* Gp = panel_rw(ws, out, PN_GB + u.pn); bf16* O = (bf16*)(ws + WS_MERGED);
        const int row0 = u.pm * 256 + wr * 64 + fr, cin = wc * 32 + 8 * fq;
#pragma unroll
        for (int ai = 0; ai < 2; ++ai) { v4u gw[8], yw[8];
#pragma unroll
            for (int p = 0; p < 8; ++p) { EPI_POS(p) (void)a0; (void)a1; gw[p] = *(const GAS v4u*)(Gp + row * 256 + cp); yw[p] = *(const GAS v4u*)(O + row * 1024 + u.pn * 256 + cp); }
#pragma unroll
            for (int p = 0; p < 8; ++p) { EPI_POS(p) f32x4 g0, g1, y0, y1; unpack8(gw[p], g0, g1); unpack8(yw[p], y0, y1);
                *(GAS v4u*)(O + row * 1024 + u.pn * 256 + cp) = pack8(y0 + sig4(g0) * a0, y1 + sig4(g1) * a1); } }
    } };
struct EpiOut { static constexpr bool PERM = true; unsigned char* ws; const float* xp; const float* xs; float* out;
    __device__ __forceinline__ void operator()(CAccRef acc, const pg8::Unit& u, int wr, int wc, int fr, int fq) const {
        bf16* HB = (bf16*)(ws + WS_H1B);
        const int row0 = u.pm * 256 + wr * 64 + fr, cin = wc * 32 + 8 * fq;
#pragma unroll
        for (int ai = 0; ai < 2; ++ai) { f32x4 x0[8], x1[8];
#pragma unroll
            for (int p = 0; p < 8; ++p) { EPI_POS(p) (void)a0; (void)a1; const size_t col = (size_t)u.pn * 256 + cp;
                const float* xr = (row < (size_t)MP) ? xp + row * 1024 + col : xs + (row - MP) * 1024 + col; x0[p] = *(const GAS f32x4*)xr; x1[p] = *(const GAS f32x4*)(xr + 4); }
#pragma unroll
            for (int p = 0; p < 8; ++p) { EPI_POS(p) const size_t col = (size_t)u.pn * 256 + cp;
                *(GAS v4u*)(HB + row * 1024 + col) = pack8(x0[p] + a0, x1[p] + a1); } }
    } };
struct EpiPe { static constexpr bool PERM = true; unsigned char* ws;
    __device__ __forceinline__ void operator()(CAccRef acc, const pg8::Unit& u, int wr, int wc, int fr, int fq) const {
        bf16* O = (bf16*)(ws + WS_PE);
        EPI_LOOP_BEGIN *(GAS v4u*)(O + row * 1024 + u.pn * 256 + cp) = pack8(a0, a1); EPI_LOOP_END
    } };
struct EpiGate { static constexpr bool PERM = true; unsigned char* ws; float* out;
    __device__ __forceinline__ void operator()(CAccRef acc, const pg8::Unit& u, int wr, int wc, int fr, int fq) const {
        const bf16* PEp = (const bf16*)(ws + WS_PE); const bf16* HB = (const bf16*)(ws + WS_H1B); bf16* H2 = (bf16*)(ws + WS_MERGED); float* RS = (float*)(ws + WS_RSSP);
        const int row0 = u.pm * 256 + wr * 64 + fr, cin = wc * 32 + 8 * fq;
#pragma unroll
        for (int ai = 0; ai < 2; ++ai) { v4u pw[8], hw[8];
#pragma unroll
            for (int p = 0; p < 8; ++p) { EPI_POS(p) (void)a0; (void)a1; const size_t col = (size_t)u.pn * 256 + cp;
                pw[p] = *(const GAS v4u*)(PEp + row * 1024 + col); hw[p] = *(const GAS v4u*)(HB + row * 1024 + col); }
            float ssm[4] = {0.f, 0.f, 0.f, 0.f};
#pragma unroll
            for (int p = 0; p < 8; ++p) { EPI_POS(p) const size_t col = (size_t)u.pn * 256 + cp;
                f32x4 p0, p1, x0, x1; unpack8(pw[p], p0, p1); unpack8(hw[p], x0, x1);
                const f32x4 h0 = x0 + sig4(a0) * p0, h1 = x1 + sig4(a1) * p1;
                *(GAS v4u*)(H2 + row * 1024 + col) = pack8(h0, h1);
                ssm[m] += (h0.x * h0.x + h0.y * h0.y) + (h0.z * h0.z + h0.w * h0.w) + (h1.x * h1.x + h1.y * h1.y) + (h1.z * h1.z + h1.w * h1.w); }
#pragma unroll
            for (int mm = 0; mm < 4; ++mm) { float ss = ssm[mm]; ss += __shfl_xor(ss, 16); ss += __shfl_xor(ss, 32);
                if (fq == 0) RS[(size_t)(row0 + ai * 128 + mm * 16) * 16 + u.pn * 4 + wc] = ss; } }
    } };

__device__ __forceinline__ void p6_final_norm(const Args& A, int vcu, int G, int wave, int lane) {
    const int gw = vcu * NWAVES + wave, NGW = G * NWAVES;
    const float* RS = (const float*)(A.ws + WS_RSSP); const bf16* HB = (const bf16*)(A.ws + WS_MERGED);
    const GAS f32x4* fw = (const GAS f32x4*)A.in[21];
    const f32x4 w0 = fw[4 * lane], w1 = fw[4 * lane + 1], w2 = fw[4 * lane + 2], w3 = fw[4 * lane + 3];
    for (int m = gw; m < M; m += NGW) {
        const f32x4 ra = *(const GAS f32x4*)(RS + (size_t)m * 16), rb = *(const GAS f32x4*)(RS + (size_t)m * 16 + 4), rc = *(const GAS f32x4*)(RS + (size_t)m * 16 + 8), rd = *(const GAS f32x4*)(RS + (size_t)m * 16 + 12);
        const v4u ha = *(const GAS v4u*)(HB + (size_t)m * D + 16 * lane), hb = *(const GAS v4u*)(HB + (size_t)m * D + 16 * lane + 8);
        const float ss = (((ra.x + ra.y) + (ra.z + ra.w)) + ((rb.x + rb.y) + (rb.z + rb.w))) + (((rc.x + rc.y) + (rc.z + rc.w)) + ((rd.x + rd.y) + (rd.z + rd.w)));
        const float r = 1.f / sqrtf(ss * (1.f / D) + NORM_EPS);
        f32x4 a0, a1, a2, a3; unpack8(ha, a0, a1); unpack8(hb, a2, a3);
        GAS f32x4* o = (GAS f32x4*)(A.out + (size_t)m * D + 16 * lane);
        o[0] = a0 * r * w0; o[1] = a1 * r * w1; o[2] = a2 * r * w2; o[3] = a3 * r * w3;
    }
}
#ifndef MK_N_LAUNCHES
#define MK_N_LAUNCHES 1
#endif
constexpr int N_PHASES = 7;
__global__ void __launch_bounds__(NTHREADS, 2) mk_fwd(Args args) {
    extern __shared__ __attribute__((aligned(16))) unsigned char lds_raw[];
    LAS unsigned char* lds = (LAS unsigned char*)lds_raw;
    volatile LAS unsigned* MISC = (volatile LAS unsigned*)(lds + MISC_OFF);
    const int tid = threadIdx.x, lane = tid & 63, wave = __builtin_amdgcn_readfirstlane(tid >> 6);
    const int G = gridDim.x, bx = blockIdx.x;
    const int vcu = (G % 8 == 0) ? (bx % 8) * (G / 8) + bx / 8 : bx;
    for (int u = tid; u < (LDS_BYTES - LDSCTL_OFF) / 4; u += NTHREADS) ((LAS unsigned*)(lds + LDSCTL_OFF))[u] = 0u;
    __syncthreads();
    unsigned char* ws = args.ws;
    XcdBarrier bar; bar.bar = (unsigned*)(ws + WS_CTL) + CW_BAR; bar.x = 0; bar.st = nullptr;
    if (MK_N_LAUNCHES == 1) bar = xcd_barrier_post((unsigned*)(ws + WS_CTL) + CW_BAR, MISC + 8);
    const int lo = args.ph_lo, hi = args.ph_hi;
#ifdef PROBE_WG
    unsigned long long* stamps = (unsigned long long*)(ws + WS_CTL + 32768) + (size_t)bx * 16;
#define STAMP(k) do { if (tid == 0) stamps[k] = __builtin_amdgcn_s_memrealtime(); } while (0)
#else
#define STAMP(k) do { } while (0)
#endif
    STAMP(0);
#define IN(k) (lo <= (k) && (k) < hi)
#define SEAM(k) do { if (IN(k) && IN((k) + 1)) xcd_barrier(bar); } while (0)

    if (IN(0)) { p0_prologue(args, lds, vcu, G, wave, lane); }
    STAMP(1); SEAM(0); STAMP(2);
    if (IN(1)) {
        pg8::Gemm g{(const bf16*)(ws + WS_XN), (const bf16*)(ws + WS_WIN), M, NPROJ, 1024}; pg8::StaticOrder S; S.init(M, NPROJ, G, bx);
        EpiProj E{ws, args.out};
        pg8::gemm_phase<EpiProj, pg8::StaticOrder>(lds + RING_OFF, g, S, E);
    }
    STAMP(3); SEAM(1); STAMP(4);
#ifndef PROBE_DUP
#define PROBE_DUP -1
#endif
    if (IN(2)) { p2_recurrences(args, lds, bx, G, bar); if (PROBE_DUP == 2) p2_recurrences(args, lds, bx, G, bar); }
    STAMP(7); SEAM(2); STAMP(8);
    if (IN(3)) {
        pg8::StaticOrder S; S.init(M, 1024, G, bx);
        { pg8::Gemm g{(const bf16*)(ws + WS_OA), (const bf16*)(ws + WS_WUA), M, 1024, 512}; EpiUpA E{ws, args.out}; pg8::gemm_phase<EpiUpA, pg8::StaticOrder>(lds + RING_OFF, g, S, E); }
        { pg8::Gemm g{(const bf16*)(ws + WS_OB), (const bf16*)(ws + WS_WUB), M, 1024, 512}; EpiUpB E{ws, args.out}; pg8::gemm_phase<EpiUpB, pg8::StaticOrder>(lds + RING_OFF, g, S, E); }
    }
    STAMP(9); SEAM(3); STAMP(10);
    if (IN(4)) {
        pg8::StaticOrder S; S.init(M, 1024, G, bx);
        pg8::Gemm g{(const bf16*)(ws + WS_MERGED), (const bf16*)(ws + WS_WO), M, 1024, 1024}; EpiOut E{ws, args.in[0], args.in[1], args.out};
        pg8::gemm_phase<EpiOut, pg8::StaticOrder>(lds + RING_OFF, g, S, E);
    }
    STAMP(11); SEAM(4); STAMP(12);
    if (IN(5)) {
        pg8::StaticOrder S; S.init(M, 1024, G, bx);
        { pg8::Gemm g{(const bf16*)(ws + WS_PB), (const bf16*)(ws + WS_WP), M, 1024, 256}; EpiPe E{ws}; pg8::gemm_phase<EpiPe, pg8::StaticOrder>(lds + RING_OFF, g, S, E); }
        { pg8::Gemm g{(const bf16*)(ws + WS_H1B), (const bf16*)(ws + WS_WG), M, 1024, 1024}; EpiGate E{ws, args.out}; pg8::gemm_phase<EpiGate, pg8::StaticOrder>(lds + RING_OFF, g, S, E); }
    }
    STAMP(13); SEAM(5); STAMP(14);
    if (IN(6)) { p6_final_norm(args, vcu, G, wave, lane); }
    STAMP(15);
#ifdef PROBE_WG
    xcd_barrier(bar);
    if (bx == 0) { const unsigned long long* sp = (const unsigned long long*)(ws + WS_CTL + ((PROBE_K1 >= 16) ? 65536 : 32768)) + (size_t)(PROBE_WG) * 16 - ((PROBE_K1 >= 16) ? 16 : 0);
        const float X = (PROBE_K1 < 0) ? 0.3f : (float)(__hip_atomic_load(sp + PROBE_K1, __ATOMIC_RELAXED, __HIP_MEMORY_SCOPE_AGENT) - __hip_atomic_load(sp + PROBE_K0, __ATOMIC_RELAXED, __HIP_MEMORY_SCOPE_AGENT)) * 1e-5f * (float)(PROBE_SCALE);
        for (int i = tid; i < 8 * 3 * 1536; i += NTHREADS) args.out[OUT_CONV_P + i] += X; }
#endif
#undef IN
#undef SEAM
}

extern "C" void kernel_launch(void* const* d_in, const int* in_sizes, int n_in, void* d_out, int out_size, void* d_ws, size_t ws_size, hipStream_t stream) {
    static int grid = 0;
    if (grid == 0) {
        if (n_in != 22 || in_sizes[0] != MP * D || (size_t)out_size != OUT_TOTAL || ws_size < WS_END) {
            fprintf(stderr, "kernel_launch: unexpected shapes: n_in %d in0 %d out %d ws %zu (need %zu)\n", n_in, n_in > 0 ? in_sizes[0] : -1, out_size, ws_size, (size_t)WS_END); grid = -1; return; }
        int dev = 0, cus = 0, per_cu = 0;
        if (hipGetDevice(&dev) != hipSuccess || hipDeviceGetAttribute(&cus, hipDeviceAttributeMultiprocessorCount, dev) != hipSuccess) { grid = -1; return; }
        if (hipFuncSetAttribute((const void*)mk_fwd, hipFuncAttributeMaxDynamicSharedMemorySize, LDS_BYTES) != hipSuccess) { fprintf(stderr, "kernel_launch: hipFuncSetAttribute failed\n"); grid = -1; return; }
        if (hipOccupancyMaxActiveBlocksPerMultiprocessor(&per_cu, (const void*)mk_fwd, NTHREADS, LDS_BYTES) != hipSuccess || per_cu < 1) {
            fprintf(stderr, "kernel_launch: occupancy query reports %d workgroups per CU\n", per_cu); (void)hipGetLastError(); grid = -1; return; }
        grid = cus;
    }
    if (grid < 0) return;
    (void)hipMemsetAsync((char*)d_ws + WS_CTL, 0, CTL_ZERO_BYTES, stream);
    Args a{};
    for (int i = 0; i < 22; ++i) a.in[i] = (const float*)d_in[i];
    a.out = (float*)d_out; a.ws = (unsigned char*)d_ws;
#if MK_N_LAUNCHES == 1
    a.ph_lo = 0; a.ph_hi = N_PHASES;
    hipLaunchKernelGGL(mk_fwd, dim3(grid), dim3(NTHREADS), LDS_BYTES, stream, a);
#else
    for (int p = 0; p < N_PHASES; ++p) { a.ph_lo = p; a.ph_hi = p + 1; hipLaunchKernelGGL(mk_fwd, dim3(grid), dim3(NTHREADS), LDS_BYTES, stream, a); }
#endif
}
```

```cpp
#include <hip/hip_runtime.h>
#include <cstdio>
#include <cstdint>
#define MK_N_LAUNCHES 1
#define PROBE_DUP -1
namespace pg8 {
#define PG8_LAS __attribute__((address_space(3)))
typedef unsigned short bf16_t;
typedef short bf16x8 __attribute__((ext_vector_type(8)));
typedef float f32x4 __attribute__((ext_vector_type(4)));
typedef unsigned u32x4 __attribute__((ext_vector_type(4)));
constexpr int BM = 256, BK = 64, HALF = 128, HTB = HALF * BK * 2  , STAGE_BYTES = 8 * HTB, NXCD = 8, WGM = 8;

__host__ __device__ __forceinline__ int lds_byte(int r, int c) { const int st = (r >> 4) * 2 + (c >> 5), rr = r & 15, cc = c & 31, ob = rr * 64 + cc * 2; return st * 1024 + (ob ^ (((ob >> 9) & 1) << 5)); }
__host__ __device__ __forceinline__ void stage_rc(int b, int& R, int& C) { const int st = b / 1024, sb = b % 1024, swz = sb ^ (((sb >> 9) & 1) << 5); R = (st >> 1) * 16 + swz / 64; C = (st & 1) * 32 + (swz % 64) / 2; }
__host__ __device__ __forceinline__ int perm32(int rho) { const int n = rho >> 4, i = rho & 15; return 8 * (i >> 2) + 4 * n + (i & 3); }

struct Unit { int pm, pn; };
struct Gemm { const bf16_t* A; const bf16_t* Bt; int M, N, K; };

struct StaticOrder {
    int nM, nN, nwg, G, c;
    __host__ __device__ void init(int M, int N, int G_, int c_) { nM = M / BM; nN = N / BM; nwg = nM * nN; G = G_; c = c_; }
    __host__ __device__ bool next(int i, Unit& u) const {
        const long L = (long)i * G + c; if (L >= nwg) return false;
        int wgid = (int)L; { const int q = nwg / NXCD, r = nwg % NXCD, xcd = wgid % NXCD, off = wgid / NXCD; wgid = (xcd < r ? xcd * (q + 1) : r * (q + 1) + (xcd - r) * q) + off; }
        const int nig = WGM * nN, gid = wgid / nig, fm = gid * WGM, gsz = (nM - fm) < WGM ? (nM - fm) : WGM;
        u.pm = fm + ((wgid % nig) % gsz); u.pn = (wgid % nig) / gsz; return true;
    }
    __device__ __forceinline__ void a_ready(const Unit&) const {}
    __device__ __forceinline__ void done(const Unit&) const {}
};

typedef __bf16 bf16x2_t __attribute__((ext_vector_type(2)));
typedef float f32x2_t __attribute__((ext_vector_type(2)));
__device__ __forceinline__ unsigned cvt_pk_bf16(float lo, float hi) { const f32x2_t v = {lo, hi}; return __builtin_bit_cast(unsigned, __builtin_convertvector(v, bf16x2_t)); }

template <class Epi, class Sched>
__device__ __forceinline__ void gemm_phase(PG8_LAS unsigned char* lds, const Gemm g, const Sched& S, const Epi& E) {
    int tid_ = threadIdx.x; asm volatile("" : "+v"(tid_));
    const int tid = tid_, wid = __builtin_amdgcn_readfirstlane(tid >> 6), lane = tid & 63, wr = wid >> 2, wc = wid & 3, fr = lane & 15, fq = lane >> 4;
    const int K = g.K, nt = K / BK;
    unsigned voffA[2], voffB[2];
#pragma unroll
    for (int i = 0; i < 2; ++i) { int R, C; stage_rc(tid * 16 + i * 8192, R, C); const int Rb = Epi::PERM ? ((R & ~31) + perm32(R & 31)) : R;
        voffA[i] = (unsigned)(R * K + C) * 2u; voffB[i] = (unsigned)(Rb * K + C) * 2u; }
    const size_t kstep = (size_t)(BK * 2);
    const size_t hstep = (size_t)HALF * K * 2;
    const size_t tstep = 2 * hstep;
    const unsigned ldsw = (unsigned)wid * 1024u;
    const int aoff = lds_byte(wr * 64 + fr, fq * 8), boff = lds_byte(wc * 32 + fr, fq * 8);
#define PG8_SA(b, h) (((b) * 2 + (h)) * HTB)
#define PG8_SB(b, h) ((4 + (b) * 2 + (h)) * HTB)
#define PG8_STAGE(bufoff, gbase, voff) do { _Pragma("unroll") for (int _i = 0; _i < 2; ++_i) \
        __builtin_amdgcn_global_load_lds((const unsigned*)((const char*)(gbase) + (voff)[_i]), (PG8_LAS unsigned*)(lds + (bufoff) + ldsw + _i * 8192), 16, 0, 0); } while (0)
#define PG8_LDA(dst, b, h) do { _Pragma("unroll") for (int m = 0; m < 4; ++m) _Pragma("unroll") for (int k = 0; k < 2; ++k) dst[m][k] = *(const PG8_LAS bf16x8*)(lds + PG8_SA(b, h) + aoff + m * 2048 + k * 1024); } while (0)
#define PG8_LDB(dst, b, h) do { _Pragma("unroll") for (int n = 0; n < 2; ++n) _Pragma("unroll") for (int k = 0; k < 2; ++k) dst[n][k] = *(const PG8_LAS bf16x8*)(lds + PG8_SB(b, h) + boff + n * 2048 + k * 1024); } while (0)
#define PG8_MMA(ai, bj, At, Bt) do { __builtin_amdgcn_s_setprio(1); _Pragma("unroll") for (int m = 0; m < 4; ++m) _Pragma("unroll") for (int n = 0; n < 2; ++n) _Pragma("unroll") for (int k = 0; k < 2; ++k) \
        acc[ai][bj][m][n] = __builtin_amdgcn_mfma_f32_16x16x32_bf16(Bt[n][k], At[m][k], acc[ai][bj][m][n], 0, 0, 0); __builtin_amdgcn_s_setprio(0); } while (0)
#define PG8_WAIT_V(n) asm volatile("s_waitcnt vmcnt(" #n ")" ::: "memory")
#define PG8_WAIT_L(n) asm volatile("s_waitcnt lgkmcnt(" #n ")" ::: "memory")
#define PG8_BAR __builtin_amdgcn_s_barrier()
#define PG8_SCHED __builtin_amdgcn_sched_barrier(0)
    Unit cur, nxt; int ui = 0;
    if (!S.next(0, cur)) return;
    f32x4 acc[2][2][4][2];
#pragma unroll
    for (int a = 0; a < 2; ++a)
#pragma unroll
        for (int b = 0; b < 2; ++b)
#pragma unroll
            for (int m = 0; m < 4; ++m)
#pragma unroll
                for (int n = 0; n < 2; ++n) acc[a][b][m][n] = (f32x4){0.f, 0.f, 0.f, 0.f};
    bf16x8 At[4][2], B0[2][2], B1[2][2];
    const char* cA = (const char*)g.A + (size_t)cur.pm * tstep; const char* cB = (const char*)g.Bt + (size_t)cur.pn * tstep;
    S.a_ready(cur);
    PG8_STAGE(PG8_SB(0, 0), cB, voffB); PG8_STAGE(PG8_SA(0, 0), cA, voffA); PG8_STAGE(PG8_SB(0, 1), cB + hstep, voffB); PG8_STAGE(PG8_SA(0, 1), cA + hstep, voffA);
    if (wr == 1) PG8_BAR;
    PG8_WAIT_V(4); PG8_BAR;
    PG8_STAGE(PG8_SB(1, 0), cB + kstep, voffB); PG8_STAGE(PG8_SA(1, 0), cA + kstep, voffA); PG8_STAGE(PG8_SB(1, 1), cB + hstep + kstep, voffB);
    PG8_WAIT_V(6); PG8_BAR;
    for (;;) {
        const bool has_next = S.next(ui + 1, nxt);
        const char* nA = has_next ? (const char*)g.A + (size_t)nxt.pm * tstep : cA; const char* nB = has_next ? (const char*)g.Bt + (size_t)nxt.pn * tstep : cB;
        for (int t = 0; t < nt; t += 2) {
            const bool last = (t == nt - 2);
            const char* a1 = cA + (size_t)(t + 1) * kstep;
            const char* a2 = last ? nA : cA + (size_t)(t + 2) * kstep; const char* b2 = last ? nB : cB + (size_t)(t + 2) * kstep;
            const char* a3 = a2 + kstep; const char* b3 = b2 + kstep;
            if (last && has_next) S.a_ready(nxt);
            PG8_LDB(B0, 0, 0); PG8_SCHED; PG8_LDA(At, 0, 0); PG8_STAGE(PG8_SA(1, 1), a1 + hstep, voffA);
            PG8_WAIT_L(8); PG8_BAR; PG8_WAIT_L(0); PG8_MMA(0, 0, At, B0); PG8_BAR; PG8_SCHED;
            PG8_LDB(B1, 0, 1); PG8_STAGE(PG8_SB(0, 0), b2, voffB);
            PG8_BAR; PG8_WAIT_L(0); PG8_MMA(0, 1, At, B1); PG8_BAR;
            PG8_LDA(At, 0, 1); PG8_STAGE(PG8_SA(0, 0), a2, voffA);
            PG8_BAR; PG8_WAIT_L(0); PG8_MMA(1, 0, At, B0); PG8_BAR; PG8_SCHED;
            PG8_STAGE(PG8_SB(0, 1), b2 + hstep, voffB);
            PG8_WAIT_V(6); PG8_BAR; PG8_MMA(1, 1, At, B1); PG8_BAR;
            PG8_LDB(B0, 1, 0); PG8_SCHED; PG8_LDA(At, 1, 0); PG8_STAGE(PG8_SA(0, 1), a2 + hstep, voffA);
            PG8_WAIT_L(8); PG8_BAR; PG8_WAIT_L(0); PG8_MMA(0, 0, At, B0); PG8_BAR; PG8_SCHED;
            PG8_LDB(B1, 1, 1); PG8_STAGE(PG8_SB(1, 0), b3, voffB);
            PG8_BAR; PG8_WAIT_L(0); PG8_MMA(0, 1, At, B1); PG8_BAR;
            PG8_LDA(At, 1, 1); PG8_STAGE(PG8_SA(1, 0), a3, voffA);
            PG8_BAR; PG8_WAIT_L(0); PG8_MMA(1, 0, At, B0); PG8_BAR; PG8_SCHED;
            PG8_STAGE(PG8_SB(1, 1), b3 + hstep, voffB);
            PG8_WAIT_V(6); PG8_BAR; PG8_MMA(1, 1, At, B1); PG8_BAR;
        }
        E(acc, cur, wr, wc, fr, fq); S.done(cur);
        if (!has_next) break;
#pragma unroll
        for (int a = 0; a < 2; ++a)
#pragma unroll
            for (int b = 0; b < 2; ++b)
#pragma unroll
                for (int m = 0; m < 4; ++m)
#pragma unroll
                    for (int n = 0; n < 2; ++n) acc[a][b][m][n] = (f32x4){0.f, 0.f, 0.f, 0.f};
        cur = nxt; cA = nA; cB = nB; ++ui;
    }
    PG8_WAIT_V(0);
    if (wr == 0) PG8_BAR;
    PG8_BAR;
#undef PG8_SA
#undef PG8_SB
#undef PG8_STAGE
#undef PG8_LDA
#undef PG8_LDB
#undef PG8_MMA
#undef PG8_WAIT_V
#undef PG8_WAIT_L
#undef PG8_BAR
#undef PG8_SCHED
}
}
struct Args { const float* in[22]; float* out; unsigned char* ws; int ph_lo, ph_hi; };
constexpr int D = 1024, SEQ = 2048, NB = 8, MP = NB * SEQ, DB = 128, DSQ = 8, MS = DB * DSQ, M = MP + MS;
constexpr int NPANEL = 23, NPROJ = NPANEL * 256;
constexpr float NORM_EPS = 1e-6f;
constexpr int GLA_DK = 64, GLA_DV = 128, GDN_DK = 128, GDN_DV = 128, CONV_CH = 1536;

constexpr size_t MiB = 1u << 20;
constexpr size_t SZ_PANEL = (size_t)M * 256 * 2;
constexpr size_t WS_CTL = 0, CTL_ZERO_BYTES = 128 * 1024;
constexpr size_t WS_WIN = 1 * MiB;
constexpr size_t WS_WUA = WS_WIN + (size_t)NPROJ * 1024 * 2;
constexpr size_t WS_WUB = WS_WUA + 1 * MiB;
constexpr size_t WS_WO = WS_WUB + 1 * MiB;
constexpr size_t WS_WG = WS_WO + 2 * MiB;
constexpr size_t WS_WP = WS_WG + 2 * MiB;
constexpr size_t WS_SPEC = WS_WP + MiB / 2;
constexpr size_t WS_RSSP = WS_SPEC + (size_t)M * 32 * 2;
constexpr size_t WS_CDEC = WS_RSSP + (size_t)M * 16 * 4;
constexpr size_t WS_PB = WS_CDEC + 4096;
constexpr size_t WS_XN = WS_PB + SZ_PANEL;
constexpr size_t WS_PROJ = WS_XN + (size_t)M * 1024 * 2;
constexpr size_t WS_REC = WS_PROJ + 14 * SZ_PANEL;
constexpr size_t WS_END = WS_REC + (size_t)1024 * 73728;
static_assert(WS_END <= 256 * MiB, "workspace map exceeds 256 MiB");
static_assert(WS_WIN % 256 == 0 && WS_SPEC % 256 == 0 && WS_RSSP % 256 == 0 && WS_PB % 256 == 0 && WS_XN % 256 == 0 && WS_PROJ % 256 == 0 && WS_REC % 256 == 0, "alignment");
constexpr size_t WS_OA = WS_XN, WS_OB = WS_XN + (size_t)M * 512 * 2;
constexpr size_t WS_MERGED = WS_PROJ + 0 * SZ_PANEL;
constexpr size_t WS_H1B = WS_PROJ + 6 * SZ_PANEL;
constexpr size_t WS_PE = WS_PROJ + 10 * SZ_PANEL;
constexpr int PN_QA = 0, PN_KA = 1, PN_VA = 2, PN_ZA = 4, PN_QB = 6, PN_KB = 8, PN_VB = 10, PN_ZB = 12, PN_GA = 14, PN_GB = 18, PN_SPEC = 22;
constexpr size_t OUT_Y = 0, OUT_GLA_P = (size_t)M * D, OUT_GDN_P = OUT_GLA_P + 8 * 4 * 64 * 128, OUT_CONV_P = OUT_GDN_P + 8 * 4 * 128 * 128,
                 OUT_GLA_S = OUT_CONV_P + 8 * 3 * 1536, OUT_GDN_S = OUT_GLA_S + (size_t)128 * 4 * 64 * 128, OUT_CONV_S = OUT_GDN_S + (size_t)128 * 4 * 128 * 128,
                 OUT_TOTAL = OUT_CONV_S + 128 * 3 * 1536;
constexpr int CW_BAR = 1024;

constexpr int RING_OFF = 0, RING_BYTES = 131072;
constexpr int LDS_BYTES = 147456;
constexpr int LDSCTL_OFF = LDS_BYTES - 512, MISC_OFF = LDSCTL_OFF + 320;
constexpr int NWAVES = 8, NTHREADS = 512;

#define GAS __attribute__((address_space(1)))
#define LAS __attribute__((address_space(3)))
typedef unsigned short bf16;
typedef unsigned v4u __attribute__((ext_vector_type(4)));
typedef unsigned v2u __attribute__((ext_vector_type(2)));
typedef float f32x4 __attribute__((ext_vector_type(4)));
typedef GAS unsigned gu32;
#define RLX_AGENT __ATOMIC_RELAXED, __HIP_MEMORY_SCOPE_AGENT
#define LDS_WAIT() asm volatile("s_waitcnt lgkmcnt(0)" ::: "memory")
#define VM_WAIT() asm volatile("s_waitcnt vmcnt(0)" ::: "memory")
__device__ __forceinline__ unsigned f2bf(float f) { unsigned u = __builtin_bit_cast(unsigned, f); return (u + 0x7fffu + ((u >> 16) & 1u)) >> 16; }
__device__ __forceinline__ unsigned pk2(float lo, float hi) { return f2bf(lo) | (f2bf(hi) << 16); }
__device__ __forceinline__ float bf2f(unsigned short b) { return __builtin_bit_cast(float, (unsigned)b << 16); }
__device__ __forceinline__ float bflo(unsigned w) { return __builtin_bit_cast(float, w << 16); }
__device__ __forceinline__ float bfhi(unsigned w) { return __builtin_bit_cast(float, w & 0xffff0000u); }
__device__ __forceinline__ float sigmoidf_(float x) { return 1.f / (1.f + __expf(-x)); }
__device__ __forceinline__ float siluf_(float x) { return x / (1.f + __expf(-x)); }
__device__ __forceinline__ float softplusf_(float x) { return fmaxf(x, 0.f) + log1pf(__expf(-fabsf(x))); }
__device__ __forceinline__ float wave_sum(float v) {
#pragma unroll
    for (int o = 1; o < 64; o <<= 1) v += __shfl_xor(v, o);
    return v;
}

#define XB_TMO      128
#define XB_XCNT(j)  (256  + 64 * (j))
#define XB_XSUB(j)  (1280 + 64 * (j))
#define XB_XGEN(j)  (2304 + 64 * (j))
#define XB_TOP      3328
#define XB_TOPGEN   3392
#define XCD_BAR_WORDS 3456
#define XB_SPIN_CAP (1u << 18)
__device__ __forceinline__ unsigned xb_ld(unsigned* p)              { return __hip_atomic_load(p, __ATOMIC_RELAXED, __HIP_MEMORY_SCOPE_AGENT); }
__device__ __forceinline__ unsigned xb_add(unsigned* p, unsigned v) { return __hip_atomic_fetch_add(p, v, __ATOMIC_RELAXED, __HIP_MEMORY_SCOPE_AGENT); }
__device__ __forceinline__ unsigned xb_xcc_id() { return (unsigned)__builtin_amdgcn_s_getreg((3 << 11) | 20) & 0xFu; }
#define XB_SPIN(cond, bar) do { unsigned _sp = 0; while (cond) { __builtin_amdgcn_s_sleep(1); \
    if ((++_sp & 255u) == 0u) { if (xb_ld(&(bar)[XB_TMO])) break; if (_sp > XB_SPIN_CAP) { atomicAdd(&(bar)[XB_TMO], 1u); break; } } } } while (0)
struct XcdBarrier { unsigned* bar; unsigned x; volatile LAS unsigned* st; };
__device__ __forceinline__ XcdBarrier xcd_barrier_post(unsigned* bar, volatile LAS unsigned* st) {
    XcdBarrier b; b.bar = bar; b.x = xb_xcc_id(); b.st = st;
    if (threadIdx.x == 0) (void)xb_add(&bar[XB_XCNT(b.x)], 1u);
    return b;
}
__device__ __forceinline__ void xcd_barrier_complete(unsigned* bar, unsigned x, unsigned& nloc, unsigned& nx) {
    const unsigned G = gridDim.x * gridDim.y * gridDim.z;
    unsigned sum, cnt, mine, sp = 0u;
    for (;;) {
        sum = 0u; cnt = 0u; mine = 0u;
#pragma unroll
        for (unsigned j = 0; j < 16; ++j) { const unsigned c = xb_ld(&bar[XB_XCNT(j)]); sum += c; cnt += (c > 0u) ? 1u : 0u; mine = (j == x) ? c : mine; }
        if (sum == G) break;
        __builtin_amdgcn_s_sleep(1);
        if ((++sp & 255u) == 0u) { if (xb_ld(&bar[XB_TMO])) break; if (sp > XB_SPIN_CAP) { atomicAdd(&bar[XB_TMO], 1u); break; } }
    }
    nloc = mine > 0u ? mine : 1u; nx = cnt > 0u ? cnt : 1u;
}
__device__ __forceinline__ void xcd_barrier(const XcdBarrier& b) {
    asm volatile("s_waitcnt vmcnt(0)" ::: "memory");
    __syncthreads();
    if (threadIdx.x == 0) {
        unsigned* bar = b.bar;
        __builtin_amdgcn_s_waitcnt(0);
        unsigned nloc = b.st[0], nx = b.st[1];
        if (nloc == 0u) { xcd_barrier_complete(bar, b.x, nloc, nx); b.st[0] = nloc; b.st[1] = nx; }
        const unsigned old = xb_add(&bar[XB_XSUB(b.x)], 1u);
        const unsigned gen = old / nloc;
        if (old + 1u == (gen + 1u) * nloc) {
            __builtin_amdgcn_fence(__ATOMIC_RELEASE, "agent");
            asm volatile("s_waitcnt vmcnt(0)" ::: "memory");
            const unsigned og = xb_add(&bar[XB_TOP], 1u);
            const unsigned tg = og / nx;
            if (og + 1u == (tg + 1u) * nx) xb_add(&bar[XB_TOPGEN], 1u);
            else XB_SPIN(xb_ld(&bar[XB_TOPGEN]) == tg, bar);
            __builtin_amdgcn_fence(__ATOMIC_ACQUIRE, "agent");
            xb_add(&bar[XB_XGEN(b.x)], 1u);
            asm volatile("s_waitcnt vmcnt(0)" ::: "memory");
        } else {
            XB_SPIN(xb_ld(&bar[XB_XGEN(b.x)]) == gen, bar);
            __builtin_amdgcn_fence(__ATOMIC_ACQUIRE, "agent");
            asm volatile("s_waitcnt vmcnt(0)" ::: "memory");
        }
    }
    __syncthreads();
}

struct Frame {
    LAS unsigned char* lds;
    volatile LAS unsigned* MISC;
    int tid, lane, wave, G, vcu;
    const float* in[22];
    float* out;
    unsigned char* ws;
};
__device__ __forceinline__ int win_src_col(int n) {
    if (n < 1024) return n;
    if (n < 3072) return n + 16;
    if (n < 5632) return n + 24;
    if (n < 5648) return 1024 + (n - 5632);
    if (n < 5656) return 3088 + (n - 5648);
    return -1;
}
template <bool MAPCOL>
__device__ __forceinline__ void p0_transpose_item(const float* W, int K, int Nsrc, int Ndst, bf16* WT, LAS float* scr, int item, int lane) {
    const int nblk = Ndst / 32, kb = item / nblk, nb = item % nblk, k0 = 64 * kb, n0 = 32 * nb;
    int sc = n0 + (lane & 31); if (MAPCOL) sc = win_src_col(sc);
#pragma unroll 8
    for (int i = 0; i < 32; ++i) { const int kk = 2 * i + (lane >> 5); scr[kk * 33 + (lane & 31)] = (sc >= 0) ? W[(size_t)(k0 + kk) * Nsrc + sc] : 0.f; }
    LDS_WAIT(); asm volatile("" ::: "memory");
    const int c = lane & 7;
#pragma unroll
    for (int j = 0; j < 4; ++j) { const int n = (lane >> 3) + 8 * j; const LAS float* s = scr + (8 * c) * 33 + n;
        v4u o; o.x = pk2(s[0 * 33], s[1 * 33]); o.y = pk2(s[2 * 33], s[3 * 33]); o.z = pk2(s[4 * 33], s[5 * 33]); o.w = pk2(s[6 * 33], s[7 * 33]);
        *(GAS v4u*)(WT + (size_t)(n0 + n) * K + k0 + 8 * c) = o; }
    LDS_WAIT(); asm volatile("" ::: "memory");
}
__device__ __forceinline__ void rms_row_to_bf16(const float* xrow, const float* w, bf16* orow, int lane) {
    const GAS f32x4* xr = (const GAS f32x4*)xrow + lane;
    const GAS f32x4* wr = (const GAS f32x4*)w + lane;
    f32x4 v[4]; float s = 0.f;
#pragma unroll
    for (int j = 0; j < 4; ++j) { v[j] = xr[64 * j]; s += (v[j].x * v[j].x + v[j].y * v[j].y) + (v[j].z * v[j].z + v[j].w * v[j].w); }
    const float r = 1.f / sqrtf(wave_sum(s) * (1.f / D) + NORM_EPS);
    GAS unsigned long long* o8 = (GAS unsigned long long*)orow + lane;
#pragma unroll
    for (int j = 0; j < 4; ++j) { const f32x4 ww = wr[64 * j];
        o8[64 * j] = (unsigned long long)pk2(v[j].x * r * ww.x, v[j].y * r * ww.y) | ((unsigned long long)pk2(v[j].z * r * ww.z, v[j].w * r * ww.w) << 32); }
}
__device__ __forceinline__ void p0_prologue(const Args& A, LAS unsigned char* lds, int vcu, int G, int wave, int lane) {
    LAS float* scr = (LAS float*)(lds + RING_OFF + wave * 16384);
    const int gw = vcu * NWAVES + wave, NGW = G * NWAVES;
    unsigned char* ws = A.ws;
    constexpr int I_IN = (1024 / 64) * (NPROJ / 32), I_UP = (512 / 64) * (1024 / 32), I_SQ = (1024 / 64) * (1024 / 32), I_PL = (256 / 64) * (1024 / 32);
    constexpr int NITEMS = I_IN + 2 * I_UP + 2 * I_SQ + I_PL;
    for (int it = gw; it < NITEMS; it += NGW) {
        int r = it;
        if (r < I_IN) { p0_transpose_item<true>(A.in[8], 1024, 5656, NPROJ, (bf16*)(ws + WS_WIN), scr, r, lane); continue; } r -= I_IN;
        if (r < I_UP) { p0_transpose_item<false>(A.in[16], 512, 1024, 1024, (bf16*)(ws + WS_WUA), scr, r, lane); continue; } r -= I_UP;
        if (r < I_UP) { p0_transpose_item<false>(A.in[17], 512, 1024, 1024, (bf16*)(ws + WS_WUB), scr, r, lane); continue; } r -= I_UP;
        if (r < I_SQ) { p0_transpose_item<false>(A.in[18], 1024, 1024, 1024, (bf16*)(ws + WS_WO), scr, r, lane); continue; } r -= I_SQ;
        if (r < I_SQ) { p0_transpose_item<false>(A.in[19], 1024, 1024, 1024, (bf16*)(ws + WS_WG), scr, r, lane); continue; } r -= I_SQ;
        p0_transpose_item<false>(A.in[20], 256, 1024, 1024, (bf16*)(ws + WS_WP), scr, r, lane);
    }
    bf16* XN = (bf16*)(ws + WS_XN);
    for (int m = gw; m < M; m += NGW) {
        const float* xrow = (m < MP) ? A.in[0] + (size_t)m * D : A.in[1] + (size_t)(m - MP) * D;
        rms_row_to_bf16(xrow, A.in[7], XN + (size_t)m * D, lane);
    }
    bf16* PB = (bf16*)(ws + WS_PB);
    const int gt = gw * 64 + lane, NGT = NGW * 64;
    for (int i = gt; i < M * 256 / 8; i += NGT) {
        const size_t e = (size_t)i * 8; const int m = (int)(e >> 8), c = (int)(e & 255);
        const float* src = (m < MP) ? A.in[5] + (size_t)m * 256 + c : A.in[6] + (size_t)(m - MP) * 256 + c;
        const f32x4 a = *(const GAS f32x4*)src, b = *(const GAS f32x4*)(src + 4);
        v4u o; o.x = pk2(a.x, a.y); o.y = pk2(a.z, a.w); o.z = pk2(b.x, b.y); o.w = pk2(b.z, b.w);
        *(GAS v4u*)(PB + e) = o;
    }
}
__device__ __forceinline__ const bf16* panel(const unsigned char* ws, int pn) { return (const bf16*)(ws + WS_PROJ + (size_t)pn * SZ_PANEL); }
#ifdef PROBE_WG
#define STAMP3(k) do { if (threadIdx.x == 0) ((unsigned long long*)(A.ws + WS_CTL + 65536))[(size_t)blockIdx.x * 16 + (k)] = __builtin_amdgcn_s_memrealtime(); } while (0)
#else
#define STAMP3(k) do { } while (0)
#endif
#define LBAR() do { asm volatile("s_waitcnt lgkmcnt(0)" ::: "memory"); __builtin_amdgcn_s_barrier(); asm volatile("" ::: "memory"); } while (0)
template <int CTRL> __device__ __forceinline__ float dpp_f(float v) { return __builtin_bit_cast(float, __builtin_amdgcn_update_dpp(0, __builtin_bit_cast(int, v), CTRL, 0xf, 0xf, true)); }
__device__ __forceinline__ float rl_f(float v, int l) { return __builtin_bit_cast(float, __builtin_amdgcn_readlane(__builtin_bit_cast(int, v), l)); }
__device__ __forceinline__ float wsum(float v) {
    v += dpp_f<0xB1>(v); v += dpp_f<0x4E>(v); v += dpp_f<0x141>(v); v += dpp_f<0x140>(v);
    return (rl_f(v, 0) + rl_f(v, 16)) + (rl_f(v, 32) + rl_f(v, 48));
}
__device__ __forceinline__ float quad_sum(float v) { v += dpp_f<0xB1>(v); v += dpp_f<0x4E>(v); return v; }

__device__ __forceinline__ void gla_item_s(const Args& A, LAS unsigned char* lds, int h, int m0, const float* S0, float* Sout) {
    const int tid = threadIdx.x, lane = tid & 63, wave = tid >> 6;
    const unsigned char* ws = A.ws;
    LAS float* sq = (LAS float*)lds; LAS float* sk = sq + 512; LAS float* sd = sk + 512; LAS float* sv = sd + 512; LAS float* part = sv + 1024; LAS float* oraw = part + 1024;
    const int dv = tid & 127, g = tid >> 7;
    float S[16];
#pragma unroll
    for (int i = 0; i < 16; ++i) S[i] = S0[(size_t)(g * 16 + i) * 128 + dv];
    const bf16* PQ = panel(ws, PN_QA); const bf16* PK = panel(ws, PN_KA); const bf16* PV = panel(ws, PN_VA + (h >> 1)); const bf16* PZ = panel(ws, PN_ZA + (h >> 1));
    const bf16* SPEC = (const bf16*)(ws + WS_SPEC);
    const size_t mt = (size_t)m0 + wave;
    const unsigned short qh = PQ[mt * 256 + h * 64 + lane], kh = PK[mt * 256 + h * 64 + lane];
    const unsigned vw = *(const GAS unsigned*)(PV + mt * 256 + (h & 1) * 128 + 2 * lane);
    const unsigned zw = *(const GAS unsigned*)(PZ + mt * 256 + (h & 1) * 128 + 2 * lane);
    const v4u ga0 = *(const GAS v4u*)(SPEC + mt * 32), ga1 = *(const GAS v4u*)(SPEC + mt * 32 + 8);
    float wg[16];
#pragma unroll
    for (int r = 0; r < 16; ++r) wg[r] = A.in[9][r * 256 + h * 64 + lane];
    const float bgv = A.in[10][h * 64 + lane];
    const float nw0 = A.in[11][2 * lane], nw1 = A.in[11][2 * lane + 1];
    { float x = bgv; const unsigned gw[8] = {ga0.x, ga0.y, ga0.z, ga0.w, ga1.x, ga1.y, ga1.z, ga1.w};
#pragma unroll
      for (int r = 0; r < 8; ++r) x += bflo(gw[r]) * wg[2 * r] + bfhi(gw[r]) * wg[2 * r + 1];
      const float ls = fminf(x, 0.f) - log1pf(__expf(-fabsf(x)));
      sd[wave * 64 + lane] = __expf(ls * (1.f / 16.f)); sq[wave * 64 + lane] = bf2f(qh) * 0.125f; sk[wave * 64 + lane] = bf2f(kh);
      sv[wave * 128 + 2 * lane] = bflo(vw); sv[wave * 128 + 2 * lane + 1] = bfhi(vw); }
    LBAR();
#pragma unroll 1
    for (int tk = 0; tk < 8; ++tk) {
        const float vv = sv[tk * 128 + dv];
        float po = 0.f;
#pragma unroll
        for (int i = 0; i < 16; ++i) { const int dk = g * 16 + i; S[i] = sd[tk * 64 + dk] * S[i] + sk[tk * 64 + dk] * vv; po += sq[tk * 64 + dk] * S[i]; }
        part[((tk & 1) * 4 + g) * 128 + dv] = po;
        LBAR();
        if (g == 0) { const LAS float* pp = part + (tk & 1) * 512 + dv; oraw[tk * 128 + dv] = (pp[0] + pp[128]) + (pp[256] + pp[384]); }
    }
#pragma unroll
    for (int i = 0; i < 16; ++i) Sout[(size_t)(g * 16 + i) * 128 + dv] = S[i];
    LBAR();
    { bf16* OA = (bf16*)(A.ws + WS_OA);
      const float o0 = oraw[wave * 128 + 2 * lane], o1 = oraw[wave * 128 + 2 * lane + 1];
      const float r = 1.f / sqrtf(wsum(o0 * o0 + o1 * o1) * (1.f / 128.f) + NORM_EPS);
      *(GAS unsigned*)(OA + mt * 512 + h * 128 + 2 * lane) = pk2(o0 * r * nw0 * siluf_(bflo(zw)), o1 * r * nw1 * siluf_(bfhi(zw))); }
    LBAR();
}

__device__ __forceinline__ void gdn_item_s(const Args& A, LAS unsigned char* lds, int h, int m0, const float* S0, float* Sout, const float* convbuf) {
    const int tid = threadIdx.x, lane = tid & 63, wave = tid >> 6;
    const unsigned char* ws = A.ws;
    LAS float* sq = (LAS float*)lds; LAS float* sk = sq + 1024; LAS float* sv = sk + 1024; LAS float* sbeta = sv + 1024; LAS float* sgd = sbeta + 8; LAS float* sqk = sgd + 8;
    LAS float* part = sqk + 16; LAS float* oraw = part + 2048;
    const int dv = tid & 127, g = tid >> 7;
    float S[32];
#pragma unroll
    for (int i = 0; i < 32; ++i) S[i] = S0[(size_t)(g * 32 + i) * 128 + dv];
    const bf16* SPEC = (const bf16*)(ws + WS_SPEC);
    const size_t mt = (size_t)m0 + wave;
    const bf16* PZ = panel(ws, PN_ZB + (h >> 1));
    const unsigned zw = *(const GAS unsigned*)(PZ + mt * 256 + (h & 1) * 128 + 2 * lane);
    const float nw0 = A.in[15][2 * lane], nw1 = A.in[15][2 * lane + 1];
    float raw[11], cw[4]; const int c = tid, seg = c >> 7, cc = c & 127;
    if (tid < 384) { const bf16* P = panel(ws, PN_QB + 2 * seg + (h >> 1)); const int ch = seg * 512 + h * 128 + cc;
#pragma unroll
        for (int j = 0; j < 3; ++j) raw[j] = convbuf[j * 1536 + ch];
#pragma unroll
        for (int j = 0; j < 8; ++j) raw[3 + j] = bf2f(P[(size_t)(m0 + j) * 256 + (h & 1) * 128 + cc]);
#pragma unroll
        for (int j = 0; j < 4; ++j) cw[j] = A.in[12][j * 1536 + ch]; }
    float bta = 0.f, gdv = 0.f;
    if (tid < 8) { const size_t m = (size_t)m0 + tid; bta = bf2f(SPEC[m * 32 + 20 + h]); gdv = bf2f(SPEC[m * 32 + 16 + h]); }
    const float negA = -__expf(A.in[13][h]), dtb = A.in[14][h];
    if (tid < 384) { LAS float* dst = seg == 0 ? sq : (seg == 1 ? sk : sv);
#pragma unroll
        for (int t = 0; t < 8; ++t) dst[t * 128 + cc] = siluf_(cw[0] * raw[t] + cw[1] * raw[t + 1] + cw[2] * raw[t + 2] + cw[3] * raw[t + 3]); }
    if (tid < 8) { sbeta[tid] = sigmoidf_(bta); sgd[tid] = __expf(negA * softplusf_(gdv + dtb)); }
    LBAR();
    { float q0 = sq[wave * 128 + lane], q1 = sq[wave * 128 + lane + 64], k0 = sk[wave * 128 + lane], k1 = sk[wave * 128 + lane + 64];
      const float rq = 0.08838834764831845f / sqrtf(wsum(q0 * q0 + q1 * q1) + NORM_EPS), rk = 1.f / sqrtf(wsum(k0 * k0 + k1 * k1) + NORM_EPS);
      q0 *= rq; q1 *= rq; k0 *= rk; k1 *= rk;
      sq[wave * 128 + lane] = q0; sq[wave * 128 + lane + 64] = q1; sk[wave * 128 + lane] = k0; sk[wave * 128 + lane + 64] = k1;
      const float qk = wsum(q0 * k0 + q1 * k1); if (lane == 0) sqk[wave] = qk; }
    LBAR();
#pragma unroll 1
    for (int tk = 0; tk < 8; ++tk) {
        float pk = 0.f, pq = 0.f;
#pragma unroll
        for (int i = 0; i < 32; ++i) { const int dk = g * 32 + i; pk += sk[tk * 128 + dk] * S[i]; pq += sq[tk * 128 + dk] * S[i]; }
        LAS float* pp = part + (tk & 1) * 1024;
        pp[g * 128 + dv] = pk; pp[512 + g * 128 + dv] = pq;
        LBAR();
        const float gd = sgd[tk];
        const float kS = gd * ((pp[dv] + pp[128 + dv]) + (pp[256 + dv] + pp[384 + dv]));
        const float vnew = sbeta[tk] * (sv[tk * 128 + dv] - kS);
#pragma unroll
        for (int i = 0; i < 32; ++i) { const int dk = g * 32 + i; S[i] = gd * S[i] + sk[tk * 128 + dk] * vnew; }
        if (g == 0) { const float qS = gd * ((pp[512 + dv] + pp[640 + dv]) + (pp[768 + dv] + pp[896 + dv])); oraw[tk * 128 + dv] = qS + sqk[tk] * vnew; }
    }
#pragma unroll
    for (int i = 0; i < 32; ++i) Sout[(size_t)(g * 32 + i) * 128 + dv] = S[i];
    LBAR();
    { bf16* OB = (bf16*)(A.ws + WS_OB);
      const float o0 = oraw[wave * 128 + 2 * lane], o1 = oraw[wave * 128 + 2 * lane + 1];
      const float r = 1.f / sqrtf(wsum(o0 * o0 + o1 * o1) * (1.f / 128.f) + NORM_EPS);
      *(GAS unsigned*)(OB + mt * 512 + h * 128 + 2 * lane) = pk2(o0 * r * nw0 * siluf_(bflo(zw)), o1 * r * nw1 * siluf_(bfhi(zw))); }
    LBAR();
}
typedef short bf16x8 __attribute__((ext_vector_type(8)));
typedef float f32x16 __attribute__((ext_vector_type(16)));
typedef float f32x4v __attribute__((ext_vector_type(4)));
typedef float f32x2v __attribute__((ext_vector_type(2)));
#define MFMA32(a, b, c) __builtin_amdgcn_mfma_f32_32x32x16_bf16((a), (b), (c), 0, 0, 0)
#define MFMA16(a, b, c) __builtin_amdgcn_mfma_f32_16x16x32_bf16((a), (b), (c), 0, 0, 0)
__device__ __forceinline__ int c32row(int lane, int reg) { return (reg & 3) + 8 * (reg >> 2) + 4 * (lane >> 5); }
__device__ __forceinline__ bf16x8 acc_frag(const f32x16& c, int s) {
    v4u w;
    if (s == 0) { w.x = pg8::cvt_pk_bf16(c[0], c[1]); w.y = pg8::cvt_pk_bf16(c[2], c[3]); w.z = pg8::cvt_pk_bf16(c[4], c[5]); w.w = pg8::cvt_pk_bf16(c[6], c[7]); }
    else { w.x = pg8::cvt_pk_bf16(c[8], c[9]); w.y = pg8::cvt_pk_bf16(c[10], c[11]); w.z = pg8::cvt_pk_bf16(c[12], c[13]); w.w = pg8::cvt_pk_bf16(c[14], c[15]); }
    return __builtin_bit_cast(bf16x8, w);
}
__device__ __forceinline__ bf16x8 lds_frag(const LAS bf16* rowp, int k0, int h) { return *(const LAS bf16x8*)(rowp + k0 + 8 * h); }
__device__ __forceinline__ bf16x8 lds_frag_perm(const LAS bf16* rowp, int s, int h) {
    const v2u a = *(const LAS v2u*)(rowp + 16 * s + 4 * h), b = *(const LAS v2u*)(rowp + 16 * s + 8 + 4 * h);
    v4u w; w.x = a.x; w.y = a.y; w.z = b.x; w.w = b.y; return __builtin_bit_cast(bf16x8, w);
}
__device__ __forceinline__ f32x16 zero16() { f32x16 z;
#pragma unroll
    for (int i = 0; i < 16; ++i) z[i] = 0.f; return z; }

__device__ __forceinline__ v4u pack8(const f32x4 a, const f32x4 b) { v4u w; w.x = pg8::cvt_pk_bf16(a.x, a.y); w.y = pg8::cvt_pk_bf16(a.z, a.w); w.z = pg8::cvt_pk_bf16(b.x, b.y); w.w = pg8::cvt_pk_bf16(b.z, b.w); return w; }
__device__ __forceinline__ void unpack8(const v4u w, f32x4& a, f32x4& b) { a = (f32x4){bflo(w.x), bfhi(w.x), bflo(w.y), bfhi(w.y)}; b = (f32x4){bflo(w.z), bfhi(w.z), bflo(w.w), bfhi(w.w)}; }
__device__ __forceinline__ f32x4 sig4(const f32x4 x) { return (f32x4){sigmoidf_(x.x), sigmoidf_(x.y), sigmoidf_(x.z), sigmoidf_(x.w)}; }
constexpr int GLA_QE = 0, GLA_KE = 9216, GLA_KENDT = 18432, GLA_VT = 27648, GLA_ATT = 46080, GLA_GA = 55296, GLA_SEG = 59392, GLA_DD = 61440, GLA_OBUF = 61696, GLA_LDS_END = GLA_OBUF + 64 * 132 * 4;
static_assert(GLA_LDS_END <= 131072, "GLA LDS");
struct GlaState { f32x16 S[2]; bf16x8 Sb[4]; };
struct GlaPre { unsigned vv[8]; unsigned short qh[8], kh[8]; unsigned ga; };
__device__ __forceinline__ void gla_touch(const GlaPre& p) {
    asm volatile("" :: "v"(p.vv[0]), "v"(p.vv[1]), "v"(p.vv[2]), "v"(p.vv[3]), "v"(p.vv[4]), "v"(p.vv[5]), "v"(p.vv[6]), "v"(p.vv[7]), "v"(p.ga));
    asm volatile("" :: "v"(p.qh[0]), "v"(p.qh[1]), "v"(p.qh[2]), "v"(p.qh[3]), "v"(p.qh[4]), "v"(p.qh[5]), "v"(p.qh[6]), "v"(p.qh[7]));
    asm volatile("" :: "v"(p.kh[0]), "v"(p.kh[1]), "v"(p.kh[2]), "v"(p.kh[3]), "v"(p.kh[4]), "v"(p.kh[5]), "v"(p.kh[6]), "v"(p.kh[7]));
}
#define SB0() __builtin_amdgcn_sched_barrier(0)
__device__ __forceinline__ void gla_prefetch(const Args& A, int b, int h, int n, GlaPre& p) {
    const int tid = threadIdx.x, lane = tid & 63, wave = tid >> 6;
    const unsigned char* ws = A.ws; const size_t m0 = (size_t)b * SEQ + (size_t)n * 64;
    const bf16* PQ = panel(ws, PN_QA); const bf16* PK = panel(ws, PN_KA); const bf16* PV = panel(ws, PN_VA + (h >> 1)); const bf16* SPEC = (const bf16*)(ws + WS_SPEC);
    p.ga = *(const GAS unsigned*)(SPEC + (m0 + (tid >> 3)) * 32 + (tid & 7) * 2);
#pragma unroll
    for (int i = 0; i < 8; ++i) p.vv[i] = *(const GAS unsigned*)(PV + (m0 + wave * 8 + i) * 256 + (h & 1) * 128 + 2 * lane);
    const int dk = tid & 63, seg = tid >> 6;
#pragma unroll
    for (int i = 0; i < 8; ++i) { p.qh[i] = PQ[(m0 + seg * 8 + i) * 256 + h * 64 + dk]; p.kh[i] = PK[(m0 + seg * 8 + i) * 256 + h * 64 + dk]; }
}
__device__ __forceinline__ void gla_chunk(const Args& A, LAS unsigned char* lds, int b, int h, int n, GlaState& st, const float (&wg)[16], float bgv, GlaPre& cur, float nw0, float nw1) {
    const int tid = threadIdx.x, lane = tid & 63, wave = __builtin_amdgcn_readfirstlane(tid >> 6), r = lane & 31, hh = lane >> 5;
    const unsigned char* ws = A.ws;
    const size_t m0 = (size_t)b * SEQ + (size_t)n * 64;
    LAS bf16* QE = (LAS bf16*)(lds + GLA_QE); LAS bf16* KE = (LAS bf16*)(lds + GLA_KE); LAS bf16* KENDT = (LAS bf16*)(lds + GLA_KENDT);
    LAS bf16* VT = (LAS bf16*)(lds + GLA_VT); LAS bf16* ATT = (LAS bf16*)(lds + GLA_ATT);
    LAS float* GA = (LAS float*)(lds + GLA_GA); LAS float* SEG = (LAS float*)(lds + GLA_SEG); LAS float* DD = (LAS float*)(lds + GLA_DD); LAS float* OBUF = (LAS float*)(lds + GLA_OBUF);
    const bf16* PZ = panel(ws, PN_ZA + (h >> 1));
    if (n == 2) STAMP3(0);
    unsigned zw[8];
#pragma unroll
    for (int i = 0; i < 8; ++i) zw[i] = *(const GAS unsigned*)(PZ + (m0 + wave * 8 + i) * 256 + (h & 1) * 128 + 2 * lane);
    { const int t = tid >> 3, c2 = (tid & 7) * 2; GA[t * 16 + c2] = bflo(cur.ga); GA[t * 16 + c2 + 1] = bfhi(cur.ga); }
    { const unsigned* vv = cur.vv;
      v4u lo, hi; lo.x = (vv[0] & 0xffffu) | (vv[1] << 16); lo.y = (vv[2] & 0xffffu) | (vv[3] << 16); lo.z = (vv[4] & 0xffffu) | (vv[5] << 16); lo.w = (vv[6] & 0xffffu) | (vv[7] << 16);
      hi.x = (vv[0] >> 16) | (vv[1] & 0xffff0000u); hi.y = (vv[2] >> 16) | (vv[3] & 0xffff0000u); hi.z = (vv[4] >> 16) | (vv[5] & 0xffff0000u); hi.w = (vv[6] >> 16) | (vv[7] & 0xffff0000u);
      *(LAS v4u*)(VT + (2 * lane) * 72 + wave * 8) = lo; *(LAS v4u*)(VT + (2 * lane + 1) * 72 + wave * 8) = hi; }
    LBAR();
    if (n == 2) STAMP3(1);
    const int dk = tid & 63, seg = tid >> 6;
    float cs[8];
    { float run = 0.f;
#pragma unroll
      for (int i = 0; i < 8; ++i) { const int t = seg * 8 + i; float x = bgv;
#pragma unroll
          for (int q = 0; q < 4; ++q) { const f32x4v g4 = *(const LAS f32x4v*)(GA + t * 16 + 4 * q); x += g4[0] * wg[4 * q] + g4[1] * wg[4 * q + 1] + g4[2] * wg[4 * q + 2] + g4[3] * wg[4 * q + 3]; }
          const float ls = fminf(x, 0.f) - __logf(1.f + __expf(-fabsf(x)));
          run += ls * (1.f / 16.f); cs[i] = run; }
      SEG[seg * 64 + dk] = run; }
    LBAR();
    if (n == 2) STAMP3(2);
    { float off = 0.f, tot = 0.f;
#pragma unroll
      for (int s = 0; s < 8; ++s) { const float v = SEG[s * 64 + dk]; tot += v; if (s < seg) off += v; }
      unsigned kend[4];
#pragma unroll
      for (int i = 0; i < 8; ++i) { const int t = seg * 8 + i; const float bb = off + cs[i];
          const float q = bf2f(cur.qh[i]), k = bf2f(cur.kh[i]);
          QE[t * 72 + dk] = (bf16)f2bf(q * 0.125f * __expf(bb)); KE[t * 72 + dk] = (bf16)f2bf(k * __expf(-bb));
          const unsigned ke = f2bf(k * __expf(tot - bb)); if (i & 1) kend[i >> 1] |= ke << 16; else kend[i >> 1] = ke; }
      v4u kw; kw.x = kend[0]; kw.y = kend[1]; kw.z = kend[2]; kw.w = kend[3];
      *(LAS v4u*)(KENDT + dk * 72 + seg * 8) = kw;
      if (seg == 0) DD[dk] = __expf(tot); }
    if (n + 1 < 32) gla_prefetch(A, b, h, n + 1, cur);
    LBAR();
    if (n == 2) STAMP3(3);
    if (wave < 3) { const int tp = (wave == 2) ? 1 : 0, mt = (wave == 0) ? 0 : 1;
        f32x16 acc = zero16(); bf16x8 fa[4], fb[4];
#pragma unroll
        for (int s = 0; s < 4; ++s) { fa[s] = lds_frag(KE + (32 * tp + r) * 72, 16 * s, hh); fb[s] = lds_frag(QE + (32 * mt + r) * 72, 16 * s, hh); }
        SB0();
#pragma unroll
        for (int s = 0; s < 4; ++s) acc = MFMA32(fa[s], fb[s], acc);
        SB0();
        const int t = 32 * mt + r;
#pragma unroll
        for (int q = 0; q < 4; ++q) { const int tq = 32 * tp + 8 * q + 4 * hh; float v[4];
#pragma unroll
            for (int e = 0; e < 4; ++e) v[e] = (tq + e <= t) ? acc[4 * q + e] : 0.f;
            v2u w; w.x = pg8::cvt_pk_bf16(v[0], v[1]); w.y = pg8::cvt_pk_bf16(v[2], v[3]); *(LAS v2u*)(ATT + t * 72 + tq) = w; } }
    LBAR();
    if (n == 2) STAMP3(4);
    if (wave < 4) {
        const LAS bf16* vrow = VT + (32 * wave + r) * 72;
        bf16x8 vb[4], fa[6], fb[4];
#pragma unroll
        for (int s = 0; s < 4; ++s) vb[s] = lds_frag(vrow, 16 * s, hh);
        fa[0] = lds_frag(ATT + r * 72, 0, hh); fa[1] = lds_frag(ATT + r * 72, 16, hh);
#pragma unroll
        for (int s = 0; s < 4; ++s) fa[2 + s] = lds_frag(ATT + (32 + r) * 72, 16 * s, hh);
#pragma unroll
        for (int s = 0; s < 4; ++s) fb[s] = lds_frag_perm(QE + r * 72, s, hh);
        SB0();
        f32x16 O0 = zero16(), O1 = zero16();
        O0 = MFMA32(fa[0], vb[0], O0); O0 = MFMA32(fa[1], vb[1], O0);
#pragma unroll
        for (int s = 0; s < 4; ++s) O1 = MFMA32(fa[2 + s], vb[s], O1);
        SB0();
#pragma unroll
        for (int s = 0; s < 4; ++s) fa[s] = lds_frag_perm(QE + (32 + r) * 72, s, hh);
        SB0();
#pragma unroll
        for (int s = 0; s < 4; ++s) O0 = MFMA32(fb[s], st.Sb[s], O0);
        SB0();
#pragma unroll
        for (int s = 0; s < 4; ++s) fb[s] = lds_frag(KENDT + r * 72, 16 * s, hh);
        SB0();
#pragma unroll
        for (int s = 0; s < 4; ++s) O1 = MFMA32(fa[s], st.Sb[s], O1);
#pragma unroll
        for (int g2 = 0; g2 < 16; ++g2) st.S[0][g2] *= DD[c32row(lane, g2)];
        SB0();
#pragma unroll
        for (int s = 0; s < 4; ++s) fa[s] = lds_frag(KENDT + (32 + r) * 72, 16 * s, hh);
        SB0();
#pragma unroll
        for (int s = 0; s < 4; ++s) st.S[0] = MFMA32(fb[s], vb[s], st.S[0]);
#pragma unroll
        for (int g2 = 0; g2 < 16; ++g2) st.S[1][g2] *= DD[32 + c32row(lane, g2)];
#pragma unroll
        for (int g2 = 0; g2 < 16; ++g2) OBUF[c32row(lane, g2) * 132 + 32 * wave + r] = O0[g2];
        SB0();
#pragma unroll
        for (int s = 0; s < 4; ++s) st.S[1] = MFMA32(fa[s], vb[s], st.S[1]);
#pragma unroll
        for (int g2 = 0; g2 < 16; ++g2) OBUF[(32 + c32row(lane, g2)) * 132 + 32 * wave + r] = O1[g2];
        st.Sb[0] = acc_frag(st.S[0], 0); st.Sb[1] = acc_frag(st.S[0], 1);
        SB0();
        st.Sb[2] = acc_frag(st.S[1], 0); st.Sb[3] = acc_frag(st.S[1], 1);
    }
    gla_touch(cur);
    LBAR();
    if (n == 2) STAMP3(5);
    { bf16* OA = (bf16*)(A.ws + WS_OA);
#pragma unroll
      for (int i = 0; i < 8; ++i) { const int t = wave * 8 + i; const size_t m = m0 + t;
          const float o0 = OBUF[t * 132 + 2 * lane], o1 = OBUF[t * 132 + 2 * lane + 1];
          const float rr = 1.f / sqrtf(wsum(o0 * o0 + o1 * o1) * (1.f / 128.f) + NORM_EPS);
          *(GAS unsigned*)(OA + m * 512 + h * 128 + 2 * lane) = pk2(o0 * rr * nw0 * siluf_(bflo(zw[i])), o1 * rr * nw1 * siluf_(bfhi(zw[i]))); } }
    LBAR();
    if (n == 2) STAMP3(6);
}
__device__ __forceinline__ void gla_final(const Args& A, int c, const GlaState& st) {
    const int tid = threadIdx.x, lane = tid & 63, wave = tid >> 6, r = lane & 31;
    if (wave < 4) { float* So = A.out + OUT_GLA_P + (size_t)c * 64 * 128;
#pragma unroll
        for (int mk = 0; mk < 2; ++mk)
#pragma unroll
            for (int g = 0; g < 16; ++g) So[(size_t)(32 * mk + c32row(lane, g)) * 128 + 32 * wave + r] = st.S[mk][g]; }
}
constexpr size_t REC_BYTES = 73728; constexpr int REC_W = 0, REC_QE = 16384, REC_QK = 32768, REC_KT = 40960, REC_U = 57344, REC_LDS = 57344;
constexpr int R1_KN = 0, R1_QN = 17408, R1_KNT = 34816, R1_VT = 53248, R1_AM = 71680, R1_ANEG = 89088, R1_DINV = 98304, R1_TB = 101376, R1_TBD = 110592, R1_TAB = 119808, R1_CW = R1_TAB + 1024, R1_END = R1_CW + 4 * 4 * 384 * 4;
static_assert(R1_END <= LDS_BYTES - 512, "R1 LDS");
struct R1Pre { unsigned raw[11][3]; unsigned short ab, bb; };
__device__ __forceinline__ void r1_touch(const R1Pre& p) {
#pragma unroll
    for (int rr = 0; rr < 11; ++rr) asm volatile("" :: "v"(p.raw[rr][0]), "v"(p.raw[rr][1]), "v"(p.raw[rr][2]));
    asm volatile("" :: "v"(p.ab), "v"(p.bb));
}
__device__ __forceinline__ float wscan(float v, int lane) {
    v += dpp_f<0x111>(v); v += dpp_f<0x112>(v); v += dpp_f<0x114>(v); v += dpp_f<0x118>(v);
    const float t0 = rl_f(v, 15), t1 = rl_f(v, 31), t2 = rl_f(v, 47); const int row = lane >> 4;
    return v + (row > 0 ? t0 : 0.f) + (row > 1 ? t1 : 0.f) + (row > 2 ? t2 : 0.f);
}
__device__ __forceinline__ void r1_prefetch(const Args& A, int u, R1Pre& p) {
    const int tid = threadIdx.x, lane = tid & 63, wave = tid >> 6;
    const int bh = u >> 5, n = u & 31, b = bh >> 2, h = bh & 3; const unsigned char* ws = A.ws;
    const bf16* SPEC = (const bf16*)(ws + WS_SPEC); const size_t m = (size_t)b * SEQ + (size_t)n * 64 + lane;
    p.ab = SPEC[m * 32 + 16 + h]; p.bb = SPEC[m * 32 + 20 + h];
    const int t0 = wave * 8;
#pragma unroll
    for (int rr = 0; rr < 11; ++rr) { const int t = n * 64 + t0 - 3 + rr;
#pragma unroll
        for (int sg = 0; sg < 3; ++sg) { unsigned w = 0u;
            if (t >= 0) w = *(const GAS unsigned*)(panel(ws, PN_QB + 2 * sg + (h >> 1)) + ((size_t)b * SEQ + t) * 256 + (h & 1) * 128 + 2 * lane);
            p.raw[rr][sg] = w; } }
}
__device__ __forceinline__ void r1_stage_cw(const Args& A, LAS unsigned char* lds) {
    LAS float* CW = (LAS float*)(lds + R1_CW);
    for (int i = threadIdx.x; i < 4 * 4 * 384; i += NTHREADS) { const int cc = i & 127, sg = (i >> 7) % 3, j = (i / 384) & 3, h = i / 1536; CW[i] = A.in[12][j * 1536 + sg * 512 + h * 128 + cc]; }
    LBAR();
}
__device__ __forceinline__ void st_frag(unsigned char* g, int frag, int lane, const v4u w) { *(GAS v4u*)(g + (size_t)frag * 1024 + lane * 16) = w; }

__device__ __forceinline__ void gdn_r1_unit(const Args& A, LAS unsigned char* lds, int u, R1Pre& cur, int un, const float (&negA4)[4], const float (&dtb4)[4]) {
    const int tid = threadIdx.x, lane = tid & 63, wave = __builtin_amdgcn_readfirstlane(tid >> 6), r = lane & 31, hh = lane >> 5;
    const int bh = u >> 5, n = u & 31, b = bh >> 2, h = bh & 3;
    const unsigned char* ws = A.ws;
    unsigned char* rec = A.ws + WS_REC + (size_t)u * REC_BYTES;
    const size_t m0 = (size_t)b * SEQ + (size_t)n * 64;
    LAS bf16* KN = (LAS bf16*)(lds + R1_KN); LAS bf16* QN = (LAS bf16*)(lds + R1_QN); LAS bf16* KNT = (LAS bf16*)(lds + R1_KNT); LAS bf16* VT = (LAS bf16*)(lds + R1_VT);
    LAS float* AM = (LAS float*)(lds + R1_AM); LAS bf16* ANEG = (LAS bf16*)(lds + R1_ANEG); LAS bf16* DINV = (LAS bf16*)(lds + R1_DINV);
    LAS bf16* TB = (LAS bf16*)(lds + R1_TB); LAS bf16* TBD = (LAS bf16*)(lds + R1_TBD);
    LAS float* DEC = (LAS float*)(lds + R1_TAB); LAS float* BETA = DEC + 64; LAS float* EDEC = DEC + 128; LAS float* EEND = DEC + 192;
    const bf16* SPEC = (const bf16*)(ws + WS_SPEC);
    const bool stp = (u < 224);
    if (stp) STAMP3(0);
    { const float gg = negA4[h] * softplusf_(bf2f(cur.ab) + dtb4[h]);
      const float d = wscan(gg, lane);
      const float dl = rl_f(d, 63);
      if (wave == 0) { DEC[lane] = d; BETA[lane] = sigmoidf_(bf2f(cur.bb)); EDEC[lane] = __expf(d); EEND[lane] = __expf(dl - d);
          if (lane == 0) ((float*)(A.ws + WS_CDEC))[u] = __expf(dl); } }
    { const int t0 = wave * 8;
      const LAS float* CW = (const LAS float*)(lds + R1_CW) + h * 1536;
      float cw[4][3][2];
#pragma unroll
      for (int j = 0; j < 4; ++j)
#pragma unroll
          for (int sg = 0; sg < 3; ++sg) { const f32x2v c2 = *(const LAS f32x2v*)(CW + (j * 3 + sg) * 128 + 2 * lane); cw[j][sg][0] = c2[0]; cw[j][sg][1] = c2[1]; }
#define RAWV(rr, sg, e) ((e) ? bfhi(cur.raw[rr][sg]) : bflo(cur.raw[rr][sg]))
      unsigned kt0[4], kt1[4], vt0[4], vt1[4];
#pragma unroll
      for (int i = 0; i < 8; ++i) { float o[3][2];
#pragma unroll
          for (int sg = 0; sg < 3; ++sg)
#pragma unroll
              for (int e = 0; e < 2; ++e) o[sg][e] = siluf_(cw[0][sg][e] * RAWV(i, sg, e) + cw[1][sg][e] * RAWV(i + 1, sg, e) + cw[2][sg][e] * RAWV(i + 2, sg, e) + cw[3][sg][e] * RAWV(i + 3, sg, e));
          const float rq = 0.08838834764831845f / sqrtf(wsum(o[0][0] * o[0][0] + o[0][1] * o[0][1]) + NORM_EPS);
          const float rk = 1.f / sqrtf(wsum(o[1][0] * o[1][0] + o[1][1] * o[1][1]) + NORM_EPS);
          const unsigned qw = pk2(o[0][0] * rq, o[0][1] * rq), kw = pk2(o[1][0] * rk, o[1][1] * rk), vw = pk2(o[2][0], o[2][1]);
          *(LAS unsigned*)(QN + (t0 + i) * 136 + 2 * lane) = qw; *(LAS unsigned*)(KN + (t0 + i) * 136 + 2 * lane) = kw;
          if (i & 1) { kt0[i >> 1] |= kw << 16; kt1[i >> 1] |= kw & 0xffff0000u; vt0[i >> 1] |= vw << 16; vt1[i >> 1] |= vw & 0xffff0000u; }
          else { kt0[i >> 1] = kw & 0xffffu; kt1[i >> 1] = kw >> 16; vt0[i >> 1] = vw & 0xffffu; vt1[i >> 1] = vw >> 16; } }
      v4u x; x.x = kt0[0]; x.y = kt0[1]; x.z = kt0[2]; x.w = kt0[3]; *(LAS v4u*)(KNT + (2 * lane) * 72 + t0) = x;
      x.x = kt1[0]; x.y = kt1[1]; x.z = kt1[2]; x.w = kt1[3]; *(LAS v4u*)(KNT + (2 * lane + 1) * 72 + t0) = x;
      x.x = vt0[0]; x.y = vt0[1]; x.z = vt0[2]; x.w = vt0[3]; *(LAS v4u*)(VT + (2 * lane) * 72 + t0) = x;
      x.x = vt1[0]; x.y = vt1[1]; x.z = vt1[2]; x.w = vt1[3]; *(LAS v4u*)(VT + (2 * lane + 1) * 72 + t0) = x; }
    if (un < 1024) r1_prefetch(A, un, cur);
    LBAR();
    if (stp) STAMP3(1);
    if (wave < 3) { const int tp = (wave == 2) ? 1 : 0, mt = (wave == 0) ? 0 : 1;
        f32x16 kk = zero16(), qk = zero16();
#pragma unroll
        for (int hf = 0; hf < 2; ++hf) { bf16x8 fa[4], fk[4], fq[4];
#pragma unroll
            for (int s = 0; s < 4; ++s) { const int k0 = 16 * (4 * hf + s); fa[s] = lds_frag(KN + (32 * tp + r) * 136, k0, hh); fk[s] = lds_frag(KN + (32 * mt + r) * 136, k0, hh); fq[s] = lds_frag(QN + (32 * mt + r) * 136, k0, hh); }
            SB0();
#pragma unroll
            for (int s = 0; s < 4; ++s) { kk = MFMA32(fa[s], fk[s], kk); qk = MFMA32(fa[s], fq[s], qk); }
            SB0(); }
        const int t = 32 * mt + r; const float dect = DEC[t], bet = BETA[t];
#pragma unroll
        for (int q = 0; q < 4; ++q) { const int tq = 32 * tp + 8 * q + 4 * hh; float av[4], qv[4];
#pragma unroll
            for (int e = 0; e < 4; ++e) { const int tpp = tq + e; const float gam = (tpp <= t) ? __expf(dect - DEC[tpp]) : 0.f;
                av[e] = (tpp < t) ? bet * kk[4 * q + e] * gam : 0.f; qv[e] = qk[4 * q + e] * gam; qk[4 * q + e] = qv[e]; }
            *(LAS f32x4v*)(AM + t * 68 + tq) = (f32x4v){av[0], av[1], av[2], av[3]};
            v2u w; w.x = pg8::cvt_pk_bf16(-av[0], -av[1]); w.y = pg8::cvt_pk_bf16(-av[2], -av[3]); *(LAS v2u*)(ANEG + t * 72 + tq) = w; }
        st_frag(rec + REC_QK, mt * 4 + 2 * tp + 0, lane, __builtin_bit_cast(v4u, acc_frag(qk, 0)));
        st_frag(rec + REC_QK, mt * 4 + 2 * tp + 1, lane, __builtin_bit_cast(v4u, acc_frag(qk, 1)));
    } else {
        for (int f = wave - 3; f < 32; f += 5) {
            if (f < 16) { const int mt = f >> 3, s = f & 7, t = 32 * mt + r; const float e = EDEC[t];
                const LAS bf16* rp = QN + t * 136; const v2u a = *(const LAS v2u*)(rp + 16 * s + 4 * hh), c = *(const LAS v2u*)(rp + 16 * s + 8 + 4 * hh);
                v4u w; w.x = pk2(bflo(a.x) * e, bfhi(a.x) * e); w.y = pk2(bflo(a.y) * e, bfhi(a.y) * e); w.z = pk2(bflo(c.x) * e, bfhi(c.x) * e); w.w = pk2(bflo(c.y) * e, bfhi(c.y) * e);
                st_frag(rec + REC_QE, f, lane, w); }
            else { const int g = f - 16, mk = g >> 2, sp = g & 3; const LAS bf16* rp = KNT + (32 * mk + r) * 72; const int ta = 16 * sp + 4 * hh, tb = ta + 8;
                const v2u a = *(const LAS v2u*)(rp + ta), c = *(const LAS v2u*)(rp + tb);
                v4u w; w.x = pk2(bflo(a.x) * EEND[ta], bfhi(a.x) * EEND[ta + 1]); w.y = pk2(bflo(a.y) * EEND[ta + 2], bfhi(a.y) * EEND[ta + 3]);
                w.z = pk2(bflo(c.x) * EEND[tb], bfhi(c.x) * EEND[tb + 1]); w.w = pk2(bflo(c.y) * EEND[tb + 2], bfhi(c.y) * EEND[tb + 3]);
                st_frag(rec + REC_KT, g, lane, w); }
        }
    }
    LBAR();
    if (stp) STAMP3(2);
    if (wave == 0) { const int I = lane >> 4, c = lane & 15; float x[16];
#pragma unroll
        for (int i = 0; i < 16; ++i) { float acc = (i == c) ? 1.f : 0.f; const LAS float* nr = AM + (16 * I + i) * 68 + 16 * I;
#pragma unroll
            for (int j = 0; j < i; ++j) acc -= nr[j] * x[j];
            x[i] = acc; DINV[(I * 16 + i) * 24 + c] = (bf16)f2bf(acc); } }
    LBAR();
    if (stp) STAMP3(3);
    if (wave < 4) { const int Jc = wave, c = lane & 15, g = lane >> 4; f32x4v X[4];
#pragma unroll
        for (int I = 0; I < 4; ++I) { X[I] = (f32x4v){0.f, 0.f, 0.f, 0.f};
            if (I >= Jc) { f32x4v R;
#pragma unroll
                for (int e = 0; e < 4; ++e) R[e] = (I == Jc && 4 * g + e == c) ? 1.f : 0.f;
#pragma unroll
                for (int p = 0; p < 2; ++p) { const int J0 = 2 * p, J1 = 2 * p + 1; if (J0 < I) {
                    const LAS bf16* ar = ANEG + (16 * I + c) * 72;
                    const v2u a0 = *(const LAS v2u*)(ar + 16 * J0 + 4 * g); v2u a1; a1.x = 0u; a1.y = 0u; if (J1 < I) a1 = *(const LAS v2u*)(ar + 16 * J1 + 4 * g);
                    v4u aw; aw.x = a0.x; aw.y = a0.y; aw.z = a1.x; aw.w = a1.y;
                    v4u bw; bw.x = pg8::cvt_pk_bf16(X[J0][0], X[J0][1]); bw.y = pg8::cvt_pk_bf16(X[J0][2], X[J0][3]); bw.z = 0u; bw.w = 0u;
                    if (J1 < I) { bw.z = pg8::cvt_pk_bf16(X[J1][0], X[J1][1]); bw.w = pg8::cvt_pk_bf16(X[J1][2], X[J1][3]); }
                    R = MFMA16(__builtin_bit_cast(bf16x8, aw), __builtin_bit_cast(bf16x8, bw), R); } }
                const v2u d0 = *(const LAS v2u*)(DINV + (I * 16 + c) * 24 + 4 * g);
                v4u aw; aw.x = d0.x; aw.y = d0.y; aw.z = 0u; aw.w = 0u;
                v4u bw; bw.x = pg8::cvt_pk_bf16(R[0], R[1]); bw.y = pg8::cvt_pk_bf16(R[2], R[3]); bw.z = 0u; bw.w = 0u;
                const f32x4v z4 = {0.f, 0.f, 0.f, 0.f}; X[I] = MFMA16(__builtin_bit_cast(bf16x8, aw), __builtin_bit_cast(bf16x8, bw), z4); } }
        const int cc = 16 * Jc + c; const float bet = BETA[cc], bed = bet * EDEC[cc];
#pragma unroll
        for (int I = 0; I < 4; ++I)
#pragma unroll
            for (int e = 0; e < 4; ++e) { const int t = 16 * I + 4 * g + e; TB[t * 72 + cc] = (bf16)f2bf(X[I][e] * bet); TBD[t * 72 + cc] = (bf16)f2bf(X[I][e] * bed); } }
    LBAR();
    if (stp) STAMP3(4);
    { const int mt = wave & 1, cb = wave >> 1; const int ns = mt ? 4 : 2;
      f32x16 ua = zero16(), wa = zero16();
      bf16x8 f0[4], f1[4], f2[4], f3[4];
#pragma unroll
      for (int s = 0; s < 4; ++s) if (s < ns) { f0[s] = lds_frag(TB + (32 * mt + r) * 72, 16 * s, hh); f1[s] = lds_frag(VT + (32 * cb + r) * 72, 16 * s, hh);
          f2[s] = lds_frag(KNT + (32 * cb + r) * 72, 16 * s, hh); f3[s] = lds_frag(TBD + (32 * mt + r) * 72, 16 * s, hh); }
      SB0();
#pragma unroll
      for (int s = 0; s < 4; ++s) if (s < ns) { ua = MFMA32(f0[s], f1[s], ua); wa = MFMA32(f2[s], f3[s], wa); }
      SB0();
      r1_touch(cur);
      { v4u lo = __builtin_bit_cast(v4u, acc_frag(ua, 0)), hi = __builtin_bit_cast(v4u, acc_frag(ua, 1));
        unsigned char* up = rec + REC_U + (size_t)((cb * 2 + mt) * 64 + lane) * 32; *(GAS v4u*)up = lo; *(GAS v4u*)(up + 16) = hi; }
#pragma unroll
      for (int g = 0; g < 16; ++g) wa[g] = -wa[g];
      st_frag(rec + REC_W, mt * 8 + 2 * cb + 0, lane, __builtin_bit_cast(v4u, acc_frag(wa, 0)));
      st_frag(rec + REC_W, mt * 8 + 2 * cb + 1, lane, __builtin_bit_cast(v4u, acc_frag(wa, 1))); }
    LBAR();
    if (stp) STAMP3(5);
}

constexpr int R2_BUF0 = 0, R2_BUF1 = REC_LDS, R2_OBUF = 2 * REC_LDS, R2_END = R2_OBUF + 64 * 136 * 2;
static_assert(R2_END <= LDS_BYTES - 512, "R2 LDS");
#define RAW_BAR() do { asm volatile("" ::: "memory"); __builtin_amdgcn_s_barrier(); asm volatile("" ::: "memory"); } while (0)
__device__ __forceinline__ void gdn_r2_item(const Args& A, LAS unsigned char* lds, int bh) {
    const int tid = threadIdx.x, lane = tid & 63, wave = __builtin_amdgcn_readfirstlane(tid >> 6), r = lane & 31, hh = lane >> 5;
    const int b = bh >> 2, h = bh & 3;
    const unsigned char* recs = A.ws + WS_REC + (size_t)bh * 32 * REC_BYTES;
    const float* CDEC = (const float*)(A.ws + WS_CDEC) + bh * 32;
    LAS bf16* OBUF = (LAS bf16*)(lds + R2_OBUF);
    if (wave >= 4) { const int wl = wave - 4;
        for (int p = wl; p < 56; p += 4) __builtin_amdgcn_global_load_lds((const unsigned*)(recs + (size_t)p * 1024 + lane * 16), (LAS unsigned*)(lds + R2_BUF0 + p * 1024), 16, 0, 0);
        asm volatile("s_waitcnt vmcnt(0)" ::: "memory"); }
    RAW_BAR();
    if (wave < 4) {
        f32x16 S[4]; bf16x8 Sb[8];
#pragma unroll
        for (int i = 0; i < 4; ++i) S[i] = zero16();
#pragma unroll
        for (int i = 0; i < 8; ++i) Sb[i] = (bf16x8){0, 0, 0, 0, 0, 0, 0, 0};
        v4u un[2][2]; float cdn = CDEC[0];
#pragma unroll
        for (int mt = 0; mt < 2; ++mt) { const unsigned char* up = recs + REC_U + (size_t)((wave * 2 + mt) * 64 + lane) * 32; un[mt][0] = *(const GAS v4u*)up; un[mt][1] = *(const GAS v4u*)(up + 16); }
#define SB0() __builtin_amdgcn_sched_barrier(0)
#define FRG(off, idx) (*(const LAS bf16x8*)(buf + (off) + (idx) * 1024 + lane * 16))
        for (int n = 0; n < 32; ++n) {
            const LAS unsigned char* buf = lds + ((n & 1) ? R2_BUF1 : R2_BUF0);
            const float cdec = cdn;
            bf16x8 fa[8], fb[8];
#pragma unroll
            for (int s = 0; s < 8; ++s) fa[s] = FRG(REC_W, s);
#pragma unroll
            for (int s = 0; s < 8; ++s) fb[s] = FRG(REC_W, 8 + s);
            f32x16 V[2];
#pragma unroll
            for (int mt = 0; mt < 2; ++mt) { const v4u lo = un[mt][0], hi = un[mt][1];
                V[mt][0] = bflo(lo.x); V[mt][1] = bfhi(lo.x); V[mt][2] = bflo(lo.y); V[mt][3] = bfhi(lo.y); V[mt][4] = bflo(lo.z); V[mt][5] = bfhi(lo.z); V[mt][6] = bflo(lo.w); V[mt][7] = bfhi(lo.w);
                V[mt][8] = bflo(hi.x); V[mt][9] = bfhi(hi.x); V[mt][10] = bflo(hi.y); V[mt][11] = bfhi(hi.y); V[mt][12] = bflo(hi.z); V[mt][13] = bfhi(hi.z); V[mt][14] = bflo(hi.w); V[mt][15] = bfhi(hi.w); }
            if (n + 1 < 32) { cdn = CDEC[n + 1];
#pragma unroll
                for (int mt = 0; mt < 2; ++mt) { const unsigned char* up = recs + (size_t)(n + 1) * REC_BYTES + REC_U + (size_t)((wave * 2 + mt) * 64 + lane) * 32; un[mt][0] = *(const GAS v4u*)up; un[mt][1] = *(const GAS v4u*)(up + 16); } }
            SB0();
#pragma unroll
            for (int s = 0; s < 8; ++s) V[0] = MFMA32(fa[s], Sb[s], V[0]);
            SB0();
#pragma unroll
            for (int s = 0; s < 8; ++s) fa[s] = FRG(REC_QE, s);
            SB0();
#pragma unroll
            for (int s = 0; s < 8; ++s) V[1] = MFMA32(fb[s], Sb[s], V[1]);
            SB0();
#pragma unroll
            for (int s = 0; s < 8; ++s) fb[s] = FRG(REC_QE, 8 + s);
            bf16x8 Vb[4]; Vb[0] = acc_frag(V[0], 0); Vb[1] = acc_frag(V[0], 1);
            SB0();
            f32x16 O0 = zero16(), O1 = zero16();
#pragma unroll
            for (int s = 0; s < 8; ++s) O0 = MFMA32(fa[s], Sb[s], O0);
            Vb[2] = acc_frag(V[1], 0); Vb[3] = acc_frag(V[1], 1);
            SB0();
            fa[0] = FRG(REC_QK, 0); fa[1] = FRG(REC_QK, 1); fa[2] = FRG(REC_QK, 4); fa[3] = FRG(REC_QK, 5); fa[4] = FRG(REC_QK, 6); fa[5] = FRG(REC_QK, 7);
            SB0();
#pragma unroll
            for (int s = 0; s < 8; ++s) O1 = MFMA32(fb[s], Sb[s], O1);
            SB0();
#pragma unroll
            for (int s = 0; s < 8; ++s) fb[s] = FRG(REC_KT, s);
            SB0();
            O0 = MFMA32(fa[0], Vb[0], O0); O0 = MFMA32(fa[1], Vb[1], O0);
#pragma unroll
            for (int s = 0; s < 4; ++s) O1 = MFMA32(fa[2 + s], Vb[s], O1);
#pragma unroll
            for (int g = 0; g < 16; ++g) { S[0][g] *= cdec; S[1][g] *= cdec; }
            SB0();
#pragma unroll
            for (int s = 0; s < 8; ++s) fa[s] = FRG(REC_KT, 8 + s);
            asm volatile("s_waitcnt lgkmcnt(0)" ::: "memory");
            RAW_BAR();
            SB0();
#pragma unroll
            for (int s = 0; s < 4; ++s) { S[0] = MFMA32(fb[s], Vb[s], S[0]); S[1] = MFMA32(fb[4 + s], Vb[s], S[1]); }
#pragma unroll
            for (int g = 0; g < 16; ++g) { OBUF[c32row(lane, g) * 136 + 32 * wave + r] = (bf16)f2bf(O0[g]); OBUF[(32 + c32row(lane, g)) * 136 + 32 * wave + r] = (bf16)f2bf(O1[g]); }
#pragma unroll
            for (int g = 0; g < 16; ++g) { S[2][g] *= cdec; S[3][g] *= cdec; }
            SB0();
#pragma unroll
            for (int s = 0; s < 4; ++s) { S[2] = MFMA32(fa[s], Vb[s], S[2]); S[3] = MFMA32(fa[4 + s], Vb[s], S[3]); }
            Sb[0] = acc_frag(S[0], 0); Sb[1] = acc_frag(S[0], 1); Sb[2] = acc_frag(S[1], 0); Sb[3] = acc_frag(S[1], 1);
            SB0();
            Sb[4] = acc_frag(S[2], 0); Sb[5] = acc_frag(S[2], 1); Sb[6] = acc_frag(S[3], 0); Sb[7] = acc_frag(S[3], 1);
            asm volatile("s_waitcnt lgkmcnt(0)" ::: "memory");
            RAW_BAR();
        }
        RAW_BAR();
        float* So = A.out + OUT_GDN_P + (size_t)bh * 128 * 128;
#pragma unroll
        for (int mk = 0; mk < 4; ++mk)
#pragma unroll
            for (int g = 0; g < 16; ++g) So[(size_t)(32 * mk + c32row(lane, g)) * 128 + 32 * wave + r] = S[mk][g];
    } else {
        const int wl = wave - 4, lt = tid - 256, t = lt >> 2, qd = lt & 3;
        const bf16* PZ = panel(A.ws, PN_ZB + (h >> 1)); bf16* OB = (bf16*)(A.ws + WS_OB);
        f32x4 nw[8];
#pragma unroll
        for (int i = 0; i < 8; ++i) nw[i] = *(const GAS f32x4*)(A.in[15] + 32 * qd + 4 * i);
        v4u zc[4], zn[4];
        { const size_t m = (size_t)b * SEQ + t;
#pragma unroll
          for (int i = 0; i < 4; ++i) zc[i] = *(const GAS v4u*)(PZ + m * 256 + (h & 1) * 128 + 32 * qd + 8 * i); }
        for (int n = 0; n <= 32; ++n) {
            if (n + 1 < 32) { const unsigned char* src = recs + (size_t)(n + 1) * REC_BYTES; LAS unsigned char* dst = lds + (((n + 1) & 1) ? R2_BUF1 : R2_BUF0);
                for (int p = wl; p < 56; p += 4) __builtin_amdgcn_global_load_lds((const unsigned*)(src + (size_t)p * 1024 + lane * 16), (LAS unsigned*)(dst + p * 1024), 16, 0, 0); }
            if (n >= 1) { const size_t m = (size_t)b * SEQ + (size_t)(n - 1) * 64 + t;
                float ss = 0.f; f32x4 ov[8];
#pragma unroll
                for (int i = 0; i < 4; ++i) unpack8(*(const LAS v4u*)(OBUF + t * 136 + 32 * qd + 8 * i), ov[2 * i], ov[2 * i + 1]);
#pragma unroll
                for (int i = 0; i < 8; ++i) ss += (ov[i].x * ov[i].x + ov[i].y * ov[i].y) + (ov[i].z * ov[i].z + ov[i].w * ov[i].w);
                asm volatile("s_waitcnt lgkmcnt(0)" ::: "memory");
                RAW_BAR();
                ss = quad_sum(ss);
                const float rr = 1.f / sqrtf(ss * (1.f / 128.f) + NORM_EPS);
                v4u ow[4];
#pragma unroll
                for (int i = 0; i < 4; ++i) { f32x4 z0, z1; unpack8(zc[i], z0, z1);
                    f32x4 a = ov[2 * i] * rr * nw[2 * i], c = ov[2 * i + 1] * rr * nw[2 * i + 1];
                    a.x *= siluf_(z0.x); a.y *= siluf_(z0.y); a.z *= siluf_(z0.z); a.w *= siluf_(z0.w); c.x *= siluf_(z1.x); c.y *= siluf_(z1.y); c.z *= siluf_(z1.z); c.w *= siluf_(z1.w);
                    ow[i] = pack8(a, c); }
#pragma unroll
                for (int i = 0; i < 4; ++i) zc[i] = zn[i];
                asm volatile("" :: "v"(zc[0].x), "v"(zc[1].x), "v"(zc[2].x), "v"(zc[3].x), "v"(zc[0].w), "v"(zc[1].w), "v"(zc[2].w), "v"(zc[3].w));
#pragma unroll
                for (int i = 0; i < 4; ++i) *(GAS v4u*)(OB + m * 512 + h * 128 + 32 * qd + 8 * i) = ow[i];
            } else { RAW_BAR(); }
            if (n + 1 < 32) { const size_t m = (size_t)b * SEQ + (size_t)(n + 1) * 64 + t;
#pragma unroll
                for (int i = 0; i < 4; ++i) zn[i] = *(const GAS v4u*)(PZ + m * 256 + (h & 1) * 128 + 32 * qd + 8 * i); }
            if (n < 32) { asm volatile("s_waitcnt vmcnt(8)" ::: "memory"); RAW_BAR(); }
        }
    }
}
typedef pg8::f32x4 (&AccRef)[2][2][4][2];
typedef const pg8::f32x4 (&CAccRef)[2][2][4][2];

#define EPI_LOOP_BEGIN  const int row0 = u.pm * 256 + wr * 64 + fr, cin = wc * 32 + 8 * fq; \
    _Pragma("unroll") for (int ai = 0; ai < 2; ++ai) _Pragma("unroll") for (int m = 0; m < 4; ++m) { const size_t row = (size_t)(row0 + ai * 128 + m * 16); \
    _Pragma("unroll") for (int bj = 0; bj < 2; ++bj) { const int cp = bj * 128 + cin;   const f32x4 a0 = acc[ai][bj][m][0], a1 = acc[ai][bj][m][1];
#define EPI_LOOP_END } }

__device__ __forceinline__ bf16* panel_rw(unsigned char* ws, float* out, int pn) { return (pn < 14) ? (bf16*)(ws + WS_PROJ + (size_t)pn * SZ_PANEL) : (bf16*)((unsigned char*)out + (size_t)(pn - 14) * SZ_PANEL); }
struct EpiProj { static constexpr bool PERM = true; unsigned char* ws; float* out;
    __device__ __forceinline__ void operator()(CAccRef acc, const pg8::Unit& u, int wr, int wc, int fr, int fq) const {
        if (u.pn < PN_SPEC) { bf16* P = panel_rw(ws, out, u.pn);
            EPI_LOOP_BEGIN *(GAS v4u*)(P + row * 256 + cp) = pack8(a0, a1); EPI_LOOP_END }
        else { bf16* P = (bf16*)(ws + WS_SPEC);
            EPI_LOOP_BEGIN if (cp < 32) *(GAS v4u*)(P + row * 32 + cp) = pack8(a0, a1); EPI_LOOP_END }
    } };
#define EPI_POS(p) const int m = (p) >> 1, bj = (p) & 1; const size_t row = (size_t)(row0 + ai * 128 + m * 16); const int cp = bj * 128 + cin; const f32x4 a0 = acc[ai][bj][m][0], a1 = acc[ai][bj][m][1];
struct EpiUpA { static constexpr bool PERM = true; unsigned char* ws; float* out; bf16* O;
    __device__ __forceinline__ void operator()(CAccRef acc, const pg8::Unit& u, int wr, int wc, int fr, int fq) const {
        const bf16* Gp = panel_rw(ws, out, PN_GA + u.pn);
        const int row0 = u.pm * 256 + wr * 64 + fr, cin = wc * 32 + 8 * fq;
#pragma unroll
        for (int ai = 0; ai < 2; ++ai) { v4u gw[8];
#pragma unroll
            for (int p = 0; p < 8; ++p) { EPI_POS(p) (void)a0; (void)a1; gw[p] = *(const GAS v4u*)(Gp + row * 256 + cp); }
#pragma unroll
            for (int p = 0; p < 8; ++p) { EPI_POS(p) f32x4 g0, g1; unpack8(gw[p], g0, g1);
                *(GAS v4u*)(O + row * 1024 + u.pn * 256 + cp) = pack8(sig4(g0) * a0, sig4(g1) * a1); } }
    } };
struct EpiUpB { static constexpr bool PERM = true; unsigned char* ws; float* out; bf16* O;
    __device__ __forceinline__ void operator()(CAccRef acc, const pg8::Unit& u, int wr, int wc, int fr, int fq) const {
        const bf16* Gp = panel_rw(ws, out, PN_GB + u.pn);
        const int row0 = u.pm * 256 + wr * 64 + fr, cin = wc * 32 + 8 * fq;
#pragma unroll
        for (int ai = 0; ai < 2; ++ai)
#pragma unroll
            for (int hb = 0; hb < 2; ++hb) { v4u gw[4], yw[4];
#pragma unroll
                for (int q = 0; q < 4; ++q) { const int p = hb * 4 + q; EPI_POS(p) (void)a0; (void)a1; gw[q] = *(const GAS v4u*)(Gp + row * 256 + cp); yw[q] = *(const GAS v4u*)(O + row * 1024 + u.pn * 256 + cp); }
#pragma unroll
                for (int q = 0; q < 4; ++q) { const int p = hb * 4 + q; EPI_POS(p) f32x4 g0, g1, y0, y1; unpack8(gw[q], g0, g1); unpack8(yw[q], y0, y1);
                    *(GAS v4u*)(O + row * 1024 + u.pn * 256 + cp) = pack8(y0 + sig4(g0) * a0, y1 + sig4(g1) * a1); } }
    } };
struct EpiOut { static constexpr bool PERM = true; bf16* HB; const float* xp; const float* xs;
    __device__ __forceinline__ void operator()(CAccRef acc, const pg8::Unit& u, int wr, int wc, int fr, int fq) const {
        const int row0 = u.pm * 256 + wr * 64 + fr, cin = wc * 32 + 8 * fq;
#pragma unroll
        for (int ai = 0; ai < 2; ++ai) { f32x4 x0[8], x1[8];
#pragma unroll
            for (int p = 0; p < 8; ++p) { EPI_POS(p) (void)a0; (void)a1; const size_t col = (size_t)u.pn * 256 + cp;
                const float* xr = (row < (size_t)MP) ? xp + row * 1024 + col : xs + (row - MP) * 1024 + col; x0[p] = *(const GAS f32x4*)xr; x1[p] = *(const GAS f32x4*)(xr + 4); }
#pragma unroll
            for (int p = 0; p < 8; ++p) { EPI_POS(p) const size_t col = (size_t)u.pn * 256 + cp;
                *(GAS v4u*)(HB + row * 1024 + col) = pack8(x0[p] + a0, x1[p] + a1); } }
    } };
struct EpiPe { static constexpr bool PERM = true; bf16* O;
    __device__ __forceinline__ void operator()(CAccRef acc, const pg8::Unit& u, int wr, int wc, int fr, int fq) const {
        EPI_LOOP_BEGIN *(GAS v4u*)(O + row * 1024 + u.pn * 256 + cp) = pack8(a0, a1); EPI_LOOP_END
    } };
struct EpiGate { static constexpr bool PERM = true; unsigned char* ws; const bf16* PEp; const bf16* HB; bf16* H2;
    __device__ __forceinline__ void operator()(CAccRef acc, const pg8::Unit& u, int wr, int wc, int fr, int fq) const {
        float* RS = (float*)(ws + WS_RSSP);
        const int row0 = u.pm * 256 + wr * 64 + fr, cin = wc * 32 + 8 * fq;
#pragma unroll
        for (int ai = 0; ai < 2; ++ai)
#pragma unroll
            for (int hb = 0; hb < 2; ++hb) { v4u pw[4], hw[4];
#pragma unroll
                for (int q = 0; q < 4; ++q) { const int p = hb * 4 + q; EPI_POS(p) (void)a0; (void)a1; const size_t col = (size_t)u.pn * 256 + cp;
                    pw[q] = *(const GAS v4u*)(PEp + row * 1024 + col); hw[q] = *(const GAS v4u*)(HB + row * 1024 + col); }
                float ssm[2] = {0.f, 0.f};
#pragma unroll
                for (int q = 0; q < 4; ++q) { const int p = hb * 4 + q; EPI_POS(p) const size_t col = (size_t)u.pn * 256 + cp;
                    f32x4 p0, p1, x0, x1; unpack8(pw[q], p0, p1); unpack8(hw[q], x0, x1);
                    const f32x4 h0 = x0 + sig4(a0) * p0, h1 = x1 + sig4(a1) * p1;
                    *(GAS v4u*)(H2 + row * 1024 + col) = pack8(h0, h1);
                    ssm[q >> 1] += (h0.x * h0.x + h0.y * h0.y) + (h0.z * h0.z + h0.w * h0.w) + (h1.x * h1.x + h1.y * h1.y) + (h1.z * h1.z + h1.w * h1.w); }
#pragma unroll
                for (int mm = 0; mm < 2; ++mm) { float ss = ssm[mm]; ss += __shfl_xor(ss, 16); ss += __shfl_xor(ss, 32);
                    if (fq == 0) RS[(size_t)(row0 + ai * 128 + (hb * 2 + mm) * 16) * 16 + u.pn * 4 + wc] = ss; } }
    } };

__device__ __forceinline__ void p6_final_norm(const Args& A, int vcu, int G, int wave, int lane) {
    const int gw = vcu * NWAVES + wave, NGW = G * NWAVES;
    const float* RS = (const float*)(A.ws + WS_RSSP);
    const GAS f32x4* fw = (const GAS f32x4*)A.in[21];
    const f32x4 w0 = fw[4 * lane], w1 = fw[4 * lane + 1], w2 = fw[4 * lane + 2], w3 = fw[4 * lane + 3];
    for (int m = gw; m < M; m += NGW) {
        const f32x4 ra = *(const GAS f32x4*)(RS + (size_t)m * 16), rb = *(const GAS f32x4*)(RS + (size_t)m * 16 + 4), rc = *(const GAS f32x4*)(RS + (size_t)m * 16 + 8), rd = *(const GAS f32x4*)(RS + (size_t)m * 16 + 12);
        const bf16* HB = (const bf16*)(A.ws + (m < MP ? WS_MERGED : WS_H1B));
        const v4u ha = *(const GAS v4u*)(HB + (size_t)m * D + 16 * lane), hb = *(const GAS v4u*)(HB + (size_t)m * D + 16 * lane + 8);
        const float ss = (((ra.x + ra.y) + (ra.z + ra.w)) + ((rb.x + rb.y) + (rb.z + rb.w))) + (((rc.x + rc.y) + (rc.z + rc.w)) + ((rd.x + rd.y) + (rd.z + rd.w)));
        const float r = 1.f / sqrtf(ss * (1.f / D) + NORM_EPS);
        f32x4 a0, a1, a2, a3; unpack8(ha, a0, a1); unpack8(hb, a2, a3);
        GAS f32x4* o = (GAS f32x4*)(A.out + (size_t)m * D + 16 * lane);
        o[0] = a0 * r * w0; o[1] = a1 * r * w1; o[2] = a2 * r * w2; o[3] = a3 * r * w3;
    }
}

struct OneUnit { int pm, pn;
    __device__ bool next(int i, pg8::Unit& u) const { if (i != 0) return false; u.pm = pm; u.pn = pn; return true; }
    __device__ __forceinline__ void a_ready(const pg8::Unit&) const {}
    __device__ __forceinline__ void done(const pg8::Unit&) const {} };
__device__ __forceinline__ void group_arrive(unsigned* cnt) {
    asm volatile("s_waitcnt vmcnt(0)" ::: "memory"); __syncthreads();
    if (threadIdx.x == 0) { __builtin_amdgcn_fence(__ATOMIC_RELEASE, "agent"); asm volatile("s_waitcnt vmcnt(0)" ::: "memory"); (void)xb_add(cnt, 1u); }
}
__device__ __forceinline__ void group_wait(unsigned* cnt, unsigned target) {
    if (threadIdx.x == 0) { unsigned sp = 0; while (xb_ld(cnt) < target) { __builtin_amdgcn_s_sleep(2); if (++sp > (1u << 22)) break; }
        __builtin_amdgcn_fence(__ATOMIC_ACQUIRE, "agent"); asm volatile("s_waitcnt vmcnt(0)" ::: "memory"); }
    __syncthreads();
}
constexpr int CW_SDONE = 8192, CW_GBAR = 8192 + 64;
__device__ __forceinline__ void sample_chain(const Args& A, LAS unsigned char* lds, int ci, int nsample_wgs) {
    unsigned char* ws = A.ws; unsigned* ctl = (unsigned*)(ws + WS_CTL);
    const OneUnit S{MP / 256 + (ci >> 2), ci & 3};
    group_wait(ctl + CW_SDONE, (unsigned)nsample_wgs);
    bf16* T1 = (bf16*)(ws + WS_PROJ + 10 * SZ_PANEL) - (size_t)MP * 1024; bf16* T2 = T1 + (size_t)1024 * 1024; bf16* T3 = T2 + (size_t)1024 * 1024; bf16* H2s = (bf16*)(ws + WS_H1B);
    { pg8::Gemm g{(const bf16*)(ws + WS_OA), (const bf16*)(ws + WS_WUA), M, 1024, 512}; EpiUpA E{ws, A.out, T1}; pg8::gemm_phase<EpiUpA, OneUnit>(lds + RING_OFF, g, S, E); }
    { pg8::Gemm g{(const bf16*)(ws + WS_OB), (const bf16*)(ws + WS_WUB), M, 1024, 512}; EpiUpB E{ws, A.out, T1}; pg8::gemm_phase<EpiUpB, OneUnit>(lds + RING_OFF, g, S, E); }
    group_arrive(ctl + CW_GBAR); group_wait(ctl + CW_GBAR, 16u);
    { pg8::Gemm g{T1, (const bf16*)(ws + WS_WO), M, 1024, 1024}; EpiOut E{T3, A.in[0], A.in[1]}; pg8::gemm_phase<EpiOut, OneUnit>(lds + RING_OFF, g, S, E); }
    group_arrive(ctl + CW_GBAR); group_wait(ctl + CW_GBAR, 32u);
    { pg8::Gemm g{(const bf16*)(ws + WS_PB), (const bf16*)(ws + WS_WP), M, 1024, 256}; EpiPe E{T2}; pg8::gemm_phase<EpiPe, OneUnit>(lds + RING_OFF, g, S, E); }
    { pg8::Gemm g{T3, (const bf16*)(ws + WS_WG), M, 1024, 1024}; EpiGate E{ws, T2, T3, H2s}; pg8::gemm_phase<EpiGate, OneUnit>(lds + RING_OFF, g, S, E); }
}
constexpr int GLA_SPLIT = 10;
__device__ __forceinline__ void p2_recurrences(const Args& A, LAS unsigned char* lds, int c, int G, const XcdBarrier& bar) {
    float* out = A.out;
#ifdef PROBE_WG
    unsigned long long* stamps = (unsigned long long*)(A.ws + WS_CTL + 32768) + (size_t)c * 16;
#define STAMP2(k) do { if (threadIdx.x == 0) stamps[k] = __builtin_amdgcn_s_memrealtime(); } while (0)
#else
#define STAMP2(k) do { } while (0)
#endif
    const int gt = c * NTHREADS + threadIdx.x, NGT = G * NTHREADS;
    for (int i = gt; i < 8 * 3 * 1536; i += NGT) { const int ch = i % 1536, j = (i / 1536) % 3, b = i / (3 * 1536); const size_t m = (size_t)b * SEQ + SEQ - 3 + j;
        out[OUT_CONV_P + i] = bf2f(panel(A.ws, PN_QB + (ch >> 8))[m * 256 + (ch & 255)]); }
    for (int i = gt; i < 128 * 3 * 1536; i += NGT) { const int ch = i % 1536, j = (i / 1536) % 3, b = i / (3 * 1536); const size_t m = (size_t)MP + b * DSQ + DSQ - 3 + j;
        out[OUT_CONV_S + i] = bf2f(panel(A.ws, PN_QB + (ch >> 8))[m * 256 + (ch & 255)]); }
    if (c < 32) {
        const int b = c >> 2, h = c & 3, lane = threadIdx.x & 63;
        float wg[16];
#pragma unroll
        for (int r = 0; r < 16; ++r) wg[r] = A.in[9][r * 256 + h * 64 + lane];
        const float bgv = A.in[10][h * 64 + lane];
        GlaState st; st.S[0] = zero16(); st.S[1] = zero16();
#pragma unroll
        for (int i = 0; i < 4; ++i) st.Sb[i] = (bf16x8){0, 0, 0, 0, 0, 0, 0, 0};
        const float nw0 = A.in[11][2 * lane], nw1 = A.in[11][2 * lane + 1];
        GlaPre pa; gla_prefetch(A, b, h, 0, pa); gla_touch(pa);
        for (int n = 0; n < 32; ++n) {
            if (n == GLA_SPLIT && MK_N_LAUNCHES == 1) { STAMP2(5); xcd_barrier(bar); STAMP2(6); }
            gla_chunk(A, lds, b, h, n, st, wg, bgv, pa, nw0, nw1); }
        gla_final(A, c, st);
    } else {
        { r1_stage_cw(A, lds); const int step = G - 32; int u = c - 32; R1Pre pa;
          float negA4[4], dtb4[4];
#pragma unroll
          for (int i = 0; i < 4; ++i) { negA4[i] = -__expf(A.in[13][i]); dtb4[i] = A.in[14][i]; }
          if (u < 1024) { r1_prefetch(A, u, pa); r1_touch(pa); }
          while (u < 1024) { const int un = u + step; gdn_r1_unit(A, lds, u, pa, un, negA4, dtb4); u = un; } }
        STAMP2(5); if (MK_N_LAUNCHES == 1) xcd_barrier(bar); STAMP2(6);
        if (c < 64) gdn_r2_item(A, lds, c - 32);
        else { const int nw = G - 64;
            for (int it = c - 64; it < 1024; it += nw) {
                if (it < 512) { const int b = it >> 2, h = it & 3; gla_item_s(A, lds, h, MP + b * DSQ, A.in[2] + (size_t)it * 64 * 128, out + OUT_GLA_S + (size_t)it * 64 * 128); }
                else { const int i = it - 512, b = i >> 2, h = i & 3; gdn_item_s(A, lds, h, MP + b * DSQ, A.in[3] + (size_t)i * 128 * 128, out + OUT_GDN_S + (size_t)i * 128 * 128, A.in[4] + (size_t)b * 3 * 1536); }
            }
            if (MK_N_LAUNCHES == 1) { group_arrive((unsigned*)(A.ws + WS_CTL) + CW_SDONE);
                if (c < 80) sample_chain(A, lds, c - 64, nw); } }
    }
}
#ifndef MK_N_LAUNCHES
#define MK_N_LAUNCHES 1
#endif
constexpr int N_PHASES = 7;
__global__ void __launch_bounds__(NTHREADS, 2) mk_fwd(Args args) {
    extern __shared__ __attribute__((aligned(16))) unsigned char lds_raw[];
    LAS unsigned char* lds = (LAS unsigned char*)lds_raw;
    volatile LAS unsigned* MISC = (volatile LAS unsigned*)(lds + MISC_OFF);
    const int tid = threadIdx.x, lane = tid & 63, wave = __builtin_amdgcn_readfirstlane(tid >> 6);
    const int G = gridDim.x, bx = blockIdx.x;
    const int vcu = (G % 8 == 0) ? (bx % 8) * (G / 8) + bx / 8 : bx;
    for (int u = tid; u < (LDS_BYTES - LDSCTL_OFF) / 4; u += NTHREADS) ((LAS unsigned*)(lds + LDSCTL_OFF))[u] = 0u;
    __syncthreads();
    unsigned char* ws = args.ws;
    XcdBarrier bar; bar.bar = (unsigned*)(ws + WS_CTL) + CW_BAR; bar.x = 0; bar.st = nullptr;
    if (MK_N_LAUNCHES == 1) bar = xcd_barrier_post((unsigned*)(ws + WS_CTL) + CW_BAR, MISC + 8);
    const int lo = args.ph_lo, hi = args.ph_hi;
#ifdef PROBE_WG
    unsigned long long* stamps = (unsigned long long*)(ws + WS_CTL + 32768) + (size_t)bx * 16;
#define STAMP(k) do { if (tid == 0) stamps[k] = __builtin_amdgcn_s_memrealtime(); } while (0)
#else
#define STAMP(k) do { } while (0)
#endif
    STAMP(0);
#define IN(k) (lo <= (k) && (k) < hi)
#define SEAM(k) do { if (IN(k) && IN((k) + 1)) xcd_barrier(bar); } while (0)

    if (IN(0)) { p0_prologue(args, lds, vcu, G, wave, lane); }
    STAMP(1); SEAM(0); STAMP(2);
    if (IN(1)) {
        pg8::Gemm g{(const bf16*)(ws + WS_XN), (const bf16*)(ws + WS_WIN), M, NPROJ, 1024}; pg8::StaticOrder S; S.init(M, NPROJ, G, bx);
        EpiProj E{ws, args.out};
        pg8::gemm_phase<EpiProj, pg8::StaticOrder>(lds + RING_OFF, g, S, E);
    }
    STAMP(3); SEAM(1); STAMP(4);
#ifndef PROBE_DUP
#define PROBE_DUP -1
#endif
    if (IN(2)) { p2_recurrences(args, lds, bx, G, bar); if (PROBE_DUP == 2) p2_recurrences(args, lds, bx, G, bar); }
    STAMP(7); SEAM(2); STAMP(8);
    if (IN(3)) {
        pg8::StaticOrder S; S.init(MP, 1024, G, bx);
        { pg8::Gemm g{(const bf16*)(ws + WS_OA), (const bf16*)(ws + WS_WUA), M, 1024, 512}; EpiUpA E{ws, args.out, (bf16*)(ws + WS_MERGED)}; pg8::gemm_phase<EpiUpA, pg8::StaticOrder>(lds + RING_OFF, g, S, E); }
        { pg8::Gemm g{(const bf16*)(ws + WS_OB), (const bf16*)(ws + WS_WUB), M, 1024, 512}; EpiUpB E{ws, args.out, (bf16*)(ws + WS_MERGED)}; pg8::gemm_phase<EpiUpB, pg8::StaticOrder>(lds + RING_OFF, g, S, E); }
    }
    STAMP(9); SEAM(3); STAMP(10);
    if (IN(4)) {
        pg8::StaticOrder S; S.init(MP, 1024, G, bx);
        pg8::Gemm g{(const bf16*)(ws + WS_MERGED), (const bf16*)(ws + WS_WO), M, 1024, 1024}; EpiOut E{(bf16*)(ws + WS_H1B), args.in[0], args.in[1]};
        pg8::gemm_phase<EpiOut, pg8::StaticOrder>(lds + RING_OFF, g, S, E);
    }
    STAMP(11); SEAM(4); STAMP(12);
    if (IN(5)) {
        pg8::StaticOrder S; S.init(MP, 1024, G, bx);
        { pg8::Gemm g{(const bf16*)(ws + WS_PB), (const bf16*)(ws + WS_WP), M, 1024, 256}; EpiPe E{(bf16*)(ws + WS_PE)}; pg8::gemm_phase<EpiPe, pg8::StaticOrder>(lds + RING_OFF, g, S, E); }
        { pg8::Gemm g{(const bf16*)(ws + WS_H1B), (const bf16*)(ws + WS_WG), M, 1024, 1024}; EpiGate E{ws, (const bf16*)(ws + WS_PE), (const bf16*)(ws + WS_H1B), (bf16*)(ws + WS_MERGED)}; pg8::gemm_phase<EpiGate, pg8::StaticOrder>(lds + RING_OFF, g, S, E); }
    }
    STAMP(13); SEAM(5); STAMP(14);
    if (IN(6)) { p6_final_norm(args, vcu, G, wave, lane); }
    STAMP(15);
#ifdef PROBE_WG
    xcd_barrier(bar);
    if (bx == 0) { const unsigned long long* sp = (const unsigned long long*)(ws + WS_CTL + ((PROBE_K1 >= 16) ? 65536 : 32768)) + (size_t)(PROBE_WG) * 16 - ((PROBE_K1 >= 16) ? 16 : 0);
        const float X = (PROBE_K1 < 0) ? 0.3f : (float)(__hip_atomic_load(sp + PROBE_K1, __ATOMIC_RELAXED, __HIP_MEMORY_SCOPE_AGENT) - __hip_atomic_load(sp + PROBE_K0, __ATOMIC_RELAXED, __HIP_MEMORY_SCOPE_AGENT)) * 1e-5f * (float)(PROBE_SCALE);
        for (int i = tid; i < 8 * 3 * 1536; i += NTHREADS) args.out[OUT_CONV_P + i] += X; }
#endif
#undef IN
#undef SEAM
}

extern "C" void kernel_launch(void* const* d_in, const int* in_sizes, int n_in, void* d_out, int out_size, void* d_ws, size_t ws_size, hipStream_t stream) {
    static int grid = 0;
    if (grid == 0) {
        if (n_in != 22 || in_sizes[0] != MP * D || (size_t)out_size != OUT_TOTAL || ws_size < WS_END) {
            fprintf(stderr, "kernel_launch: unexpected shapes: n_in %d in0 %d out %d ws %zu (need %zu)\n", n_in, n_in > 0 ? in_sizes[0] : -1, out_size, ws_size, (size_t)WS_END); grid = -1; return; }
        int dev = 0, cus = 0, per_cu = 0;
        if (hipGetDevice(&dev) != hipSuccess || hipDeviceGetAttribute(&cus, hipDeviceAttributeMultiprocessorCount, dev) != hipSuccess) { grid = -1; return; }
        if (hipFuncSetAttribute((const void*)mk_fwd, hipFuncAttributeMaxDynamicSharedMemorySize, LDS_BYTES) != hipSuccess) { fprintf(stderr, "kernel_launch: hipFuncSetAttribute failed\n"); grid = -1; return; }
        if (hipOccupancyMaxActiveBlocksPerMultiprocessor(&per_cu, (const void*)mk_fwd, NTHREADS, LDS_BYTES) != hipSuccess || per_cu < 1) {
            fprintf(stderr, "kernel_launch: occupancy query reports %d workgroups per CU\n", per_cu); (void)hipGetLastError(); grid = -1; return; }
        grid = cus;
    }
    if (grid < 0) return;
    (void)hipMemsetAsync((char*)d_ws + WS_CTL, 0, CTL_ZERO_BYTES, stream);
    Args a{};
    for (int i = 0; i < 22; ++i) a.in[i] = (const float*)d_in[i];
    a.out = (float*)d_out; a.ws = (unsigned char*)d_ws;
#if MK_N_LAUNCHES == 1
    a.ph_lo = 0; a.ph_hi = N_PHASES;
    hipLaunchKernelGGL(mk_fwd, dim3(grid), dim3(NTHREADS), LDS_BYTES, stream, a);
#else
    for (int p = 0; p < N_PHASES; ++p) { a.ph_lo = p; a.ph_hi = p + 1; hipLaunchKernelGGL(mk_fwd, dim3(grid), dim3(NTHREADS), LDS_BYTES, stream, a); }
#endif
}
```

```cpp
#include <hip/hip_runtime.h>
#include <cstdio>
#include <cstdint>
#define MK_N_LAUNCHES 1
#define PROBE_DUP -1
namespace pg8 {
#define PG8_LAS __attribute__((address_space(3)))
typedef unsigned short bf16_t;
typedef short bf16x8 __attribute__((ext_vector_type(8)));
typedef float f32x4 __attribute__((ext_vector_type(4)));
typedef unsigned u32x4 __attribute__((ext_vector_type(4)));
constexpr int BM = 256, BK = 64, HALF = 128, HTB = HALF * BK * 2  , STAGE_BYTES = 8 * HTB, NXCD = 8, WGM = 8;

__host__ __device__ __forceinline__ int lds_byte(int r, int c) { const int st = (r >> 4) * 2 + (c >> 5), rr = r & 15, cc = c & 31, ob = rr * 64 + cc * 2; return st * 1024 + (ob ^ (((ob >> 9) & 1) << 5)); }
__host__ __device__ __forceinline__ void stage_rc(int b, int& R, int& C) { const int st = b / 1024, sb = b % 1024, swz = sb ^ (((sb >> 9) & 1) << 5); R = (st >> 1) * 16 + swz / 64; C = (st & 1) * 32 + (swz % 64) / 2; }
__host__ __device__ __forceinline__ int perm32(int rho) { const int n = rho >> 4, i = rho & 15; return 8 * (i >> 2) + 4 * n + (i & 3); }

struct Unit { int pm, pn; };
struct Gemm { const bf16_t* A; const bf16_t* Bt; int M, N, K; };

struct StaticOrder {
    int nM, nN, nwg, G, c;
    __host__ __device__ void init(int M, int N, int G_, int c_) { nM = M / BM; nN = N / BM; nwg = nM * nN; G = G_; c = c_; }
    __host__ __device__ bool next(int i, Unit& u) const {
        const long L = (long)i * G + c; if (L >= nwg) return false;
        int wgid = (int)L; { const int q = nwg / NXCD, r = nwg % NXCD, xcd = wgid % NXCD, off = wgid / NXCD; wgid = (xcd < r ? xcd * (q + 1) : r * (q + 1) + (xcd - r) * q) + off; }
        const int nig = WGM * nN, gid = wgid / nig, fm = gid * WGM, gsz = (nM - fm) < WGM ? (nM - fm) : WGM;
        u.pm = fm + ((wgid % nig) % gsz); u.pn = (wgid % nig) / gsz; return true;
    }
    __device__ __forceinline__ void a_ready(const Unit&) const {}
    __device__ __forceinline__ void done(const Unit&) const {}
};

typedef __bf16 bf16x2_t __attribute__((ext_vector_type(2)));
typedef float f32x2_t __attribute__((ext_vector_type(2)));
__device__ __forceinline__ unsigned cvt_pk_bf16(float lo, float hi) { const f32x2_t v = {lo, hi}; return __builtin_bit_cast(unsigned, __builtin_convertvector(v, bf16x2_t)); }

template <class Epi, class Sched>
__device__ __forceinline__ void gemm_phase(PG8_LAS unsigned char* lds, const Gemm g, const Sched& S, const Epi& E) {
    int tid_ = threadIdx.x; asm volatile("" : "+v"(tid_));
    const int tid = tid_, wid = __builtin_amdgcn_readfirstlane(tid >> 6), lane = tid & 63, wr = wid >> 2, wc = wid & 3, fr = lane & 15, fq = lane >> 4;
    const int K = g.K, nt = K / BK;
    unsigned voffA[2], voffB[2];
#pragma unroll
    for (int i = 0; i < 2; ++i) { int R, C; stage_rc(tid * 16 + i * 8192, R, C); const int Rb = Epi::PERM ? ((R & ~31) + perm32(R & 31)) : R;
        voffA[i] = (unsigned)(R * K + C) * 2u; voffB[i] = (unsigned)(Rb * K + C) * 2u; }
    const size_t kstep = (size_t)(BK * 2);
    const size_t hstep = (size_t)HALF * K * 2;
    const size_t tstep = 2 * hstep;
    const unsigned ldsw = (unsigned)wid * 1024u;
    const int aoff = lds_byte(wr * 64 + fr, fq * 8), boff = lds_byte(wc * 32 + fr, fq * 8);
#define PG8_SA(b, h) (((b) * 2 + (h)) * HTB)
#define PG8_SB(b, h) ((4 + (b) * 2 + (h)) * HTB)
#define PG8_STAGE(bufoff, gbase, voff) do { _Pragma("unroll") for (int _i = 0; _i < 2; ++_i) \
        __builtin_amdgcn_global_load_lds((const unsigned*)((const char*)(gbase) + (voff)[_i]), (PG8_LAS unsigned*)(lds + (bufoff) + ldsw + _i * 8192), 16, 0, 0); } while (0)
#define PG8_LDA(dst, b, h) do { _Pragma("unroll") for (int m = 0; m < 4; ++m) _Pragma("unroll") for (int k = 0; k < 2; ++k) dst[m][k] = *(const PG8_LAS bf16x8*)(lds + PG8_SA(b, h) + aoff + m * 2048 + k * 1024); } while (0)
#define PG8_LDB(dst, b, h) do { _Pragma("unroll") for (int n = 0; n < 2; ++n) _Pragma("unroll") for (int k = 0; k < 2; ++k) dst[n][k] = *(const PG8_LAS bf16x8*)(lds + PG8_SB(b, h) + boff + n * 2048 + k * 1024); } while (0)
#define PG8_MMA(ai, bj, At, Bt) do { __builtin_amdgcn_s_setprio(1); _Pragma("unroll") for (int m = 0; m < 4; ++m) _Pragma("unroll") for (int n = 0; n < 2; ++n) _Pragma("unroll") for (int k = 0; k < 2; ++k) \
        acc[ai][bj][m][n] = __builtin_amdgcn_mfma_f32_16x16x32_bf16(Bt[n][k], At[m][k], acc[ai][bj][m][n], 0, 0, 0); __builtin_amdgcn_s_setprio(0); } while (0)
#define PG8_WAIT_V(n) asm volatile("s_waitcnt vmcnt(" #n ")" ::: "memory")
#define PG8_WAIT_L(n) asm volatile("s_waitcnt lgkmcnt(" #n ")" ::: "memory")
#define PG8_BAR __builtin_amdgcn_s_barrier()
#define PG8_SCHED __builtin_amdgcn_sched_barrier(0)
    Unit cur, nxt; int ui = 0;
    if (!S.next(0, cur)) return;
    f32x4 acc[2][2][4][2];
#pragma unroll
    for (int a = 0; a < 2; ++a)
#pragma unroll
        for (int b = 0; b < 2; ++b)
#pragma unroll
            for (int m = 0; m < 4; ++m)
#pragma unroll
                for (int n = 0; n < 2; ++n) acc[a][b][m][n] = (f32x4){0.f, 0.f, 0.f, 0.f};
    bf16x8 At[4][2], B0[2][2], B1[2][2];
    const char* cA = (const char*)g.A + (size_t)cur.pm * tstep; const char* cB = (const char*)g.Bt + (size_t)cur.pn * tstep;
    S.a_ready(cur);
    PG8_STAGE(PG8_SB(0, 0), cB, voffB); PG8_STAGE(PG8_SA(0, 0), cA, voffA); PG8_STAGE(PG8_SB(0, 1), cB + hstep, voffB); PG8_STAGE(PG8_SA(0, 1), cA + hstep, voffA);
    if (wr == 1) PG8_BAR;
    PG8_WAIT_V(4); PG8_BAR;
    PG8_STAGE(PG8_SB(1, 0), cB + kstep, voffB); PG8_STAGE(PG8_SA(1, 0), cA + kstep, voffA); PG8_STAGE(PG8_SB(1, 1), cB + hstep + kstep, voffB);
    PG8_WAIT_V(6); PG8_BAR;
    for (;;) {
        const bool has_next = S.next(ui + 1, nxt);
        const char* nA = has_next ? (const char*)g.A + (size_t)nxt.pm * tstep : cA; const char* nB = has_next ? (const char*)g.Bt + (size_t)nxt.pn * tstep : cB;
        for (int t = 0; t < nt; t += 2) {
            const bool last = (t == nt - 2);
            const char* a1 = cA + (size_t)(t + 1) * kstep;
            const char* a2 = last ? nA : cA + (size_t)(t + 2) * kstep; const char* b2 = last ? nB : cB + (size_t)(t + 2) * kstep;
            const char* a3 = a2 + kstep; const char* b3 = b2 + kstep;
            if (last && has_next) S.a_ready(nxt);
            PG8_LDB(B0, 0, 0); PG8_SCHED; PG8_LDA(At, 0, 0); PG8_STAGE(PG8_SA(1, 1), a1 + hstep, voffA);
            PG8_WAIT_L(8); PG8_BAR; PG8_WAIT_L(0); PG8_MMA(0, 0, At, B0); PG8_BAR; PG8_SCHED;
            PG8_LDB(B1, 0, 1); PG8_STAGE(PG8_SB(0, 0), b2, voffB);
            PG8_BAR; PG8_WAIT_L(0); PG8_MMA(0, 1, At, B1); PG8_BAR;
            PG8_LDA(At, 0, 1); PG8_STAGE(PG8_SA(0, 0), a2, voffA);
            PG8_BAR; PG8_WAIT_L(0); PG8_MMA(1, 0, At, B0); PG8_BAR; PG8_SCHED;
            PG8_STAGE(PG8_SB(0, 1), b2 + hstep, voffB);
            PG8_WAIT_V(6); PG8_BAR; PG8_MMA(1, 1, At, B1); PG8_BAR;
            PG8_LDB(B0, 1, 0); PG8_SCHED; PG8_LDA(At, 1, 0); PG8_STAGE(PG8_SA(0, 1), a2 + hstep, voffA);
            PG8_WAIT_L(8); PG8_BAR; PG8_WAIT_L(0); PG8_MMA(0, 0, At, B0); PG8_BAR; PG8_SCHED;
            PG8_LDB(B1, 1, 1); PG8_STAGE(PG8_SB(1, 0), b3, voffB);
            PG8_BAR; PG8_WAIT_L(0); PG8_MMA(0, 1, At, B1); PG8_BAR;
            PG8_LDA(At, 1, 1); PG8_STAGE(PG8_SA(1, 0), a3, voffA);
            PG8_BAR; PG8_WAIT_L(0); PG8_MMA(1, 0, At, B0); PG8_BAR; PG8_SCHED;
            PG8_STAGE(PG8_SB(1, 1), b3 + hstep, voffB);
            PG8_WAIT_V(6); PG8_BAR; PG8_MMA(1, 1, At, B1); PG8_BAR;
        }
        E(acc, cur, wr, wc, fr, fq); S.done(cur);
        if (!has_next) break;
#pragma unroll
        for (int a = 0; a < 2; ++a)
#pragma unroll
            for (int b = 0; b < 2; ++b)
#pragma unroll
                for (int m = 0; m < 4; ++m)
#pragma unroll
                    for (int n = 0; n < 2; ++n) acc[a][b][m][n] = (f32x4){0.f, 0.f, 0.f, 0.f};
        cur = nxt; cA = nA; cB = nB; ++ui;
    }
    PG8_WAIT_V(0);
    if (wr == 0) PG8_BAR;
    PG8_BAR;
#undef PG8_SA
#undef PG8_SB
#undef PG8_STAGE
#undef PG8_LDA
#undef PG8_LDB
#undef PG8_MMA
#undef PG8_WAIT_V
#undef PG8_WAIT_L
#undef PG8_BAR
#undef PG8_SCHED
}
}
struct Args { const float* in[22]; float* out; unsigned char* ws; int ph_lo, ph_hi; };
constexpr int D = 1024, SEQ = 2048, NB = 8, MP = NB * SEQ, DB = 128, DSQ = 8, MS = DB * DSQ, M = MP + MS;
constexpr int NPANEL = 23, NPROJ = NPANEL * 256;
constexpr float NORM_EPS = 1e-6f;
constexpr int GLA_DK = 64, GLA_DV = 128, GDN_DK = 128, GDN_DV = 128, CONV_CH = 1536;

constexpr size_t MiB = 1u << 20;
constexpr size_t SZ_PANEL = (size_t)M * 256 * 2;
constexpr size_t WS_CTL = 0, CTL_ZERO_BYTES = 128 * 1024;
constexpr size_t WS_WIN = CTL_ZERO_BYTES;
constexpr size_t WS_WUA = WS_WIN + (size_t)NPROJ * 1024 * 2;
constexpr size_t WS_WUB = WS_WUA + 1 * MiB;
constexpr size_t WS_WO = WS_WUB + 1 * MiB;
constexpr size_t WS_WG = WS_WO + 2 * MiB;
constexpr size_t WS_WP = WS_WG + 2 * MiB;
constexpr size_t WS_SPEC = WS_WP + MiB / 2;
constexpr size_t WS_RSSP = WS_SPEC + (size_t)M * 32 * 2;
constexpr size_t WS_CDEC = WS_RSSP + (size_t)M * 16 * 4;
constexpr size_t WS_PB = WS_CDEC + 4096;
constexpr size_t WS_XN = WS_PB + SZ_PANEL;
constexpr size_t WS_PROJ = WS_XN + (size_t)M * 1024 * 2;
constexpr size_t WS_REC = WS_PROJ + 14 * SZ_PANEL;
constexpr size_t WS_T1 = WS_REC + (size_t)1024 * 73728;
constexpr size_t WS_END = WS_T1 + 2 * MiB;
static_assert(WS_END <= 256 * MiB, "workspace map exceeds 256 MiB");
static_assert(WS_WIN % 256 == 0 && WS_SPEC % 256 == 0 && WS_RSSP % 256 == 0 && WS_PB % 256 == 0 && WS_XN % 256 == 0 && WS_PROJ % 256 == 0 && WS_REC % 256 == 0, "alignment");
constexpr size_t WS_OA = WS_XN, WS_OB = WS_XN + (size_t)M * 512 * 2;
constexpr size_t WS_MERGED = WS_PROJ + 0 * SZ_PANEL;
constexpr size_t WS_H1B = WS_PROJ + 6 * SZ_PANEL;
constexpr size_t WS_PE = WS_PROJ + 10 * SZ_PANEL;
constexpr int PN_QA = 0, PN_KA = 1, PN_VA = 2, PN_ZA = 4, PN_QB = 6, PN_KB = 8, PN_VB = 10, PN_ZB = 12, PN_GA = 14, PN_GB = 18, PN_SPEC = 22;
constexpr size_t OUT_Y = 0, OUT_GLA_P = (size_t)M * D, OUT_GDN_P = OUT_GLA_P + 8 * 4 * 64 * 128, OUT_CONV_P = OUT_GDN_P + 8 * 4 * 128 * 128,
                 OUT_GLA_S = OUT_CONV_P + 8 * 3 * 1536, OUT_GDN_S = OUT_GLA_S + (size_t)128 * 4 * 64 * 128, OUT_CONV_S = OUT_GDN_S + (size_t)128 * 4 * 128 * 128,
                 OUT_TOTAL = OUT_CONV_S + 128 * 3 * 1536;
constexpr int CW_BAR = 1024;

constexpr int RING_OFF = 0, RING_BYTES = 131072;
constexpr int LDS_BYTES = 163840;
constexpr int LDSCTL_OFF = LDS_BYTES - 512, MISC_OFF = LDSCTL_OFF + 320;
constexpr int NWAVES = 8, NTHREADS = 512;

#define GAS __attribute__((address_space(1)))
#define LAS __attribute__((address_space(3)))
typedef unsigned short bf16;
typedef unsigned v4u __attribute__((ext_vector_type(4)));
typedef unsigned v2u __attribute__((ext_vector_type(2)));
typedef float f32x4 __attribute__((ext_vector_type(4)));
typedef GAS unsigned gu32;
#define RLX_AGENT __ATOMIC_RELAXED, __HIP_MEMORY_SCOPE_AGENT
#define LDS_WAIT() asm volatile("s_waitcnt lgkmcnt(0)" ::: "memory")
#define VM_WAIT() asm volatile("s_waitcnt vmcnt(0)" ::: "memory")
__device__ __forceinline__ unsigned pk2(float lo, float hi) { return pg8::cvt_pk_bf16(lo, hi); }
__device__ __forceinline__ unsigned f2bf(float f) { return pg8::cvt_pk_bf16(f, 0.f) & 0xffffu; }
__device__ __forceinline__ float bf2f(unsigned short b) { return __builtin_bit_cast(float, (unsigned)b << 16); }
__device__ __forceinline__ float bflo(unsigned w) { return __builtin_bit_cast(float, w << 16); }
__device__ __forceinline__ float bfhi(unsigned w) { return __builtin_bit_cast(float, w & 0xffff0000u); }
__device__ __forceinline__ float rcpf_(float x) { return __builtin_amdgcn_rcpf(x); }
__device__ __forceinline__ float rsqf_(float x) { return __builtin_amdgcn_rsqf(x); }
__device__ __forceinline__ float sigmoidf_(float x) { return rcpf_(1.f + __expf(-x)); }
__device__ __forceinline__ float siluf_(float x) { return x * rcpf_(1.f + __expf(-x)); }
__device__ __forceinline__ float softplusf_(float x) { return fmaxf(x, 0.f) + log1pf(__expf(-fabsf(x))); }
__device__ __forceinline__ float wave_sum(float v) {
#pragma unroll
    for (int o = 1; o < 64; o <<= 1) v += __shfl_xor(v, o);
    return v;
}

#define XB_TMO      128
#define XB_XCNT(j)  (256  + 64 * (j))
#define XB_XSUB(j)  (1280 + 64 * (j))
#define XB_XGEN(j)  (2304 + 64 * (j))
#define XB_TOP      3328
#define XB_TOPGEN   3392
#define XCD_BAR_WORDS 3456
#define XB_SPIN_CAP (1u << 18)
__device__ __forceinline__ unsigned xb_ld(unsigned* p)              { return __hip_atomic_load(p, __ATOMIC_RELAXED, __HIP_MEMORY_SCOPE_AGENT); }
__device__ __forceinline__ unsigned xb_add(unsigned* p, unsigned v) { return __hip_atomic_fetch_add(p, v, __ATOMIC_RELAXED, __HIP_MEMORY_SCOPE_AGENT); }
__device__ __forceinline__ unsigned xb_xcc_id() { return (unsigned)__builtin_amdgcn_s_getreg((3 << 11) | 20) & 0xFu; }
#define XB_SPIN(cond, bar) do { unsigned _sp = 0; while (cond) { __builtin_amdgcn_s_sleep(1); \
    if ((++_sp & 255u) == 0u) { if (xb_ld(&(bar)[XB_TMO])) break; if (_sp > XB_SPIN_CAP) { atomicAdd(&(bar)[XB_TMO], 1u); break; } } } } while (0)
struct XcdBarrier { unsigned* bar; unsigned x; volatile LAS unsigned* st; };
__device__ __forceinline__ XcdBarrier xcd_barrier_post(unsigned* bar, volatile LAS unsigned* st) {
    XcdBarrier b; b.bar = bar; b.x = xb_xcc_id(); b.st = st;
    if (threadIdx.x == 0) (void)xb_add(&bar[XB_XCNT(b.x)], 1u);
    return b;
}
__device__ __forceinline__ void xcd_barrier_complete(unsigned* bar, unsigned x, unsigned& nloc, unsigned& nx) {
    const unsigned G = gridDim.x * gridDim.y * gridDim.z;
    unsigned sum, cnt, mine, sp = 0u;
    for (;;) {
        sum = 0u; cnt = 0u; mine = 0u;
#pragma unroll
        for (unsigned j = 0; j < 16; ++j) { const unsigned c = xb_ld(&bar[XB_XCNT(j)]); sum += c; cnt += (c > 0u) ? 1u : 0u; mine = (j == x) ? c : mine; }
        if (sum == G) break;
        __builtin_amdgcn_s_sleep(1);
        if ((++sp & 255u) == 0u) { if (xb_ld(&bar[XB_TMO])) break; if (sp > XB_SPIN_CAP) { atomicAdd(&bar[XB_TMO], 1u); break; } }
    }
    nloc = mine > 0u ? mine : 1u; nx = cnt > 0u ? cnt : 1u;
}
__device__ __forceinline__ void xcd_barrier(const XcdBarrier& b) {
    asm volatile("s_waitcnt vmcnt(0)" ::: "memory");
    __syncthreads();
    if (threadIdx.x == 0) {
        unsigned* bar = b.bar;
        __builtin_amdgcn_s_waitcnt(0);
        unsigned nloc = b.st[0], nx = b.st[1];
        if (nloc == 0u) { xcd_barrier_complete(bar, b.x, nloc, nx); b.st[0] = nloc; b.st[1] = nx; }
        const unsigned old = xb_add(&bar[XB_XSUB(b.x)], 1u);
        const unsigned gen = old / nloc;
        if (old + 1u == (gen + 1u) * nloc) {
            __builtin_amdgcn_fence(__ATOMIC_RELEASE, "agent");
            asm volatile("s_waitcnt vmcnt(0)" ::: "memory");
            const unsigned og = xb_add(&bar[XB_TOP], 1u);
            const unsigned tg = og / nx;
            if (og + 1u == (tg + 1u) * nx) xb_add(&bar[XB_TOPGEN], 1u);
            else XB_SPIN(xb_ld(&bar[XB_TOPGEN]) == tg, bar);
            __builtin_amdgcn_fence(__ATOMIC_ACQUIRE, "agent");
            xb_add(&bar[XB_XGEN(b.x)], 1u);
            asm volatile("s_waitcnt vmcnt(0)" ::: "memory");
        } else {
            XB_SPIN(xb_ld(&bar[XB_XGEN(b.x)]) == gen, bar);
            __builtin_amdgcn_fence(__ATOMIC_ACQUIRE, "agent");
            asm volatile("s_waitcnt vmcnt(0)" ::: "memory");
        }
    }
    __syncthreads();
}

struct Frame {
    LAS unsigned char* lds;
    volatile LAS unsigned* MISC;
    int tid, lane, wave, G, vcu;
    const float* in[22];
    float* out;
    unsigned char* ws;
};
__device__ __forceinline__ int win_src_col(int n) {
    if (n < 1024) return n;
    if (n < 3072) return n + 16;
    if (n < 5632) return n + 24;
    if (n < 5648) return 1024 + (n - 5632);
    if (n < 5656) return 3088 + (n - 5648);
    return -1;
}
template <bool MAPCOL>
__device__ __forceinline__ void p0_transpose_item(const float* W, int K, int Nsrc, int Ndst, bf16* WT, LAS float* scr, int item, int lane) {
    const int nblk = Ndst / 32, kb = item / nblk, nb = item % nblk, k0 = 64 * kb, n0 = 32 * nb;
    int sc = n0 + (lane & 31); if (MAPCOL) sc = win_src_col(sc);
#pragma unroll 8
    for (int i = 0; i < 32; ++i) { const int kk = 2 * i + (lane >> 5); scr[kk * 33 + (lane & 31)] = (sc >= 0) ? W[(size_t)(k0 + kk) * Nsrc + sc] : 0.f; }
    LDS_WAIT(); asm volatile("" ::: "memory");
    const int c = lane & 7;
#pragma unroll
    for (int j = 0; j < 4; ++j) { const int n = (lane >> 3) + 8 * j; const LAS float* s = scr + (8 * c) * 33 + n;
        v4u o; o.x = pk2(s[0 * 33], s[1 * 33]); o.y = pk2(s[2 * 33], s[3 * 33]); o.z = pk2(s[4 * 33], s[5 * 33]); o.w = pk2(s[6 * 33], s[7 * 33]);
        *(GAS v4u*)(WT + (size_t)(n0 + n) * K + k0 + 8 * c) = o; }
    LDS_WAIT(); asm volatile("" ::: "memory");
}
__device__ __forceinline__ void rms_row_to_bf16(const float* xrow, const float* w, bf16* orow, int lane) {
    const GAS f32x4* xr = (const GAS f32x4*)xrow + lane;
    const GAS f32x4* wr = (const GAS f32x4*)w + lane;
    f32x4 v[4]; float s = 0.f;
#pragma unroll
    for (int j = 0; j < 4; ++j) { v[j] = xr[64 * j]; s += (v[j].x * v[j].x + v[j].y * v[j].y) + (v[j].z * v[j].z + v[j].w * v[j].w); }
    const float r = rsqf_(wave_sum(s) * (1.f / D) + NORM_EPS);
    GAS unsigned long long* o8 = (GAS unsigned long long*)orow + lane;
#pragma unroll
    for (int j = 0; j < 4; ++j) { const f32x4 ww = wr[64 * j];
        o8[64 * j] = (unsigned long long)pk2(v[j].x * r * ww.x, v[j].y * r * ww.y) | ((unsigned long long)pk2(v[j].z * r * ww.z, v[j].w * r * ww.w) << 32); }
}
__device__ __forceinline__ void p0_prologue(const Args& A, LAS unsigned char* lds, int vcu, int G, int wave, int lane) {
    LAS float* scr = (LAS float*)(lds + RING_OFF + wave * 16384);
    const int gw = vcu * NWAVES + wave, NGW = G * NWAVES;
    unsigned char* ws = A.ws;
    constexpr int I_IN = (1024 / 64) * (NPROJ / 32), I_UP = (512 / 64) * (1024 / 32), I_SQ = (1024 / 64) * (1024 / 32), I_PL = (256 / 64) * (1024 / 32);
    constexpr int NITEMS = I_IN + 2 * I_UP + 2 * I_SQ + I_PL;
    for (int it = gw; it < NITEMS; it += NGW) {
        int r = it;
        if (r < I_IN) { p0_transpose_item<true>(A.in[8], 1024, 5656, NPROJ, (bf16*)(ws + WS_WIN), scr, r, lane); continue; } r -= I_IN;
        if (r < I_UP) { p0_transpose_item<false>(A.in[16], 512, 1024, 1024, (bf16*)(ws + WS_WUA), scr, r, lane); continue; } r -= I_UP;
        if (r < I_UP) { p0_transpose_item<false>(A.in[17], 512, 1024, 1024, (bf16*)(ws + WS_WUB), scr, r, lane); continue; } r -= I_UP;
        if (r < I_SQ) { p0_transpose_item<false>(A.in[18], 1024, 1024, 1024, (bf16*)(ws + WS_WO), scr, r, lane); continue; } r -= I_SQ;
        if (r < I_SQ) { p0_transpose_item<false>(A.in[19], 1024, 1024, 1024, (bf16*)(ws + WS_WG), scr, r, lane); continue; } r -= I_SQ;
        p0_transpose_item<false>(A.in[20], 256, 1024, 1024, (bf16*)(ws + WS_WP), scr, r, lane);
    }
    bf16* XN = (bf16*)(ws + WS_XN);
    for (int m = gw; m < M; m += NGW) {
        const float* xrow = (m < MP) ? A.in[0] + (size_t)m * D : A.in[1] + (size_t)(m - MP) * D;
        rms_row_to_bf16(xrow, A.in[7], XN + (size_t)m * D, lane);
    }
    bf16* PB = (bf16*)(ws + WS_PB);
    const int gt = gw * 64 + lane, NGT = NGW * 64;
    for (int i = gt; i < M * 256 / 8; i += NGT) {
        const size_t e = (size_t)i * 8; const int m = (int)(e >> 8), c = (int)(e & 255);
        const float* src = (m < MP) ? A.in[5] + (size_t)m * 256 + c : A.in[6] + (size_t)(m - MP) * 256 + c;
        const f32x4 a = *(const GAS f32x4*)src, b = *(const GAS f32x4*)(src + 4);
        v4u o; o.x = pk2(a.x, a.y); o.y = pk2(a.z, a.w); o.z = pk2(b.x, b.y); o.w = pk2(b.z, b.w);
        *(GAS v4u*)(PB + e) = o;
    }
}
__device__ __forceinline__ const bf16* panel(const unsigned char* ws, int pn) { return (const bf16*)(ws + WS_PROJ + (size_t)pn * SZ_PANEL); }
#ifdef PROBE_WG
#define STAMP3(k) do { if (threadIdx.x == 0) ((unsigned long long*)(A.ws + WS_CTL + 65536))[(size_t)blockIdx.x * 16 + (k)] = __builtin_amdgcn_s_memrealtime(); } while (0)
#else
#define STAMP3(k) do { } while (0)
#endif
#define LBAR() do { asm volatile("s_waitcnt lgkmcnt(0)" ::: "memory"); __builtin_amdgcn_s_barrier(); asm volatile("" ::: "memory"); } while (0)
template <int CTRL> __device__ __forceinline__ float dpp_f(float v) { return __builtin_bit_cast(float, __builtin_amdgcn_update_dpp(0, __builtin_bit_cast(int, v), CTRL, 0xf, 0xf, true)); }
__device__ __forceinline__ float rl_f(float v, int l) { return __builtin_bit_cast(float, __builtin_amdgcn_readlane(__builtin_bit_cast(int, v), l)); }
__device__ __forceinline__ float wsum(float v) {
    v += dpp_f<0xB1>(v); v += dpp_f<0x4E>(v); v += dpp_f<0x141>(v); v += dpp_f<0x140>(v);
    return (rl_f(v, 0) + rl_f(v, 16)) + (rl_f(v, 32) + rl_f(v, 48));
}
__device__ __forceinline__ float quad_sum(float v) { v += dpp_f<0xB1>(v); v += dpp_f<0x4E>(v); return v; }

__device__ __forceinline__ void gla_item_s(const Args& A, LAS unsigned char* lds, int h, int m0, const float* S0, float* Sout) {
    const int tid = threadIdx.x, lane = tid & 63, wave = tid >> 6;
    const unsigned char* ws = A.ws;
    LAS float* sq = (LAS float*)lds; LAS float* sk = sq + 512; LAS float* sd = sk + 512; LAS float* sv = sd + 512; LAS float* part = sv + 1024; LAS float* oraw = part + 1024;
    const int dv = tid & 127, g = tid >> 7;
    float S[16];
#pragma unroll
    for (int i = 0; i < 16; ++i) S[i] = S0[(size_t)(g * 16 + i) * 128 + dv];
    const bf16* PQ = panel(ws, PN_QA); const bf16* PK = panel(ws, PN_KA); const bf16* PV = panel(ws, PN_VA + (h >> 1)); const bf16* PZ = panel(ws, PN_ZA + (h >> 1));
    const bf16* SPEC = (const bf16*)(ws + WS_SPEC);
    const size_t mt = (size_t)m0 + wave;
    const unsigned short qh = PQ[mt * 256 + h * 64 + lane], kh = PK[mt * 256 + h * 64 + lane];
    const unsigned vw = *(const GAS unsigned*)(PV + mt * 256 + (h & 1) * 128 + 2 * lane);
    const unsigned zw = *(const GAS unsigned*)(PZ + mt * 256 + (h & 1) * 128 + 2 * lane);
    const v4u ga0 = *(const GAS v4u*)(SPEC + mt * 32), ga1 = *(const GAS v4u*)(SPEC + mt * 32 + 8);
    float wg[16];
#pragma unroll
    for (int r = 0; r < 16; ++r) wg[r] = A.in[9][r * 256 + h * 64 + lane];
    const float bgv = A.in[10][h * 64 + lane];
    const float nw0 = A.in[11][2 * lane], nw1 = A.in[11][2 * lane + 1];
    { float x = bgv; const unsigned gw[8] = {ga0.x, ga0.y, ga0.z, ga0.w, ga1.x, ga1.y, ga1.z, ga1.w};
#pragma unroll
      for (int r = 0; r < 8; ++r) x += bflo(gw[r]) * wg[2 * r] + bfhi(gw[r]) * wg[2 * r + 1];
      const float ls = fminf(x, 0.f) - log1pf(__expf(-fabsf(x)));
      sd[wave * 64 + lane] = __expf(ls * (1.f / 16.f)); sq[wave * 64 + lane] = bf2f(qh) * 0.125f; sk[wave * 64 + lane] = bf2f(kh);
      sv[wave * 128 + 2 * lane] = bflo(vw); sv[wave * 128 + 2 * lane + 1] = bfhi(vw); }
    LBAR();
#pragma unroll 1
    for (int tk = 0; tk < 8; ++tk) {
        const float vv = sv[tk * 128 + dv];
        float po = 0.f;
#pragma unroll
        for (int i = 0; i < 16; ++i) { const int dk = g * 16 + i; S[i] = sd[tk * 64 + dk] * S[i] + sk[tk * 64 + dk] * vv; po += sq[tk * 64 + dk] * S[i]; }
        part[((tk & 1) * 4 + g) * 128 + dv] = po;
        LBAR();
        if (g == 0) { const LAS float* pp = part + (tk & 1) * 512 + dv; oraw[tk * 128 + dv] = (pp[0] + pp[128]) + (pp[256] + pp[384]); }
    }
#pragma unroll
    for (int i = 0; i < 16; ++i) Sout[(size_t)(g * 16 + i) * 128 + dv] = S[i];
    LBAR();
    { bf16* OA = (bf16*)(A.ws + WS_OA);
      const float o0 = oraw[wave * 128 + 2 * lane], o1 = oraw[wave * 128 + 2 * lane + 1];
      const float r = rsqf_(wsum(o0 * o0 + o1 * o1) * (1.f / 128.f) + NORM_EPS);
      *(GAS unsigned*)(OA + mt * 512 + h * 128 + 2 * lane) = pk2(o0 * r * nw0 * siluf_(bflo(zw)), o1 * r * nw1 * siluf_(bfhi(zw))); }
    LBAR();
}

__device__ __forceinline__ void gdn_item_s(const Args& A, LAS unsigned char* lds, int h, int m0, const float* S0, float* Sout, const float* convbuf) {
    const int tid = threadIdx.x, lane = tid & 63, wave = tid >> 6;
    const unsigned char* ws = A.ws;
    LAS float* sq = (LAS float*)lds; LAS float* sk = sq + 1024; LAS float* sv = sk + 1024; LAS float* sbeta = sv + 1024; LAS float* sgd = sbeta + 8; LAS float* sqk = sgd + 8;
    LAS float* part = sqk + 16; LAS float* oraw = part + 2048;
    const int dv = tid & 127, g = tid >> 7;
    float S[32];
#pragma unroll
    for (int i = 0; i < 32; ++i) S[i] = S0[(size_t)(g * 32 + i) * 128 + dv];
    const bf16* SPEC = (const bf16*)(ws + WS_SPEC);
    const size_t mt = (size_t)m0 + wave;
    const bf16* PZ = panel(ws, PN_ZB + (h >> 1));
    const unsigned zw = *(const GAS unsigned*)(PZ + mt * 256 + (h & 1) * 128 + 2 * lane);
    const float nw0 = A.in[15][2 * lane], nw1 = A.in[15][2 * lane + 1];
    float raw[11], cw[4]; const int c = tid, seg = c >> 7, cc = c & 127;
    if (tid < 384) { const bf16* P = panel(ws, PN_QB + 2 * seg + (h >> 1)); const int ch = seg * 512 + h * 128 + cc;
#pragma unroll
        for (int j = 0; j < 3; ++j) raw[j] = convbuf[j * 1536 + ch];
#pragma unroll
        for (int j = 0; j < 8; ++j) raw[3 + j] = bf2f(P[(size_t)(m0 + j) * 256 + (h & 1) * 128 + cc]);
#pragma unroll
        for (int j = 0; j < 4; ++j) cw[j] = A.in[12][j * 1536 + ch]; }
    float bta = 0.f, gdv = 0.f;
    if (tid < 8) { const size_t m = (size_t)m0 + tid; bta = bf2f(SPEC[m * 32 + 20 + h]); gdv = bf2f(SPEC[m * 32 + 16 + h]); }
    const float negA = -__expf(A.in[13][h]), dtb = A.in[14][h];
    if (tid < 384) { LAS float* dst = seg == 0 ? sq : (seg == 1 ? sk : sv);
#pragma unroll
        for (int t = 0; t < 8; ++t) dst[t * 128 + cc] = siluf_(cw[0] * raw[t] + cw[1] * raw[t + 1] + cw[2] * raw[t + 2] + cw[3] * raw[t + 3]); }
    if (tid < 8) { sbeta[tid] = sigmoidf_(bta); sgd[tid] = __expf(negA * softplusf_(gdv + dtb)); }
    LBAR();
    { float q0 = sq[wave * 128 + lane], q1 = sq[wave * 128 + lane + 64], k0 = sk[wave * 128 + lane], k1 = sk[wave * 128 + lane + 64];
      const float rq = 0.08838834764831845f * rsqf_(wsum(q0 * q0 + q1 * q1) + NORM_EPS), rk = rsqf_(wsum(k0 * k0 + k1 * k1) + NORM_EPS);
      q0 *= rq; q1 *= rq; k0 *= rk; k1 *= rk;
      sq[wave * 128 + lane] = q0; sq[wave * 128 + lane + 64] = q1; sk[wave * 128 + lane] = k0; sk[wave * 128 + lane + 64] = k1;
      const float qk = wsum(q0 * k0 + q1 * k1); if (lane == 0) sqk[wave] = qk; }
    LBAR();
#pragma unroll 1
    for (int tk = 0; tk < 8; ++tk) {
        float pk = 0.f, pq = 0.f;
#pragma unroll
        for (int i = 0; i < 32; ++i) { const int dk = g * 32 + i; pk += sk[tk * 128 + dk] * S[i]; pq += sq[tk * 128 + dk] * S[i]; }
        LAS float* pp = part + (tk & 1) * 1024;
        pp[g * 128 + dv] = pk; pp[512 + g * 128 + dv] = pq;
        LBAR();
        const float gd = sgd[tk];
        const float kS = gd * ((pp[dv] + pp[128 + dv]) + (pp[256 + dv] + pp[384 + dv]));
        const float vnew = sbeta[tk] * (sv[tk * 128 + dv] - kS);
#pragma unroll
        for (int i = 0; i < 32; ++i) { const int dk = g * 32 + i; S[i] = gd * S[i] + sk[tk * 128 + dk] * vnew; }
        if (g == 0) { const float qS = gd * ((pp[512 + dv] + pp[640 + dv]) + (pp[768 + dv] + pp[896 + dv])); oraw[tk * 128 + dv] = qS + sqk[tk] * vnew; }
    }
#pragma unroll
    for (int i = 0; i < 32; ++i) Sout[(size_t)(g * 32 + i) * 128 + dv] = S[i];
    LBAR();
    { bf16* OB = (bf16*)(A.ws + WS_OB);
      const float o0 = oraw[wave * 128 + 2 * lane], o1 = oraw[wave * 128 + 2 * lane + 1];
      const float r = rsqf_(wsum(o0 * o0 + o1 * o1) * (1.f / 128.f) + NORM_EPS);
      *(GAS unsigned*)(OB + mt * 512 + h * 128 + 2 * lane) = pk2(o0 * r * nw0 * siluf_(bflo(zw)), o1 * r * nw1 * siluf_(bfhi(zw))); }
    LBAR();
}
typedef short bf16x8 __attribute__((ext_vector_type(8)));
typedef float f32x16 __attribute__((ext_vector_type(16)));
typedef float f32x4v __attribute__((ext_vector_type(4)));
typedef float f32x2v __attribute__((ext_vector_type(2)));
#define MFMA32(a, b, c) __builtin_amdgcn_mfma_f32_32x32x16_bf16((a), (b), (c), 0, 0, 0)
#define MFMA16(a, b, c) __builtin_amdgcn_mfma_f32_16x16x32_bf16((a), (b), (c), 0, 0, 0)
__device__ __forceinline__ int c32row(int lane, int reg) { return (reg & 3) + 8 * (reg >> 2) + 4 * (lane >> 5); }
__device__ __forceinline__ bf16x8 acc_frag(const f32x16& c, int s) {
    v4u w;
    if (s == 0) { w.x = pg8::cvt_pk_bf16(c[0], c[1]); w.y = pg8::cvt_pk_bf16(c[2], c[3]); w.z = pg8::cvt_pk_bf16(c[4], c[5]); w.w = pg8::cvt_pk_bf16(c[6], c[7]); }
    else { w.x = pg8::cvt_pk_bf16(c[8], c[9]); w.y = pg8::cvt_pk_bf16(c[10], c[11]); w.z = pg8::cvt_pk_bf16(c[12], c[13]); w.w = pg8::cvt_pk_bf16(c[14], c[15]); }
    return __builtin_bit_cast(bf16x8, w);
}
__device__ __forceinline__ bf16x8 lds_frag(const LAS bf16* rowp, int k0, int h) { return *(const LAS bf16x8*)(rowp + k0 + 8 * h); }
__device__ __forceinline__ bf16x8 lds_frag_perm(const LAS bf16* rowp, int s, int h) {
    const v2u a = *(const LAS v2u*)(rowp + 16 * s + 4 * h), b = *(const LAS v2u*)(rowp + 16 * s + 8 + 4 * h);
    v4u w; w.x = a.x; w.y = a.y; w.z = b.x; w.w = b.y; return __builtin_bit_cast(bf16x8, w);
}
__device__ __forceinline__ f32x16 zero16() { f32x16 z;
#pragma unroll
    for (int i = 0; i < 16; ++i) z[i] = 0.f; return z; }

__device__ __forceinline__ v4u pack8(const f32x4 a, const f32x4 b) { v4u w; w.x = pg8::cvt_pk_bf16(a.x, a.y); w.y = pg8::cvt_pk_bf16(a.z, a.w); w.z = pg8::cvt_pk_bf16(b.x, b.y); w.w = pg8::cvt_pk_bf16(b.z, b.w); return w; }
__device__ __forceinline__ void unpack8(const v4u w, f32x4& a, f32x4& b) { a = (f32x4){bflo(w.x), bfhi(w.x), bflo(w.y), bfhi(w.y)}; b = (f32x4){bflo(w.z), bfhi(w.z), bflo(w.w), bfhi(w.w)}; }
__device__ __forceinline__ f32x4 sig4(const f32x4 x) { return (f32x4){sigmoidf_(x.x), sigmoidf_(x.y), sigmoidf_(x.z), sigmoidf_(x.w)}; }
constexpr int GLA_QE = 0, GLA_KE = 9216, GLA_KENDT = 18432, GLA_VT = 27648, GLA_ATT = 46080, GLA_GA = 55296, GLA_SEG = 59392, GLA_DD = 61440, GLA_OBUF = 61696,
              GLA_RQ = GLA_OBUF + 64 * 132 * 4, GLA_RK = GLA_RQ + 8192, GLA_RV = GLA_RK + 8192, GLA_RZ = GLA_RV + 16384, GLA_RS = GLA_RZ + 16384, GLA_LDS_END = GLA_RS + 4096;
static_assert(GLA_LDS_END <= LDS_BYTES - 512, "GLA LDS");
struct GlaState { f32x16 S[2]; bf16x8 Sb[4]; };
#define SB0() __builtin_amdgcn_sched_barrier(0)
#define GLDS16(gp, lp) __builtin_amdgcn_global_load_lds((const unsigned*)(gp), (LAS unsigned*)(lp), 16, 0, 0)
__device__ __forceinline__ void gla_issue_vs(const Args& A, LAS unsigned char* lds, int b, int h, int n) {
    const int lane = threadIdx.x & 63, wave = __builtin_amdgcn_readfirstlane(threadIdx.x >> 6); const unsigned char* ws = A.ws; const size_t m0 = (size_t)b * SEQ + (size_t)n * 64;
    const unsigned char* PV = ws + WS_PROJ + (size_t)(PN_VA + (h >> 1)) * SZ_PANEL + (h & 1) * 256;
#pragma unroll
    for (int k = 0; k < 2; ++k) { const int p = wave * 2 + k;
        GLDS16(PV + (m0 + 4 * p + (lane >> 4)) * 512 + (lane & 15) * 16, lds + GLA_RV + p * 1024); }
    { const int p = wave & 3;
        GLDS16(ws + WS_SPEC + (m0 + 16 * p + (lane >> 2)) * 64 + (lane & 3) * 16, lds + GLA_RS + p * 1024); }
}
__device__ __forceinline__ void gla_issue_qk(const Args& A, LAS unsigned char* lds, int b, int h, int n) {
    const int lane = threadIdx.x & 63, wave = __builtin_amdgcn_readfirstlane(threadIdx.x >> 6); const unsigned char* ws = A.ws; const size_t m0 = (size_t)b * SEQ + (size_t)n * 64;
    const size_t ro = (m0 + 8 * wave + (lane >> 3)) * 512 + h * 128 + (lane & 7) * 16;
    GLDS16(ws + WS_PROJ + (size_t)PN_QA * SZ_PANEL + ro, lds + GLA_RQ + wave * 1024);
    GLDS16(ws + WS_PROJ + (size_t)PN_KA * SZ_PANEL + ro, lds + GLA_RK + wave * 1024);
}
__device__ __forceinline__ void gla_issue_z(const Args& A, LAS unsigned char* lds, int b, int h, int n) {
    const int lane = threadIdx.x & 63, wave = __builtin_amdgcn_readfirstlane(threadIdx.x >> 6); const unsigned char* ws = A.ws; const size_t m0 = (size_t)b * SEQ + (size_t)n * 64;
    const unsigned char* PZ = ws + WS_PROJ + (size_t)(PN_ZA + (h >> 1)) * SZ_PANEL + (h & 1) * 256;
#pragma unroll
    for (int k = 0; k < 2; ++k) { const int p = wave * 2 + k; GLDS16(PZ + (m0 + 4 * p + (lane >> 4)) * 512 + (lane & 15) * 16, lds + GLA_RZ + p * 1024); }
}
#define VMW(n) asm volatile("s_waitcnt vmcnt(" #n ")" ::: "memory")
__device__ __forceinline__ void gla_chunk(const Args& A, LAS unsigned char* lds, int b, int h, int n, GlaState& st, const float (&wg)[16], float bgv, float nw0, float nw1) {
    const int tid = threadIdx.x, lane = tid & 63, wave = __builtin_amdgcn_readfirstlane(tid >> 6), r = lane & 31, hh = lane >> 5;
    const size_t m0 = (size_t)b * SEQ + (size_t)n * 64;
    const int nn = (n + 1 < 32) ? n + 1 : 31;
    LAS bf16* QE = (LAS bf16*)(lds + GLA_QE); LAS bf16* KE = (LAS bf16*)(lds + GLA_KE); LAS bf16* KENDT = (LAS bf16*)(lds + GLA_KENDT);
    LAS bf16* VT = (LAS bf16*)(lds + GLA_VT); LAS bf16* ATT = (LAS bf16*)(lds + GLA_ATT);
    LAS float* GA = (LAS float*)(lds + GLA_GA); LAS float* SEG = (LAS float*)(lds + GLA_SEG); LAS float* DD = (LAS float*)(lds + GLA_DD); LAS float* OBUF = (LAS float*)(lds + GLA_OBUF);
    const LAS bf16* RQ = (const LAS bf16*)(lds + GLA_RQ); const LAS bf16* RK = (const LAS bf16*)(lds + GLA_RK); const LAS bf16* RV = (const LAS bf16*)(lds + GLA_RV);
    const LAS bf16* RZ = (const LAS bf16*)(lds + GLA_RZ); const LAS bf16* RS = (const LAS bf16*)(lds + GLA_RS);
    if (n == 2) STAMP3(0);
    { const int t = tid >> 3, c2 = (tid & 7) * 2; const unsigned w = *(const LAS unsigned*)(RS + t * 32 + c2); GA[t * 16 + c2] = bflo(w); GA[t * 16 + c2 + 1] = bfhi(w); }
    { unsigned vv[8];
#pragma unroll
      for (int i = 0; i < 8; ++i) vv[i] = *(const LAS unsigned*)(RV + (wave * 8 + i) * 128 + 2 * lane);
      v4u lo, hi; lo.x = (vv[0] & 0xffffu) | (vv[1] << 16); lo.y = (vv[2] & 0xffffu) | (vv[3] << 16); lo.z = (vv[4] & 0xffffu) | (vv[5] << 16); lo.w = (vv[6] & 0xffffu) | (vv[7] << 16);
      hi.x = (vv[0] >> 16) | (vv[1] & 0xffff0000u); hi.y = (vv[2] >> 16) | (vv[3] & 0xffff0000u); hi.z = (vv[4] >> 16) | (vv[5] & 0xffff0000u); hi.w = (vv[6] >> 16) | (vv[7] & 0xffff0000u);
      *(LAS v4u*)(VT + (2 * lane) * 72 + wave * 8) = lo; *(LAS v4u*)(VT + (2 * lane + 1) * 72 + wave * 8) = hi; }
    LBAR();
    gla_issue_vs(A, lds, b, h, nn);
    if (n == 2) STAMP3(1);
    const int dk = tid & 63, seg = tid >> 6;
    float cs[8];
    { float run = 0.f;
#pragma unroll
      for (int i = 0; i < 8; ++i) { const int t = seg * 8 + i; float x = bgv;
#pragma unroll
          for (int q = 0; q < 4; ++q) { const f32x4v g4 = *(const LAS f32x4v*)(GA + t * 16 + 4 * q); x += g4[0] * wg[4 * q] + g4[1] * wg[4 * q + 1] + g4[2] * wg[4 * q + 2] + g4[3] * wg[4 * q + 3]; }
          const float ls = fminf(x, 0.f) - __logf(1.f + __expf(-fabsf(x)));
          run += ls * (1.f / 16.f); cs[i] = run; }
      SEG[seg * 64 + dk] = run; }
    VMW(13);
    LBAR();
    if (n == 2) STAMP3(2);
    { float off = 0.f, tot = 0.f;
#pragma unroll
      for (int s = 0; s < 8; ++s) { const float v = SEG[s * 64 + dk]; tot += v; if (s < seg) off += v; }
      unsigned kend[4];
#pragma unroll
      for (int i = 0; i < 8; ++i) { const int t = seg * 8 + i; const float bb = off + cs[i];
          const float q = bf2f(RQ[t * 64 + dk]), k = bf2f(RK[t * 64 + dk]);
          QE[t * 72 + dk] = (bf16)f2bf(q * 0.125f * __expf(bb)); KE[t * 72 + dk] = (bf16)f2bf(k * __expf(-bb));
          const unsigned ke = f2bf(k * __expf(tot - bb)); if (i & 1) kend[i >> 1] |= ke << 16; else kend[i >> 1] = ke; }
      v4u kw; kw.x = kend[0]; kw.y = kend[1]; kw.z = kend[2]; kw.w = kend[3];
      *(LAS v4u*)(KENDT + dk * 72 + seg * 8) = kw;
      if (seg == 0) DD[dk] = __expf(tot); }
    LBAR();
    gla_issue_qk(A, lds, b, h, nn);
    if (n == 2) STAMP3(3);
    if (wave < 3) { const int tp = (wave == 2) ? 1 : 0, mt = (wave == 0) ? 0 : 1;
        f32x16 acc = zero16(); bf16x8 fa[4], fb[4];
#pragma unroll
        for (int s = 0; s < 4; ++s) { fa[s] = lds_frag(KE + (32 * tp + r) * 72, 16 * s, hh); fb[s] = lds_frag(QE + (32 * mt + r) * 72, 16 * s, hh); }
        SB0();
#pragma unroll
        for (int s = 0; s < 4; ++s) acc = MFMA32(fa[s], fb[s], acc);
        SB0();
        const int t = 32 * mt + r;
#pragma unroll
        for (int q = 0; q < 4; ++q) { const int tq = 32 * tp + 8 * q + 4 * hh; float v[4];
#pragma unroll
            for (int e = 0; e < 4; ++e) v[e] = (tq + e <= t) ? acc[4 * q + e] : 0.f;
            v2u w; w.x = pg8::cvt_pk_bf16(v[0], v[1]); w.y = pg8::cvt_pk_bf16(v[2], v[3]); *(LAS v2u*)(ATT + t * 72 + tq) = w; } }
    LBAR();
    if (n == 2) STAMP3(4);
    if (wave < 4) {
        const LAS bf16* vrow = VT + (32 * wave + r) * 72;
        bf16x8 vb[4], fa[6], fb[4];
#pragma unroll
        for (int s = 0; s < 4; ++s) vb[s] = lds_frag(vrow, 16 * s, hh);
        fa[0] = lds_frag(ATT + r * 72, 0, hh); fa[1] = lds_frag(ATT + r * 72, 16, hh);
#pragma unroll
        for (int s = 0; s < 4; ++s) fa[2 + s] = lds_frag(ATT + (32 + r) * 72, 16 * s, hh);
#pragma unroll
        for (int s = 0; s < 4; ++s) fb[s] = lds_frag_perm(QE + r * 72, s, hh);
        SB0();
        f32x16 O0 = zero16(), O1 = zero16();
        O0 = MFMA32(fa[0], vb[0], O0); O0 = MFMA32(fa[1], vb[1], O0);
#pragma unroll
        for (int s = 0; s < 4; ++s) O1 = MFMA32(fa[2 + s], vb[s], O1);
        SB0();
#pragma unroll
        for (int s = 0; s < 4; ++s) fa[s] = lds_frag_perm(QE + (32 + r) * 72, s, hh);
        SB0();
#pragma unroll
        for (int s = 0; s < 4; ++s) O0 = MFMA32(fb[s], st.Sb[s], O0);
        SB0();
#pragma unroll
        for (int s = 0; s < 4; ++s) fb[s] = lds_frag(KENDT + r * 72, 16 * s, hh);
        SB0();
#pragma unroll
        for (int s = 0; s < 4; ++s) O1 = MFMA32(fa[s], st.Sb[s], O1);
#pragma unroll
        for (int g2 = 0; g2 < 16; ++g2) st.S[0][g2] *= DD[c32row(lane, g2)];
        SB0();
#pragma unroll
        for (int s = 0; s < 4; ++s) fa[s] = lds_frag(KENDT + (32 + r) * 72, 16 * s, hh);
        SB0();
#pragma unroll
        for (int s = 0; s < 4; ++s) st.S[0] = MFMA32(fb[s], vb[s], st.S[0]);
#pragma unroll
        for (int g2 = 0; g2 < 16; ++g2) st.S[1][g2] *= DD[32 + c32row(lane, g2)];
#pragma unroll
        for (int g2 = 0; g2 < 16; ++g2) OBUF[c32row(lane, g2) * 132 + 32 * wave + r] = O0[g2];
        SB0();
#pragma unroll
        for (int s = 0; s < 4; ++s) st.S[1] = MFMA32(fa[s], vb[s], st.S[1]);
#pragma unroll
        for (int g2 = 0; g2 < 16; ++g2) OBUF[(32 + c32row(lane, g2)) * 132 + 32 * wave + r] = O1[g2];
        st.Sb[0] = acc_frag(st.S[0], 0); st.Sb[1] = acc_frag(st.S[0], 1);
        SB0();
        st.Sb[2] = acc_frag(st.S[1], 0); st.Sb[3] = acc_frag(st.S[1], 1);
    }
    VMW(5);
    LBAR();
    if (n == 2) STAMP3(5);
    { bf16* OA = (bf16*)(A.ws + WS_OA);
#pragma unroll
      for (int i = 0; i < 8; ++i) { const int t = wave * 8 + i; const size_t m = m0 + t;
          const float o0 = OBUF[t * 132 + 2 * lane], o1 = OBUF[t * 132 + 2 * lane + 1];
          const unsigned zw = *(const LAS unsigned*)(RZ + t * 128 + 2 * lane);
          const float rr = rsqf_(wsum(o0 * o0 + o1 * o1) * (1.f / 128.f) + NORM_EPS);
          *(GAS unsigned*)(OA + m * 512 + h * 128 + 2 * lane) = pk2(o0 * rr * nw0 * siluf_(bflo(zw)), o1 * rr * nw1 * siluf_(bfhi(zw))); } }
    LBAR();
    gla_issue_z(A, lds, b, h, nn);
    VMW(12);
    LBAR();
    if (n == 2) STAMP3(6);
}
__device__ __forceinline__ void gla_final(const Args& A, int c, const GlaState& st) {
    const int tid = threadIdx.x, lane = tid & 63, wave = tid >> 6, r = lane & 31;
    if (wave < 4) { float* So = A.out + OUT_GLA_P + (size_t)c * 64 * 128;
#pragma unroll
        for (int mk = 0; mk < 2; ++mk)
#pragma unroll
            for (int g = 0; g < 16; ++g) So[(size_t)(32 * mk + c32row(lane, g)) * 128 + 32 * wave + r] = st.S[mk][g]; }
}
constexpr size_t REC_BYTES = 73728; constexpr int REC_W = 0, REC_QE = 16384, REC_QK = 32768, REC_KT = 40960, REC_U = 57344, REC_LDS = 57344;
constexpr int R1_KN = 0, R1_QN = 17408, R1_KNT = 34816, R1_VT = 53248, R1_AM = 71680, R1_ANEG = 89088, R1_DINV = 98304, R1_TB = 101376, R1_TBD = 110592, R1_TAB = 119808, R1_CW = R1_TAB + 1024, R1_END = R1_CW + 4 * 4 * 384 * 4;
static_assert(R1_END <= LDS_BYTES - 512, "R1 LDS");
struct R1Pre { unsigned raw[11][3]; unsigned short ab, bb; };
__device__ __forceinline__ void r1_touch(const R1Pre& p) {
#pragma unroll
    for (int rr = 0; rr < 11; ++rr) asm volatile("" :: "v"(p.raw[rr][0]), "v"(p.raw[rr][1]), "v"(p.raw[rr][2]));
    asm volatile("" :: "v"(p.ab), "v"(p.bb));
}
__device__ __forceinline__ float wscan(float v, int lane) {
    v += dpp_f<0x111>(v); v += dpp_f<0x112>(v); v += dpp_f<0x114>(v); v += dpp_f<0x118>(v);
    const float t0 = rl_f(v, 15), t1 = rl_f(v, 31), t2 = rl_f(v, 47); const int row = lane >> 4;
    return v + (row > 0 ? t0 : 0.f) + (row > 1 ? t1 : 0.f) + (row > 2 ? t2 : 0.f);
}
__device__ __forceinline__ void r1_prefetch(const Args& A, int u, R1Pre& p) {
    const int tid = threadIdx.x, lane = tid & 63, wave = tid >> 6;
    const int bh = u >> 5, n = u & 31, b = bh >> 2, h = bh & 3; const unsigned char* ws = A.ws;
    const bf16* SPEC = (const bf16*)(ws + WS_SPEC); const size_t m = (size_t)b * SEQ + (size_t)n * 64 + lane;
    p.ab = SPEC[m * 32 + 16 + h]; p.bb = SPEC[m * 32 + 20 + h];
    const int t0 = wave * 8;
#pragma unroll
    for (int rr = 0; rr < 11; ++rr) { const int t = n * 64 + t0 - 3 + rr;
#pragma unroll
        for (int sg = 0; sg < 3; ++sg) { unsigned w = 0u;
            if (t >= 0) w = *(const GAS unsigned*)(panel(ws, PN_QB + 2 * sg + (h >> 1)) + ((size_t)b * SEQ + t) * 256 + (h & 1) * 128 + 2 * lane);
            p.raw[rr][sg] = w; } }
}
__device__ __forceinline__ void r1_stage_cw(const Args& A, LAS unsigned char* lds) {
    LAS float* CW = (LAS float*)(lds + R1_CW);
    for (int i = threadIdx.x; i < 4 * 4 * 384; i += NTHREADS) { const int cc = i & 127, sg = (i >> 7) % 3, j = (i / 384) & 3, h = i / 1536; CW[i] = A.in[12][j * 1536 + sg * 512 + h * 128 + cc]; }
    LBAR();
}
__device__ __forceinline__ void st_frag(unsigned char* g, int frag, int lane, const v4u w) { *(GAS v4u*)(g + (size_t)frag * 1024 + lane * 16) = w; }

__device__ __forceinline__ void gdn_r1_unit(const Args& A, LAS unsigned char* lds, int u, R1Pre& cur, int un, const float (&negA4)[4], const float (&dtb4)[4]) {
    const int tid = threadIdx.x, lane = tid & 63, wave = __builtin_amdgcn_readfirstlane(tid >> 6), r = lane & 31, hh = lane >> 5;
    const int bh = u >> 5, n = u & 31, b = bh >> 2, h = bh & 3;
    const unsigned char* ws = A.ws;
    unsigned char* rec = A.ws + WS_REC + (size_t)u * REC_BYTES;
    const size_t m0 = (size_t)b * SEQ + (size_t)n * 64;
    LAS bf16* KN = (LAS bf16*)(lds + R1_KN); LAS bf16* QN = (LAS bf16*)(lds + R1_QN); LAS bf16* KNT = (LAS bf16*)(lds + R1_KNT); LAS bf16* VT = (LAS bf16*)(lds + R1_VT);
    LAS float* AM = (LAS float*)(lds + R1_AM); LAS bf16* ANEG = (LAS bf16*)(lds + R1_ANEG); LAS bf16* DINV = (LAS bf16*)(lds + R1_DINV);
    LAS bf16* TB = (LAS bf16*)(lds + R1_TB); LAS bf16* TBD = (LAS bf16*)(lds + R1_TBD);
    LAS float* DEC = (LAS float*)(lds + R1_TAB); LAS float* BETA = DEC + 64; LAS float* EDEC = DEC + 128; LAS float* EEND = DEC + 192;
    const bf16* SPEC = (const bf16*)(ws + WS_SPEC);
    const bool stp = (u < 224);
    if (stp) STAMP3(0);
    { const float gg = negA4[h] * softplusf_(bf2f(cur.ab) + dtb4[h]);
      const float d = wscan(gg, lane);
      const float dl = rl_f(d, 63);
      if (wave == 0) { DEC[lane] = d; BETA[lane] = sigmoidf_(bf2f(cur.bb)); EDEC[lane] = __expf(d); EEND[lane] = __expf(dl - d);
          if (lane == 0) ((float*)(A.ws + WS_CDEC))[u] = __expf(dl); } }
    { const int t0 = wave * 8;
      const LAS float* CW = (const LAS float*)(lds + R1_CW) + h * 1536;
      float cw[4][3][2];
#pragma unroll
      for (int j = 0; j < 4; ++j)
#pragma unroll
          for (int sg = 0; sg < 3; ++sg) { const f32x2v c2 = *(const LAS f32x2v*)(CW + (j * 3 + sg) * 128 + 2 * lane); cw[j][sg][0] = c2[0]; cw[j][sg][1] = c2[1]; }
#define RAWV(rr, sg, e) ((e) ? bfhi(cur.raw[rr][sg]) : bflo(cur.raw[rr][sg]))
      unsigned kt0[4], kt1[4], vt0[4], vt1[4];
#pragma unroll
      for (int i = 0; i < 8; ++i) { float o[3][2];
#pragma unroll
          for (int sg = 0; sg < 3; ++sg)
#pragma unroll
              for (int e = 0; e < 2; ++e) o[sg][e] = siluf_(cw[0][sg][e] * RAWV(i, sg, e) + cw[1][sg][e] * RAWV(i + 1, sg, e) + cw[2][sg][e] * RAWV(i + 2, sg, e) + cw[3][sg][e] * RAWV(i + 3, sg, e));
          const float rq = 0.08838834764831845f * rsqf_(wsum(o[0][0] * o[0][0] + o[0][1] * o[0][1]) + NORM_EPS);
          const float rk = rsqf_(wsum(o[1][0] * o[1][0] + o[1][1] * o[1][1]) + NORM_EPS);
          const unsigned qw = pk2(o[0][0] * rq, o[0][1] * rq), kw = pk2(o[1][0] * rk, o[1][1] * rk), vw = pk2(o[2][0], o[2][1]);
          *(LAS unsigned*)(QN + (t0 + i) * 136 + 2 * lane) = qw; *(LAS unsigned*)(KN + (t0 + i) * 136 + 2 * lane) = kw;
          if (i & 1) { kt0[i >> 1] |= kw << 16; kt1[i >> 1] |= kw & 0xffff0000u; vt0[i >> 1] |= vw << 16; vt1[i >> 1] |= vw & 0xffff0000u; }
          else { kt0[i >> 1] = kw & 0xffffu; kt1[i >> 1] = kw >> 16; vt0[i >> 1] = vw & 0xffffu; vt1[i >> 1] = vw >> 16; } }
      v4u x; x.x = kt0[0]; x.y = kt0[1]; x.z = kt0[2]; x.w = kt0[3]; *(LAS v4u*)(KNT + (2 * lane) * 72 + t0) = x;
      x.x = kt1[0]; x.y = kt1[1]; x.z = kt1[2]; x.w = kt1[3]; *(LAS v4u*)(KNT + (2 * lane + 1) * 72 + t0) = x;
      x.x = vt0[0]; x.y = vt0[1]; x.z = vt0[2]; x.w = vt0[3]; *(LAS v4u*)(VT + (2 * lane) * 72 + t0) = x;
      x.x = vt1[0]; x.y = vt1[1]; x.z = vt1[2]; x.w = vt1[3]; *(LAS v4u*)(VT + (2 * lane + 1) * 72 + t0) = x; }
    if (un < 1024) r1_prefetch(A, un, cur);
    LBAR();
    if (stp) STAMP3(1);
    if (wave < 3) { const int tp = (wave == 2) ? 1 : 0, mt = (wave == 0) ? 0 : 1;
        f32x16 kk = zero16(), qk = zero16();
#pragma unroll
        for (int hf = 0; hf < 2; ++hf) { bf16x8 fa[4], fk[4], fq[4];
#pragma unroll
            for (int s = 0; s < 4; ++s) { const int k0 = 16 * (4 * hf + s); fa[s] = lds_frag(KN + (32 * tp + r) * 136, k0, hh); fk[s] = lds_frag(KN + (32 * mt + r) * 136, k0, hh); fq[s] = lds_frag(QN + (32 * mt + r) * 136, k0, hh); }
            SB0();
#pragma unroll
            for (int s = 0; s < 4; ++s) { kk = MFMA32(fa[s], fk[s], kk); qk = MFMA32(fa[s], fq[s], qk); }
            SB0(); }
        const int t = 32 * mt + r; const float dect = DEC[t], bet = BETA[t];
#pragma unroll
        for (int q = 0; q < 4; ++q) { const int tq = 32 * tp + 8 * q + 4 * hh; float av[4], qv[4];
#pragma unroll
            for (int e = 0; e < 4; ++e) { const int tpp = tq + e; const float gam = (tpp <= t) ? __expf(dect - DEC[tpp]) : 0.f;
                av[e] = (tpp < t) ? bet * kk[4 * q + e] * gam : 0.f; qv[e] = qk[4 * q + e] * gam; qk[4 * q + e] = qv[e]; }
            *(LAS f32x4v*)(AM + t * 68 + tq) = (f32x4v){av[0], av[1], av[2], av[3]};
            v2u w; w.x = pg8::cvt_pk_bf16(-av[0], -av[1]); w.y = pg8::cvt_pk_bf16(-av[2], -av[3]); *(LAS v2u*)(ANEG + t * 72 + tq) = w; }
        st_frag(rec + REC_QK, mt * 4 + 2 * tp + 0, lane, __builtin_bit_cast(v4u, acc_frag(qk, 0)));
        st_frag(rec + REC_QK, mt * 4 + 2 * tp + 1, lane, __builtin_bit_cast(v4u, acc_frag(qk, 1)));
    } else {
        for (int f = wave - 3; f < 32; f += 5) {
            if (f < 16) { const int mt = f >> 3, s = f & 7, t = 32 * mt + r; const float e = EDEC[t];
                const LAS bf16* rp = QN + t * 136; const v2u a = *(const LAS v2u*)(rp + 16 * s + 4 * hh), c = *(const LAS v2u*)(rp + 16 * s + 8 + 4 * hh);
                v4u w; w.x = pk2(bflo(a.x) * e, bfhi(a.x) * e); w.y = pk2(bflo(a.y) * e, bfhi(a.y) * e); w.z = pk2(bflo(c.x) * e, bfhi(c.x) * e); w.w = pk2(bflo(c.y) * e, bfhi(c.y) * e);
                st_frag(rec + REC_QE, f, lane, w); }
            else { const int g = f - 16, mk = g >> 2, sp = g & 3; const LAS bf16* rp = KNT + (32 * mk + r) * 72; const int ta = 16 * sp + 4 * hh, tb = ta + 8;
                const v2u a = *(const LAS v2u*)(rp + ta), c = *(const LAS v2u*)(rp + tb);
                v4u w; w.x = pk2(bflo(a.x) * EEND[ta], bfhi(a.x) * EEND[ta + 1]); w.y = pk2(bflo(a.y) * EEND[ta + 2], bfhi(a.y) * EEND[ta + 3]);
                w.z = pk2(bflo(c.x) * EEND[tb], bfhi(c.x) * EEND[tb + 1]); w.w = pk2(bflo(c.y) * EEND[tb + 2], bfhi(c.y) * EEND[tb + 3]);
                st_frag(rec + REC_KT, g, lane, w); }
        }
    }
    LBAR();
    if (stp) STAMP3(2);
    if (wave == 0) { const int I = lane >> 4, c = lane & 15; float x[16];
#pragma unroll
        for (int i = 0; i < 16; ++i) { float acc = (i == c) ? 1.f : 0.f; const LAS float* nr = AM + (16 * I + i) * 68 + 16 * I;
#pragma unroll
            for (int j = 0; j < i; ++j) acc -= nr[j] * x[j];
            x[i] = acc; DINV[(I * 16 + i) * 24 + c] = (bf16)f2bf(acc); } }
    LBAR();
    if (stp) STAMP3(3);
    if (wave < 4) { const int Jc = wave, c = lane & 15, g = lane >> 4; f32x4v X[4];
#pragma unroll
        for (int I = 0; I < 4; ++I) { X[I] = (f32x4v){0.f, 0.f, 0.f, 0.f};
            if (I >= Jc) { f32x4v R;
#pragma unroll
                for (int e = 0; e < 4; ++e) R[e] = (I == Jc && 4 * g + e == c) ? 1.f : 0.f;
#pragma unroll
                for (int p = 0; p < 2; ++p) { const int J0 = 2 * p, J1 = 2 * p + 1; if (J0 < I) {
                    const LAS bf16* ar = ANEG + (16 * I + c) * 72;
                    const v2u a0 = *(const LAS v2u*)(ar + 16 * J0 + 4 * g); v2u a1; a1.x = 0u; a1.y = 0u; if (J1 < I) a1 = *(const LAS v2u*)(ar + 16 * J1 + 4 * g);
                    v4u aw; aw.x = a0.x; aw.y = a0.y; aw.z = a1.x; aw.w = a1.y;
                    v4u bw; bw.x = pg8::cvt_pk_bf16(X[J0][0], X[J0][1]); bw.y = pg8::cvt_pk_bf16(X[J0][2], X[J0][3]); bw.z = 0u; bw.w = 0u;
                    if (J1 < I) { bw.z = pg8::cvt_pk_bf16(X[J1][0], X[J1][1]); bw.w = pg8::cvt_pk_bf16(X[J1][2], X[J1][3]); }
                    R = MFMA16(__builtin_bit_cast(bf16x8, aw), __builtin_bit_cast(bf16x8, bw), R); } }
                const v2u d0 = *(const LAS v2u*)(DINV + (I * 16 + c) * 24 + 4 * g);
                v4u aw; aw.x = d0.x; aw.y = d0.y; aw.z = 0u; aw.w = 0u;
                v4u bw; bw.x = pg8::cvt_pk_bf16(R[0], R[1]); bw.y = pg8::cvt_pk_bf16(R[2], R[3]); bw.z = 0u; bw.w = 0u;
                const f32x4v z4 = {0.f, 0.f, 0.f, 0.f}; X[I] = MFMA16(__builtin_bit_cast(bf16x8, aw), __builtin_bit_cast(bf16x8, bw), z4); } }
        const int cc = 16 * Jc + c; const float bet = BETA[cc], bed = bet * EDEC[cc];
#pragma unroll
        for (int I = 0; I < 4; ++I)
#pragma unroll
            for (int e = 0; e < 4; ++e) { const int t = 16 * I + 4 * g + e; TB[t * 72 + cc] = (bf16)f2bf(X[I][e] * bet); TBD[t * 72 + cc] = (bf16)f2bf(X[I][e] * bed); } }
    LBAR();
    if (stp) STAMP3(4);
    { const int mt = wave & 1, cb = wave >> 1; const int ns = mt ? 4 : 2;
      f32x16 ua = zero16(), wa = zero16();
      bf16x8 f0[4], f1[4], f2[4], f3[4];
#pragma unroll
      for (int s = 0; s < 4; ++s) if (s < ns) { f0[s] = lds_frag(TB + (32 * mt + r) * 72, 16 * s, hh); f1[s] = lds_frag(VT + (32 * cb + r) * 72, 16 * s, hh);
          f2[s] = lds_frag(KNT + (32 * cb + r) * 72, 16 * s, hh); f3[s] = lds_frag(TBD + (32 * mt + r) * 72, 16 * s, hh); }
      SB0();
#pragma unroll
      for (int s = 0; s < 4; ++s) if (s < ns) { ua = MFMA32(f0[s], f1[s], ua); wa = MFMA32(f2[s], f3[s], wa); }
      SB0();
      r1_touch(cur);
      { v4u lo = __builtin_bit_cast(v4u, acc_frag(ua, 0)), hi = __builtin_bit_cast(v4u, acc_frag(ua, 1));
        unsigned char* up = rec + REC_U + (size_t)((cb * 2 + mt) * 64 + lane) * 32; *(GAS v4u*)up = lo; *(GAS v4u*)(up + 16) = hi; }
#pragma unroll
      for (int g = 0; g < 16; ++g) wa[g] = -wa[g];
      st_frag(rec + REC_W, mt * 8 + 2 * cb + 0, lane, __builtin_bit_cast(v4u, acc_frag(wa, 0)));
      st_frag(rec + REC_W, mt * 8 + 2 * cb + 1, lane, __builtin_bit_cast(v4u, acc_frag(wa, 1))); }
    LBAR();
    if (stp) STAMP3(5);
}

constexpr int R2_BUF0 = 0, R2_BUF1 = REC_LDS, R2_OBUF = 2 * REC_LDS, R2_END = R2_OBUF + 64 * 136 * 2;
static_assert(R2_END <= LDS_BYTES - 512, "R2 LDS");
#define RAW_BAR() do { asm volatile("" ::: "memory"); __builtin_amdgcn_s_barrier(); asm volatile("" ::: "memory"); } while (0)
__device__ __forceinline__ void gdn_r2_item(const Args& A, LAS unsigned char* lds, int bh) {
    const int tid = threadIdx.x, lane = tid & 63, wave = __builtin_amdgcn_readfirstlane(tid >> 6), r = lane & 31, hh = lane >> 5;
    const int b = bh >> 2, h = bh & 3;
    const unsigned char* recs = A.ws + WS_REC + (size_t)bh * 32 * REC_BYTES;
    const float* CDEC = (const float*)(A.ws + WS_CDEC) + bh * 32;
    LAS bf16* OBUF = (LAS bf16*)(lds + R2_OBUF);
    if (wave >= 4) { const int wl = wave - 4;
        for (int p = wl; p < 56; p += 4) __builtin_amdgcn_global_load_lds((const unsigned*)(recs + (size_t)p * 1024 + lane * 16), (LAS unsigned*)(lds + R2_BUF0 + p * 1024), 16, 0, 0);
        asm volatile("s_waitcnt vmcnt(0)" ::: "memory"); }
    RAW_BAR();
    if (wave < 4) {
        f32x16 S[4]; bf16x8 Sb[8];
#pragma unroll
        for (int i = 0; i < 4; ++i) S[i] = zero16();
#pragma unroll
        for (int i = 0; i < 8; ++i) Sb[i] = (bf16x8){0, 0, 0, 0, 0, 0, 0, 0};
        v4u un[2][2]; float cdn = CDEC[0];
#pragma unroll
        for (int mt = 0; mt < 2; ++mt) { const unsigned char* up = recs + REC_U + (size_t)((wave * 2 + mt) * 64 + lane) * 32; un[mt][0] = *(const GAS v4u*)up; un[mt][1] = *(const GAS v4u*)(up + 16); }
#define SB0() __builtin_amdgcn_sched_barrier(0)
#define FRG(off, idx) (*(const LAS bf16x8*)(buf + (off) + (idx) * 1024 + lane * 16))
        for (int n = 0; n < 32; ++n) {
            if (tid == 0) __hip_atomic_store((unsigned*)(A.ws + WS_CTL) + 12288 + 64 * bh, (unsigned)n, __ATOMIC_RELAXED, __HIP_MEMORY_SCOPE_AGENT);
            const LAS unsigned char* buf = lds + ((n & 1) ? R2_BUF1 : R2_BUF0);
            const float cdec = cdn;
            bf16x8 fa[8], fb[8];
#pragma unroll
            for (int s = 0; s < 8; ++s) fa[s] = FRG(REC_W, s);
#pragma unroll
            for (int s = 0; s < 8; ++s) fb[s] = FRG(REC_W, 8 + s);
            f32x16 V[2];
#pragma unroll
            for (int mt = 0; mt < 2; ++mt) { const v4u lo = un[mt][0], hi = un[mt][1];
                V[mt][0] = bflo(lo.x); V[mt][1] = bfhi(lo.x); V[mt][2] = bflo(lo.y); V[mt][3] = bfhi(lo.y); V[mt][4] = bflo(lo.z); V[mt][5] = bfhi(lo.z); V[mt][6] = bflo(lo.w); V[mt][7] = bfhi(lo.w);
                V[mt][8] = bflo(hi.x); V[mt][9] = bfhi(hi.x); V[mt][10] = bflo(hi.y); V[mt][11] = bfhi(hi.y); V[mt][12] = bflo(hi.z); V[mt][13] = bfhi(hi.z); V[mt][14] = bflo(hi.w); V[mt][15] = bfhi(hi.w); }
            if (n + 1 < 32) { cdn = CDEC[n + 1];
#pragma unroll
                for (int mt = 0; mt < 2; ++mt) { const unsigned char* up = recs + (size_t)(n + 1) * REC_BYTES + REC_U + (size_t)((wave * 2 + mt) * 64 + lane) * 32; un[mt][0] = *(const GAS v4u*)up; un[mt][1] = *(const GAS v4u*)(up + 16); } }
            SB0();
#pragma unroll
            for (int s = 0; s < 8; ++s) V[0] = MFMA32(fa[s], Sb[s], V[0]);
            SB0();
#pragma unroll
            for (int s = 0; s < 8; ++s) fa[s] = FRG(REC_QE, s);
            SB0();
#pragma unroll
            for (int s = 0; s < 8; ++s) V[1] = MFMA32(fb[s], Sb[s], V[1]);
            SB0();
#pragma unroll
            for (int s = 0; s < 8; ++s) fb[s] = FRG(REC_QE, 8 + s);
            bf16x8 Vb[4]; Vb[0] = acc_frag(V[0], 0); Vb[1] = acc_frag(V[0], 1);
            SB0();
            f32x16 O0 = zero16(), O1 = zero16();
#pragma unroll
            for (int s = 0; s < 8; ++s) O0 = MFMA32(fa[s], Sb[s], O0);
            Vb[2] = acc_frag(V[1], 0); Vb[3] = acc_frag(V[1], 1);
            SB0();
            fa[0] = FRG(REC_QK, 0); fa[1] = FRG(REC_QK, 1); fa[2] = FRG(REC_QK, 4); fa[3] = FRG(REC_QK, 5); fa[4] = FRG(REC_QK, 6); fa[5] = FRG(REC_QK, 7);
            SB0();
#pragma unroll
            for (int s = 0; s < 8; ++s) O1 = MFMA32(fb[s], Sb[s], O1);
            SB0();
#pragma unroll
            for (int s = 0; s < 8; ++s) fb[s] = FRG(REC_KT, s);
            SB0();
            O0 = MFMA32(fa[0], Vb[0], O0); O0 = MFMA32(fa[1], Vb[1], O0);
#pragma unroll
            for (int s = 0; s < 4; ++s) O1 = MFMA32(fa[2 + s], Vb[s], O1);
#pragma unroll
            for (int g = 0; g < 16; ++g) { S[0][g] *= cdec; S[1][g] *= cdec; }
            SB0();
#pragma unroll
            for (int s = 0; s < 8; ++s) fa[s] = FRG(REC_KT, 8 + s);
            asm volatile("s_waitcnt lgkmcnt(0)" ::: "memory");
            RAW_BAR();
            SB0();
#pragma unroll
            for (int s = 0; s < 4; ++s) { S[0] = MFMA32(fb[s], Vb[s], S[0]); S[1] = MFMA32(fb[4 + s], Vb[s], S[1]); }
#pragma unroll
            for (int g = 0; g < 16; ++g) { OBUF[c32row(lane, g) * 136 + 32 * wave + r] = (bf16)f2bf(O0[g]); OBUF[(32 + c32row(lane, g)) * 136 + 32 * wave + r] = (bf16)f2bf(O1[g]); }
#pragma unroll
            for (int g = 0; g < 16; ++g) { S[2][g] *= cdec; S[3][g] *= cdec; }
            SB0();
#pragma unroll
            for (int s = 0; s < 4; ++s) { S[2] = MFMA32(fa[s], Vb[s], S[2]); S[3] = MFMA32(fa[4 + s], Vb[s], S[3]); }
            Sb[0] = acc_frag(S[0], 0); Sb[1] = acc_frag(S[0], 1); Sb[2] = acc_frag(S[1], 0); Sb[3] = acc_frag(S[1], 1);
            SB0();
            Sb[4] = acc_frag(S[2], 0); Sb[5] = acc_frag(S[2], 1); Sb[6] = acc_frag(S[3], 0); Sb[7] = acc_frag(S[3], 1);
            asm volatile("s_waitcnt lgkmcnt(0)" ::: "memory");
            RAW_BAR();
        }
        RAW_BAR();
        float* So = A.out + OUT_GDN_P + (size_t)bh * 128 * 128;
#pragma unroll
        for (int mk = 0; mk < 4; ++mk)
#pragma unroll
            for (int g = 0; g < 16; ++g) So[(size_t)(32 * mk + c32row(lane, g)) * 128 + 32 * wave + r] = S[mk][g];
    } else {
        const int wl = wave - 4, lt = tid - 256, t = lt >> 2, qd = lt & 3;
        const bf16* PZ = panel(A.ws, PN_ZB + (h >> 1)); bf16* OB = (bf16*)(A.ws + WS_OB);
        f32x4 nw[8];
#pragma unroll
        for (int i = 0; i < 8; ++i) nw[i] = *(const GAS f32x4*)(A.in[15] + 32 * qd + 4 * i);
        v4u zc[4], zn[4];
        { const size_t m = (size_t)b * SEQ + t;
#pragma unroll
          for (int i = 0; i < 4; ++i) zc[i] = *(const GAS v4u*)(PZ + m * 256 + (h & 1) * 128 + 32 * qd + 8 * i); }
        for (int n = 0; n <= 32; ++n) {
            if (n + 1 < 32) { const unsigned char* src = recs + (size_t)(n + 1) * REC_BYTES; LAS unsigned char* dst = lds + (((n + 1) & 1) ? R2_BUF1 : R2_BUF0);
                for (int p = wl; p < 56; p += 4) __builtin_amdgcn_global_load_lds((const unsigned*)(src + (size_t)p * 1024 + lane * 16), (LAS unsigned*)(dst + p * 1024), 16, 0, 0); }
            if (n >= 1) { const size_t m = (size_t)b * SEQ + (size_t)(n - 1) * 64 + t;
                float ss = 0.f; f32x4 ov[8];
#pragma unroll
                for (int i = 0; i < 4; ++i) unpack8(*(const LAS v4u*)(OBUF + t * 136 + 32 * qd + 8 * i), ov[2 * i], ov[2 * i + 1]);
#pragma unroll
                for (int i = 0; i < 8; ++i) ss += (ov[i].x * ov[i].x + ov[i].y * ov[i].y) + (ov[i].z * ov[i].z + ov[i].w * ov[i].w);
                asm volatile("s_waitcnt lgkmcnt(0)" ::: "memory");
                RAW_BAR();
                ss = quad_sum(ss);
                const float rr = rsqf_(ss * (1.f / 128.f) + NORM_EPS);
                v4u ow[4];
#pragma unroll
                for (int i = 0; i < 4; ++i) { f32x4 z0, z1; unpack8(zc[i], z0, z1);
                    f32x4 a = ov[2 * i] * rr * nw[2 * i], c = ov[2 * i + 1] * rr * nw[2 * i + 1];
                    a.x *= siluf_(z0.x); a.y *= siluf_(z0.y); a.z *= siluf_(z0.z); a.w *= siluf_(z0.w); c.x *= siluf_(z1.x); c.y *= siluf_(z1.y); c.z *= siluf_(z1.z); c.w *= siluf_(z1.w);
                    ow[i] = pack8(a, c); }
#pragma unroll
                for (int i = 0; i < 4; ++i) zc[i] = zn[i];
                asm volatile("" :: "v"(zc[0].x), "v"(zc[1].x), "v"(zc[2].x), "v"(zc[3].x), "v"(zc[0].w), "v"(zc[1].w), "v"(zc[2].w), "v"(zc[3].w));
#pragma unroll
                for (int i = 0; i < 4; ++i) *(GAS v4u*)(OB + m * 512 + h * 128 + 32 * qd + 8 * i) = ow[i];
            } else { RAW_BAR(); }
            if (n + 1 < 32) { const size_t m = (size_t)b * SEQ + (size_t)(n + 1) * 64 + t;
#pragma unroll
                for (int i = 0; i < 4; ++i) zn[i] = *(const GAS v4u*)(PZ + m * 256 + (h & 1) * 128 + 32 * qd + 8 * i); }
            if (n < 32) { asm volatile("s_waitcnt vmcnt(8)" ::: "memory"); RAW_BAR(); }
        }
    }
}
typedef pg8::f32x4 (&AccRef)[2][2][4][2];
typedef const pg8::f32x4 (&CAccRef)[2][2][4][2];

#define EPI_LOOP_BEGIN  const int row0 = u.pm * 256 + wr * 64 + fr, cin = wc * 32 + 8 * fq; \
    _Pragma("unroll") for (int ai = 0; ai < 2; ++ai) _Pragma("unroll") for (int m = 0; m < 4; ++m) { const size_t row = (size_t)(row0 + ai * 128 + m * 16); \
    _Pragma("unroll") for (int bj = 0; bj < 2; ++bj) { const int cp = bj * 128 + cin;   const f32x4 a0 = acc[ai][bj][m][0], a1 = acc[ai][bj][m][1];
#define EPI_LOOP_END } }

__device__ __forceinline__ bf16* panel_rw(unsigned char* ws, float* out, int pn) { return (pn < 14) ? (bf16*)(ws + WS_PROJ + (size_t)pn * SZ_PANEL) : (bf16*)((unsigned char*)out + (size_t)(pn - 14) * SZ_PANEL); }
struct EpiProj { static constexpr bool PERM = true; unsigned char* ws; float* out;
    __device__ __forceinline__ void operator()(CAccRef acc, const pg8::Unit& u, int wr, int wc, int fr, int fq) const {
        if (u.pn < PN_SPEC) { bf16* P = panel_rw(ws, out, u.pn);
            EPI_LOOP_BEGIN *(GAS v4u*)(P + row * 256 + cp) = pack8(a0, a1); EPI_LOOP_END }
        else { bf16* P = (bf16*)(ws + WS_SPEC);
            EPI_LOOP_BEGIN if (cp < 32) *(GAS v4u*)(P + row * 32 + cp) = pack8(a0, a1); EPI_LOOP_END }
    } };
#define EPI_POS(p) const int m = (p) >> 1, bj = (p) & 1; const size_t row = (size_t)(row0 + ai * 128 + m * 16); const int cp = bj * 128 + cin; const f32x4 a0 = acc[ai][bj][m][0], a1 = acc[ai][bj][m][1];
struct EpiUpA { static constexpr bool PERM = true; unsigned char* ws; float* out; bf16* O;
    __device__ __forceinline__ void operator()(CAccRef acc, const pg8::Unit& u, int wr, int wc, int fr, int fq) const {
        const bf16* Gp = panel_rw(ws, out, PN_GA + u.pn);
        const int row0 = u.pm * 256 + wr * 64 + fr, cin = wc * 32 + 8 * fq;
#pragma unroll
        for (int ai = 0; ai < 2; ++ai) { v4u gw[8];
#pragma unroll
            for (int p = 0; p < 8; ++p) { EPI_POS(p) (void)a0; (void)a1; gw[p] = *(const GAS v4u*)(Gp + row * 256 + cp); }
#pragma unroll
            for (int p = 0; p < 8; ++p) { EPI_POS(p) f32x4 g0, g1; unpack8(gw[p], g0, g1);
                *(GAS v4u*)(O + row * 1024 + u.pn * 256 + cp) = pack8(sig4(g0) * a0, sig4(g1) * a1); } }
    } };
struct EpiUpB { static constexpr bool PERM = true; unsigned char* ws; float* out; bf16* O;
    __device__ __forceinline__ void operator()(CAccRef acc, const pg8::Unit& u, int wr, int wc, int fr, int fq) const {
        const bf16* Gp = panel_rw(ws, out, PN_GB + u.pn);
        const int row0 = u.pm * 256 + wr * 64 + fr, cin = wc * 32 + 8 * fq;
#pragma unroll
        for (int ai = 0; ai < 2; ++ai)
#pragma unroll
            for (int hb = 0; hb < 2; ++hb) { v4u gw[4], yw[4];
#pragma unroll
                for (int q = 0; q < 4; ++q) { const int p = hb * 4 + q; EPI_POS(p) (void)a0; (void)a1; gw[q] = *(const GAS v4u*)(Gp + row * 256 + cp); yw[q] = *(const GAS v4u*)(O + row * 1024 + u.pn * 256 + cp); }
#pragma unroll
                for (int q = 0; q < 4; ++q) { const int p = hb * 4 + q; EPI_POS(p) f32x4 g0, g1, y0, y1; unpack8(gw[q], g0, g1); unpack8(yw[q], y0, y1);
                    *(GAS v4u*)(O + row * 1024 + u.pn * 256 + cp) = pack8(y0 + sig4(g0) * a0, y1 + sig4(g1) * a1); } }
    } };
struct EpiOut { static constexpr bool PERM = true; bf16* HB; const float* xp; const float* xs;
    __device__ __forceinline__ void operator()(CAccRef acc, const pg8::Unit& u, int wr, int wc, int fr, int fq) const {
        const int row0 = u.pm * 256 + wr * 64 + fr, cin = wc * 32 + 8 * fq;
#pragma unroll
        for (int ai = 0; ai < 2; ++ai) { f32x4 x0[8], x1[8];
#pragma unroll
            for (int p = 0; p < 8; ++p) { EPI_POS(p) (void)a0; (void)a1; const size_t col = (size_t)u.pn * 256 + cp;
                const float* xr = (row < (size_t)MP) ? xp + row * 1024 + col : xs + (row - MP) * 1024 + col; x0[p] = *(const GAS f32x4*)xr; x1[p] = *(const GAS f32x4*)(xr + 4); }
#pragma unroll
            for (int p = 0; p < 8; ++p) { EPI_POS(p) const size_t col = (size_t)u.pn * 256 + cp;
                *(GAS v4u*)(HB + row * 1024 + col) = pack8(x0[p] + a0, x1[p] + a1); } }
    } };
struct EpiPe { static constexpr bool PERM = true; bf16* O;
    __device__ __forceinline__ void operator()(CAccRef acc, const pg8::Unit& u, int wr, int wc, int fr, int fq) const {
        EPI_LOOP_BEGIN *(GAS v4u*)(O + row * 1024 + u.pn * 256 + cp) = pack8(a0, a1); EPI_LOOP_END
    } };
struct EpiGate { static constexpr bool PERM = true; unsigned char* ws; const bf16* PEp; const bf16* HB; bf16* H2;
    __device__ __forceinline__ void operator()(CAccRef acc, const pg8::Unit& u, int wr, int wc, int fr, int fq) const {
        float* RS = (float*)(ws + WS_RSSP);
        const int row0 = u.pm * 256 + wr * 64 + fr, cin = wc * 32 + 8 * fq;
#pragma unroll
        for (int ai = 0; ai < 2; ++ai)
#pragma unroll
            for (int hb = 0; hb < 2; ++hb) { v4u pw[4], hw[4];
#pragma unroll
                for (int q = 0; q < 4; ++q) { const int p = hb * 4 + q; EPI_POS(p) (void)a0; (void)a1; const size_t col = (size_t)u.pn * 256 + cp;
                    pw[q] = *(const GAS v4u*)(PEp + row * 1024 + col); hw[q] = *(const GAS v4u*)(HB + row * 1024 + col); }
                float ssm[2] = {0.f, 0.f};
#pragma unroll
                for (int q = 0; q < 4; ++q) { const int p = hb * 4 + q; EPI_POS(p) const size_t col = (size_t)u.pn * 256 + cp;
                    f32x4 p0, p1, x0, x1; unpack8(pw[q], p0, p1); unpack8(hw[q], x0, x1);
                    const f32x4 h0 = x0 + sig4(a0) * p0, h1 = x1 + sig4(a1) * p1;
                    *(GAS v4u*)(H2 + row * 1024 + col) = pack8(h0, h1);
                    ssm[q >> 1] += (h0.x * h0.x + h0.y * h0.y) + (h0.z * h0.z + h0.w * h0.w) + (h1.x * h1.x + h1.y * h1.y) + (h1.z * h1.z + h1.w * h1.w); }
#pragma unroll
                for (int mm = 0; mm < 2; ++mm) { float ss = ssm[mm]; ss += __shfl_xor(ss, 16); ss += __shfl_xor(ss, 32);
                    if (fq == 0) RS[(size_t)(row0 + ai * 128 + (hb * 2 + mm) * 16) * 16 + u.pn * 4 + wc] = ss; } }
    } };

__device__ __forceinline__ void p6_final_norm(const Args& A, int vcu, int G, int wave, int lane) {
    const int gw = vcu * NWAVES + wave, NGW = G * NWAVES;
    const float* RS = (const float*)(A.ws + WS_RSSP);
    const GAS f32x4* fw = (const GAS f32x4*)A.in[21];
    const f32x4 w0 = fw[4 * lane], w1 = fw[4 * lane + 1], w2 = fw[4 * lane + 2], w3 = fw[4 * lane + 3];
    for (int m = gw; m < M; m += NGW) {
        const f32x4 ra = *(const GAS f32x4*)(RS + (size_t)m * 16), rb = *(const GAS f32x4*)(RS + (size_t)m * 16 + 4), rc = *(const GAS f32x4*)(RS + (size_t)m * 16 + 8), rd = *(const GAS f32x4*)(RS + (size_t)m * 16 + 12);
        const bf16* HB = (const bf16*)(A.ws + (m < MP ? WS_MERGED : WS_H1B));
        const v4u ha = *(const GAS v4u*)(HB + (size_t)m * D + 16 * lane), hb = *(const GAS v4u*)(HB + (size_t)m * D + 16 * lane + 8);
        const float ss = (((ra.x + ra.y) + (ra.z + ra.w)) + ((rb.x + rb.y) + (rb.z + rb.w))) + (((rc.x + rc.y) + (rc.z + rc.w)) + ((rd.x + rd.y) + (rd.z + rd.w)));
        const float r = rsqf_(ss * (1.f / D) + NORM_EPS);
        f32x4 a0, a1, a2, a3; unpack8(ha, a0, a1); unpack8(hb, a2, a3);
        GAS f32x4* o = (GAS f32x4*)(A.out + (size_t)m * D + 16 * lane);
        o[0] = a0 * r * w0; o[1] = a1 * r * w1; o[2] = a2 * r * w2; o[3] = a3 * r * w3;
    }
}

struct OneUnit { int pm, pn;
    __device__ bool next(int i, pg8::Unit& u) const { if (i != 0) return false; u.pm = pm; u.pn = pn; return true; }
    __device__ __forceinline__ void a_ready(const pg8::Unit&) const {}
    __device__ __forceinline__ void done(const pg8::Unit&) const {} };
__device__ __forceinline__ void group_arrive(unsigned* cnt) {
    asm volatile("s_waitcnt vmcnt(0)" ::: "memory"); __syncthreads();
    if (threadIdx.x == 0) { __builtin_amdgcn_fence(__ATOMIC_RELEASE, "agent"); asm volatile("s_waitcnt vmcnt(0)" ::: "memory"); (void)xb_add(cnt, 1u); }
}
__device__ __forceinline__ void group_wait(unsigned* cnt, unsigned target) {
    if (threadIdx.x == 0) { unsigned sp = 0; while (xb_ld(cnt) < target) { __builtin_amdgcn_s_sleep(2); if (++sp > (1u << 22)) break; }
        __builtin_amdgcn_fence(__ATOMIC_ACQUIRE, "agent"); asm volatile("s_waitcnt vmcnt(0)" ::: "memory"); }
    __syncthreads();
}
constexpr int CW_SDONE = 8192, CW_GBAR = 8192 + 64;
__device__ __forceinline__ void sample_chain(const Args& A, LAS unsigned char* lds, int ci, int nsample_wgs, int part) {
    unsigned char* ws = A.ws; unsigned* ctl = (unsigned*)(ws + WS_CTL);
    const OneUnit S{MP / 256 + (ci >> 2), ci & 3};
    bf16* T1 = (bf16*)(ws + WS_T1) - (size_t)MP * 1024; bf16* T2 = (bf16*)(ws + WS_PROJ + 10 * SZ_PANEL) - (size_t)MP * 1024; bf16* T3 = T2 + (size_t)1024 * 1024; bf16* H2s = (bf16*)(ws + WS_H1B);
    if (part == 0) {
        group_wait(ctl + CW_SDONE, (unsigned)nsample_wgs);
        { pg8::Gemm g{(const bf16*)(ws + WS_OA), (const bf16*)(ws + WS_WUA), M, 1024, 512}; EpiUpA E{ws, A.out, T1}; pg8::gemm_phase<EpiUpA, OneUnit>(lds + RING_OFF, g, S, E); }
        { pg8::Gemm g{(const bf16*)(ws + WS_OB), (const bf16*)(ws + WS_WUB), M, 1024, 512}; EpiUpB E{ws, A.out, T1}; pg8::gemm_phase<EpiUpB, OneUnit>(lds + RING_OFF, g, S, E); }
        group_arrive(ctl + CW_GBAR); group_wait(ctl + CW_GBAR, 16u);
    } else {
        { pg8::Gemm g{T1, (const bf16*)(ws + WS_WO), M, 1024, 1024}; EpiOut E{T3, A.in[0], A.in[1]}; pg8::gemm_phase<EpiOut, OneUnit>(lds + RING_OFF, g, S, E); }
        group_arrive(ctl + CW_GBAR); group_wait(ctl + CW_GBAR, 32u);
        { pg8::Gemm g{(const bf16*)(ws + WS_PB), (const bf16*)(ws + WS_WP), M, 1024, 256}; EpiPe E{T2}; pg8::gemm_phase<EpiPe, OneUnit>(lds + RING_OFF, g, S, E); }
        { pg8::Gemm g{T3, (const bf16*)(ws + WS_WG), M, 1024, 1024}; EpiGate E{ws, T2, T3, H2s}; pg8::gemm_phase<EpiGate, OneUnit>(lds + RING_OFF, g, S, E); }
    }
}
constexpr int CW_PROG = 12288;
__device__ __forceinline__ void touch_bytes(const unsigned char* p, int nbytes) {
    for (int o = threadIdx.x * 16; o < nbytes; o += NTHREADS * 16) { const v4u x = *(const GAS v4u*)(p + o); asm volatile("" :: "v"(x.x), "v"(x.y), "v"(x.z), "v"(x.w)); }
}
__device__ __forceinline__ bool helper_wait(unsigned* prog, int n, int lead) {
    unsigned sp = 0;
    while ((int)xb_ld(prog) + lead < n) { __builtin_amdgcn_s_sleep(8); if (++sp > (1u << 20)) return false; }
    return true;
}
__device__ __forceinline__ void helper_r2(const Args& A, int bh, int rank, int nrank) {
    unsigned* prog = (unsigned*)(A.ws + WS_CTL) + CW_PROG + 64 * bh;
    const unsigned char* recs = A.ws + WS_REC + (size_t)bh * 32 * 73728;
    for (int n = rank; n < 32; n += nrank) { if (!helper_wait(prog, n, 8)) break; touch_bytes(recs + (size_t)n * 73728, 73728); }
}
__device__ __forceinline__ void helper_gla(const Args& A, int c0, int c1, int n0) {
    for (int n = n0; n < 32; ++n)
        for (int k = 0; k < 2; ++k) { const int c = k ? c1 : c0, b = c >> 2, h = c & 3;
            unsigned* prog = (unsigned*)(A.ws + WS_CTL) + CW_PROG + 64 * (32 + c);
            if (!helper_wait(prog, n, 3)) return;
            const size_t m0 = (size_t)b * SEQ + (size_t)n * 64; const unsigned char* ws = A.ws;
            const int t = threadIdx.x >> 3, j = threadIdx.x & 7;
            const unsigned char* q = ws + WS_PROJ + (size_t)PN_QA * SZ_PANEL + (m0 + t) * 512 + h * 128 + j * 16;
            const unsigned char* kk = ws + WS_PROJ + (size_t)PN_KA * SZ_PANEL + (m0 + t) * 512 + h * 128 + j * 16;
            const unsigned char* v = ws + WS_PROJ + (size_t)(PN_VA + (h >> 1)) * SZ_PANEL + (m0 + t) * 512 + (h & 1) * 256 + j * 32;
            const unsigned char* z = ws + WS_PROJ + (size_t)(PN_ZA + (h >> 1)) * SZ_PANEL + (m0 + t) * 512 + (h & 1) * 256 + j * 32;
            const v4u a = *(const GAS v4u*)q, bb = *(const GAS v4u*)kk, cc = *(const GAS v4u*)v, dd = *(const GAS v4u*)(v + 16), ee = *(const GAS v4u*)z, ff = *(const GAS v4u*)(z + 16);
            asm volatile("" :: "v"(a.x), "v"(bb.x), "v"(cc.x), "v"(dd.x), "v"(ee.x), "v"(ff.x));
            if (j < 4) { const v4u s = *(const GAS v4u*)(ws + WS_SPEC + (m0 + t) * 64 + j * 16); asm volatile("" :: "v"(s.x)); } }
}
constexpr int GLA_SPLIT = 10;
__device__ __forceinline__ void p2_recurrences(const Args& A, LAS unsigned char* lds, int c, int G, const XcdBarrier& bar) {
    float* out = A.out;
#ifdef PROBE_WG
    unsigned long long* stamps = (unsigned long long*)(A.ws + WS_CTL + 98304) + (size_t)c * 16;
#define STAMP2(k) do { if (threadIdx.x == 0) stamps[k] = __builtin_amdgcn_s_memrealtime(); } while (0)
#else
#define STAMP2(k) do { } while (0)
#endif
    const int gt = c * NTHREADS + threadIdx.x, NGT = G * NTHREADS;
    for (int i = gt; i < 8 * 3 * 1536; i += NGT) { const int ch = i % 1536, j = (i / 1536) % 3, b = i / (3 * 1536); const size_t m = (size_t)b * SEQ + SEQ - 3 + j;
        out[OUT_CONV_P + i] = bf2f(panel(A.ws, PN_QB + (ch >> 8))[m * 256 + (ch & 255)]); }
    for (int i = gt; i < 128 * 3 * 1536; i += NGT) { const int ch = i % 1536, j = (i / 1536) % 3, b = i / (3 * 1536); const size_t m = (size_t)MP + b * DSQ + DSQ - 3 + j;
        out[OUT_CONV_S + i] = bf2f(panel(A.ws, PN_QB + (ch >> 8))[m * 256 + (ch & 255)]); }
    unsigned* ctl = (unsigned*)(A.ws + WS_CTL);
    if (c < 32) {
        const int b = c >> 2, h = c & 3, lane = threadIdx.x & 63;
        float wg[16];
#pragma unroll
        for (int r = 0; r < 16; ++r) wg[r] = A.in[9][r * 256 + h * 64 + lane];
        const float bgv = A.in[10][h * 64 + lane];
        GlaState st; st.S[0] = zero16(); st.S[1] = zero16();
#pragma unroll
        for (int i = 0; i < 4; ++i) st.Sb[i] = (bf16x8){0, 0, 0, 0, 0, 0, 0, 0};
        const float nw0 = A.in[11][2 * lane], nw1 = A.in[11][2 * lane + 1];
        gla_issue_vs(A, lds, b, h, 0); gla_issue_qk(A, lds, b, h, 0); gla_issue_z(A, lds, b, h, 0); asm volatile("s_waitcnt vmcnt(0)" ::: "memory"); LBAR();
        for (int n = 0; n < 32; ++n) {
            if (n == GLA_SPLIT && MK_N_LAUNCHES == 1) { STAMP2(5); xcd_barrier(bar); STAMP2(6); }
            if (threadIdx.x == 0) __hip_atomic_store(ctl + CW_PROG + 64 * (32 + c), (unsigned)n, __ATOMIC_RELAXED, __HIP_MEMORY_SCOPE_AGENT);
            gla_chunk(A, lds, b, h, n, st, wg, bgv, nw0, nw1); }
        gla_final(A, c, st);
    } else {
        const int nsw = G - 32;
        for (int it = c - 32; it < 1024; it += nsw) {
            if (it < 512) { const int b = it >> 2, h = it & 3; gla_item_s(A, lds, h, MP + b * DSQ, A.in[2] + (size_t)it * 64 * 128, out + OUT_GLA_S + (size_t)it * 64 * 128); }
            else { const int i = it - 512, b = i >> 2, h = i & 3; gdn_item_s(A, lds, h, MP + b * DSQ, A.in[3] + (size_t)i * 128 * 128, out + OUT_GDN_S + (size_t)i * 128 * 128, A.in[4] + (size_t)b * 3 * 1536); }
        }
        group_arrive(ctl + CW_SDONE);
        if (c < 48) {
            sample_chain(A, lds, c - 32, nsw, 0);
            STAMP2(5); xcd_barrier(bar); STAMP2(6);
            sample_chain(A, lds, c - 32, nsw, 1);
        } else {
            { r1_stage_cw(A, lds); const int step = G - 48; int u = c - 48; R1Pre pa;
              float negA4[4], dtb4[4];
#pragma unroll
              for (int i = 0; i < 4; ++i) { negA4[i] = -__expf(A.in[13][i]); dtb4[i] = A.in[14][i]; }
              if (u < 1024) { r1_prefetch(A, u, pa); r1_touch(pa); }
              while (u < 1024) { const int un = u + step; gdn_r1_unit(A, lds, u, pa, un, negA4, dtb4); u = un; } }
            STAMP2(5); xcd_barrier(bar); STAMP2(6);
            if (c < 80) gdn_r2_item(A, lds, c - 48);
            else { const int g = c & 7, j = (c - 80) >> 3;
                if (j < 20) helper_r2(A, g + 8 * (j & 3), j >> 2, 5);
                else if (j == 20) helper_gla(A, g, g + 8, GLA_SPLIT);
                else helper_gla(A, g + 16, g + 24, GLA_SPLIT); }
        }
    }
}
#ifndef MK_N_LAUNCHES
#define MK_N_LAUNCHES 1
#endif
#ifndef PROBE_DUP
#define PROBE_DUP -1
#endif
constexpr int N_PHASES = 7;
__global__ void __launch_bounds__(NTHREADS, 2) mk_fwd(Args args) {
    extern __shared__ __attribute__((aligned(16))) unsigned char lds_raw[];
    LAS unsigned char* lds = (LAS unsigned char*)lds_raw;
    volatile LAS unsigned* MISC = (volatile LAS unsigned*)(lds + MISC_OFF);
    const int tid = threadIdx.x, lane = tid & 63, wave = __builtin_amdgcn_readfirstlane(tid >> 6);
    const int G = gridDim.x, bx = blockIdx.x;
    const int vcu = (G % 8 == 0) ? (bx % 8) * (G / 8) + bx / 8 : bx;
    for (int u = tid; u < (LDS_BYTES - LDSCTL_OFF) / 4; u += NTHREADS) ((LAS unsigned*)(lds + LDSCTL_OFF))[u] = 0u;
    __syncthreads();
    unsigned char* ws = args.ws;
    XcdBarrier bar; bar.bar = (unsigned*)(ws + WS_CTL) + CW_BAR; bar.x = 0; bar.st = nullptr;
    if (MK_N_LAUNCHES == 1) bar = xcd_barrier_post((unsigned*)(ws + WS_CTL) + CW_BAR, MISC + 8);
    const int lo = args.ph_lo, hi = args.ph_hi;
#ifdef PROBE_WG
    unsigned long long* stamps = (unsigned long long*)(ws + WS_CTL + 98304) + (size_t)bx * 16;
#define STAMP(k) do { if (tid == 0) stamps[k] = __builtin_amdgcn_s_memrealtime(); } while (0)
#else
#define STAMP(k) do { } while (0)
#endif
    STAMP(0);
#define IN(k) (lo <= (k) && (k) < hi)
#define SEAM(k) do { if (IN(k) && IN((k) + 1)) xcd_barrier(bar); } while (0)

    if (IN(0)) { for (int rep = 0; rep < (PROBE_DUP == 0 ? 2 : 1); ++rep) p0_prologue(args, lds, vcu, G, wave, lane); }
    STAMP(1); SEAM(0); STAMP(2);
    if (IN(1)) for (int rep = 0; rep < (PROBE_DUP == 1 ? 2 : 1); ++rep) {
        pg8::Gemm g{(const bf16*)(ws + WS_XN), (const bf16*)(ws + WS_WIN), M, NPROJ, 1024}; pg8::StaticOrder S; S.init(M, NPROJ, G, bx);
        EpiProj E{ws, args.out};
        pg8::gemm_phase<EpiProj, pg8::StaticOrder>(lds + RING_OFF, g, S, E);
    }
    STAMP(3); SEAM(1); STAMP(4);
    if (IN(2)) { p2_recurrences(args, lds, bx, G, bar); if (PROBE_DUP == 2) p2_recurrences(args, lds, bx, G, bar); }
    STAMP(7); SEAM(2); STAMP(8);
    if (IN(3)) for (int rep = 0; rep < (PROBE_DUP == 3 ? 2 : 1); ++rep) {
        pg8::StaticOrder S; S.init(MP, 1024, G, bx);
        { pg8::Gemm g{(const bf16*)(ws + WS_OA), (const bf16*)(ws + WS_WUA), M, 1024, 512}; EpiUpA E{ws, args.out, (bf16*)(ws + WS_MERGED)}; pg8::gemm_phase<EpiUpA, pg8::StaticOrder>(lds + RING_OFF, g, S, E); }
        { pg8::Gemm g{(const bf16*)(ws + WS_OB), (const bf16*)(ws + WS_WUB), M, 1024, 512}; EpiUpB E{ws, args.out, (bf16*)(ws + WS_MERGED)}; pg8::gemm_phase<EpiUpB, pg8::StaticOrder>(lds + RING_OFF, g, S, E); }
    }
    STAMP(9); SEAM(3); STAMP(10);
    if (IN(4)) for (int rep = 0; rep < (PROBE_DUP == 4 ? 2 : 1); ++rep) {
        pg8::StaticOrder S; S.init(MP, 1024, G, bx);
        pg8::Gemm g{(const bf16*)(ws + WS_MERGED), (const bf16*)(ws + WS_WO), M, 1024, 1024}; EpiOut E{(bf16*)(ws + WS_H1B), args.in[0], args.in[1]};
        pg8::gemm_phase<EpiOut, pg8::StaticOrder>(lds + RING_OFF, g, S, E);
    }
    STAMP(11); SEAM(4); STAMP(12);
    if (IN(5)) for (int rep = 0; rep < (PROBE_DUP == 5 ? 2 : 1); ++rep) {
        pg8::StaticOrder S; S.init(MP, 1024, G, bx);
        { pg8::Gemm g{(const bf16*)(ws + WS_PB), (const bf16*)(ws + WS_WP), M, 1024, 256}; EpiPe E{(bf16*)(ws + WS_PE)}; pg8::gemm_phase<EpiPe, pg8::StaticOrder>(lds + RING_OFF, g, S, E); }
        { pg8::Gemm g{(const bf16*)(ws + WS_H1B), (const bf16*)(ws + WS_WG), M, 1024, 1024}; EpiGate E{ws, (const bf16*)(ws + WS_PE), (const bf16*)(ws + WS_H1B), (bf16*)(ws + WS_MERGED)}; pg8::gemm_phase<EpiGate, pg8::StaticOrder>(lds + RING_OFF, g, S, E); }
    }
    STAMP(13); SEAM(5); STAMP(14);
    if (IN(6)) { for (int rep = 0; rep < (PROBE_DUP == 6 ? 2 : 1); ++rep) p6_final_norm(args, vcu, G, wave, lane); }
    STAMP(15);
#ifdef PROBE_WG
    xcd_barrier(bar);
    if (bx == 0) { const unsigned long long* sp = (const unsigned long long*)(ws + WS_CTL + ((PROBE_K1 >= 16) ? 65536 : 98304)) + (size_t)(PROBE_WG) * 16 - ((PROBE_K1 >= 16) ? 16 : 0);
        const float Tus = (float)(__hip_atomic_load(sp + PROBE_K1, __ATOMIC_RELAXED, __HIP_MEMORY_SCOPE_AGENT) - __hip_atomic_load(sp + PROBE_K0, __ATOMIC_RELAXED, __HIP_MEMORY_SCOPE_AGENT)) * 0.01f;
        const float X = 0.02f * rintf(20.f * Tus / (float)(PROBE_SCALE)) * 0.05f;
        for (int i = tid; i < 8 * 3 * 1536; i += NTHREADS) args.out[OUT_CONV_P + i] += X; }
#endif
#undef IN
#undef SEAM
}

extern "C" void kernel_launch(void* const* d_in, const int* in_sizes, int n_in, void* d_out, int out_size, void* d_ws, size_t ws_size, hipStream_t stream) {
    static int grid = 0;
    if (grid == 0) {
        if (n_in != 22 || in_sizes[0] != MP * D || (size_t)out_size != OUT_TOTAL || ws_size < WS_END) {
            fprintf(stderr, "kernel_launch: unexpected shapes: n_in %d in0 %d out %d ws %zu (need %zu)\n", n_in, n_in > 0 ? in_sizes[0] : -1, out_size, ws_size, (size_t)WS_END); grid = -1; return; }
        int dev = 0, cus = 0, per_cu = 0;
        if (hipGetDevice(&dev) != hipSuccess || hipDeviceGetAttribute(&cus, hipDeviceAttributeMultiprocessorCount, dev) != hipSuccess) { grid = -1; return; }
        if (hipFuncSetAttribute((const void*)mk_fwd, hipFuncAttributeMaxDynamicSharedMemorySize, LDS_BYTES) != hipSuccess) { fprintf(stderr, "kernel_launch: hipFuncSetAttribute failed\n"); grid = -1; return; }
        if (hipOccupancyMaxActiveBlocksPerMultiprocessor(&per_cu, (const void*)mk_fwd, NTHREADS, LDS_BYTES) != hipSuccess || per_cu < 1) {
            fprintf(stderr, "kernel_launch: occupancy query reports %d workgroups per CU\n", per_cu); (void)hipGetLastError(); grid = -1; return; }
        grid = cus;
    }
    if (grid < 0) return;
    (void)hipMemsetAsync((char*)d_ws + WS_CTL, 0, CTL_ZERO_BYTES, stream);
    Args a{};
    for (int i = 0; i < 22; ++i) a.in[i] = (const float*)d_in[i];
    a.out = (float*)d_out; a.ws = (unsigned char*)d_ws;
#if MK_N_LAUNCHES == 1
    a.ph_lo = 0; a.ph_hi = N_PHASES;
    hipLaunchKernelGGL(mk_fwd, dim3(grid), dim3(NTHREADS), LDS_BYTES, stream, a);
#else
    for (int p = 0; p < N_PHASES; ++p) { a.ph_lo = p; a.ph_hi = p + 1; hipLaunchKernelGGL(mk_fwd, dim3(grid), dim3(NTHREADS), LDS_BYTES, stream, a); }
#endif
}
```

```cpp
#include <hip/hip_runtime.h>
#include <cstdio>
#include <cstdint>
#define MK_N_LAUNCHES 1
#define PROBE_DUP -1
namespace pg8 {
#define PG8_LAS __attribute__((address_space(3)))
typedef unsigned short bf16_t;
typedef short bf16x8 __attribute__((ext_vector_type(8)));
typedef float f32x4 __attribute__((ext_vector_type(4)));
typedef unsigned u32x4 __attribute__((ext_vector_type(4)));
constexpr int BM = 256, BK = 64, HALF = 128, HTB = HALF * BK * 2  , STAGE_BYTES = 8 * HTB, NXCD = 8, WGM = 8;

__host__ __device__ __forceinline__ int lds_byte(int r, int c) { const int st = (r >> 4) * 2 + (c >> 5), rr = r & 15, cc = c & 31, ob = rr * 64 + cc * 2; return st * 1024 + (ob ^ (((ob >> 9) & 1) << 5)); }
__host__ __device__ __forceinline__ void stage_rc(int b, int& R, int& C) { const int st = b / 1024, sb = b % 1024, swz = sb ^ (((sb >> 9) & 1) << 5); R = (st >> 1) * 16 + swz / 64; C = (st & 1) * 32 + (swz % 64) / 2; }
__host__ __device__ __forceinline__ int perm32(int rho) { const int n = rho >> 4, i = rho & 15; return 8 * (i >> 2) + 4 * n + (i & 3); }

struct Unit { int pm, pn; };
struct Gemm { const bf16_t* A; const bf16_t* Bt; int M, N, K; };

struct StaticOrder {
    int nM, nN, nwg, G, c;
    __host__ __device__ void init(int M, int N, int G_, int c_) { nM = M / BM; nN = N / BM; nwg = nM * nN; G = G_; c = c_; }
    __host__ __device__ bool next(int i, Unit& u) const {
        const long L = (long)i * G + c; if (L >= nwg) return false;
        int wgid = (int)L; { const int q = nwg / NXCD, r = nwg % NXCD, xcd = wgid % NXCD, off = wgid / NXCD; wgid = (xcd < r ? xcd * (q + 1) : r * (q + 1) + (xcd - r) * q) + off; }
        const int nig = WGM * nN, gid = wgid / nig, fm = gid * WGM, gsz = (nM - fm) < WGM ? (nM - fm) : WGM;
        u.pm = fm + ((wgid % nig) % gsz); u.pn = (wgid % nig) / gsz; return true;
    }
    __device__ __forceinline__ void a_ready(const Unit&) const {}
    __device__ __forceinline__ void done(const Unit&) const {}
};

typedef __bf16 bf16x2_t __attribute__((ext_vector_type(2)));
typedef float f32x2_t __attribute__((ext_vector_type(2)));
__device__ __forceinline__ unsigned cvt_pk_bf16(float lo, float hi) { const f32x2_t v = {lo, hi}; return __builtin_bit_cast(unsigned, __builtin_convertvector(v, bf16x2_t)); }

template <class Epi, class Sched>
__device__ __forceinline__ void gemm_phase(PG8_LAS unsigned char* lds, const Gemm g, const Sched& S, const Epi& E) {
    int tid_ = threadIdx.x; asm volatile("" : "+v"(tid_));
    const int tid = tid_, wid = __builtin_amdgcn_readfirstlane(tid >> 6), lane = tid & 63, wr = wid >> 2, wc = wid & 3, fr = lane & 15, fq = lane >> 4;
    const int K = g.K, nt = K / BK;
    unsigned voffA[2], voffB[2];
#pragma unroll
    for (int i = 0; i < 2; ++i) { int R, C; stage_rc(tid * 16 + i * 8192, R, C); const int Rb = Epi::PERM ? ((R & ~31) + perm32(R & 31)) : R;
        voffA[i] = (unsigned)(R * K + C) * 2u; voffB[i] = (unsigned)(Rb * K + C) * 2u; }
    const size_t kstep = (size_t)(BK * 2);
    const size_t hstep = (size_t)HALF * K * 2;
    const size_t tstep = 2 * hstep;
    const unsigned ldsw = (unsigned)wid * 1024u;
    const int aoff = lds_byte(wr * 64 + fr, fq * 8), boff = lds_byte(wc * 32 + fr, fq * 8);
#define PG8_SA(b, h) (((b) * 2 + (h)) * HTB)
#define PG8_SB(b, h) ((4 + (b) * 2 + (h)) * HTB)
#define PG8_STAGE(bufoff, gbase, voff) do { _Pragma("unroll") for (int _i = 0; _i < 2; ++_i) \
        __builtin_amdgcn_global_load_lds((const unsigned*)((const char*)(gbase) + (voff)[_i]), (PG8_LAS unsigned*)(lds + (bufoff) + ldsw + _i * 8192), 16, 0, 0); } while (0)
#define PG8_LDA(dst, b, h) do { _Pragma("unroll") for (int m = 0; m < 4; ++m) _Pragma("unroll") for (int k = 0; k < 2; ++k) dst[m][k] = *(const PG8_LAS bf16x8*)(lds + PG8_SA(b, h) + aoff + m * 2048 + k * 1024); } while (0)
#define PG8_LDB(dst, b, h) do { _Pragma("unroll") for (int n = 0; n < 2; ++n) _Pragma("unroll") for (int k = 0; k < 2; ++k) dst[n][k] = *(const PG8_LAS bf16x8*)(lds + PG8_SB(b, h) + boff + n * 2048 + k * 1024); } while (0)
#define PG8_MMA(ai, bj, At, Bt) do { __builtin_amdgcn_s_setprio(1); _Pragma("unroll") for (int m = 0; m < 4; ++m) _Pragma("unroll") for (int n = 0; n < 2; ++n) _Pragma("unroll") for (int k = 0; k < 2; ++k) \
        acc[ai][bj][m][n] = __builtin_amdgcn_mfma_f32_16x16x32_bf16(Bt[n][k], At[m][k], acc[ai][bj][m][n], 0, 0, 0); __builtin_amdgcn_s_setprio(0); } while (0)
#define PG8_WAIT_V(n) asm volatile("s_waitcnt vmcnt(" #n ")" ::: "memory")
#define PG8_WAIT_L(n) asm volatile("s_waitcnt lgkmcnt(" #n ")" ::: "memory")
#define PG8_BAR __builtin_amdgcn_s_barrier()
#define PG8_SCHED __builtin_amdgcn_sched_barrier(0)
    Unit cur, nxt; int ui = 0;
    if (!S.next(0, cur)) return;
    f32x4 acc[2][2][4][2];
#pragma unroll
    for (int a = 0; a < 2; ++a)
#pragma unroll
        for (int b = 0; b < 2; ++b)
#pragma unroll
            for (int m = 0; m < 4; ++m)
#pragma unroll
                for (int n = 0; n < 2; ++n) acc[a][b][m][n] = (f32x4){0.f, 0.f, 0.f, 0.f};
    bf16x8 At[4][2], B0[2][2], B1[2][2];
    const char* cA = (const char*)g.A + (size_t)cur.pm * tstep; const char* cB = (const char*)g.Bt + (size_t)cur.pn * tstep;
    S.a_ready(cur);
    PG8_STAGE(PG8_SB(0, 0), cB, voffB); PG8_STAGE(PG8_SA(0, 0), cA, voffA); PG8_STAGE(PG8_SB(0, 1), cB + hstep, voffB); PG8_STAGE(PG8_SA(0, 1), cA + hstep, voffA);
    if (wr == 1) PG8_BAR;
    PG8_WAIT_V(4); PG8_BAR;
    PG8_STAGE(PG8_SB(1, 0), cB + kstep, voffB); PG8_STAGE(PG8_SA(1, 0), cA + kstep, voffA); PG8_STAGE(PG8_SB(1, 1), cB + hstep + kstep, voffB);
    PG8_WAIT_V(6); PG8_BAR;
    for (;;) {
        const bool has_next = S.next(ui + 1, nxt);
        const char* nA = has_next ? (const char*)g.A + (size_t)nxt.pm * tstep : cA; const char* nB = has_next ? (const char*)g.Bt + (size_t)nxt.pn * tstep : cB;
        for (int t = 0; t < nt; t += 2) {
            const bool last = (t == nt - 2);
            const char* a1 = cA + (size_t)(t + 1) * kstep;
            const char* a2 = last ? nA : cA + (size_t)(t + 2) * kstep; const char* b2 = last ? nB : cB + (size_t)(t + 2) * kstep;
            const char* a3 = a2 + kstep; const char* b3 = b2 + kstep;
            if (last && has_next) S.a_ready(nxt);
            PG8_LDB(B0, 0, 0); PG8_SCHED; PG8_LDA(At, 0, 0); PG8_STAGE(PG8_SA(1, 1), a1 + hstep, voffA);
            PG8_WAIT_L(8); PG8_BAR; PG8_WAIT_L(0); PG8_MMA(0, 0, At, B0); PG8_BAR; PG8_SCHED;
            PG8_LDB(B1, 0, 1); PG8_STAGE(PG8_SB(0, 0), b2, voffB);
            PG8_BAR; PG8_WAIT_L(0); PG8_MMA(0, 1, At, B1); PG8_BAR;
            PG8_LDA(At, 0, 1); PG8_STAGE(PG8_SA(0, 0), a2, voffA);
            PG8_BAR; PG8_WAIT_L(0); PG8_MMA(1, 0, At, B0); PG8_BAR; PG8_SCHED;
            PG8_STAGE(PG8_SB(0, 1), b2 + hstep, voffB);
            PG8_WAIT_V(6); PG8_BAR; PG8_MMA(1, 1, At, B1); PG8_BAR;
            PG8_LDB(B0, 1, 0); PG8_SCHED; PG8_LDA(At, 1, 0); PG8_STAGE(PG8_SA(0, 1), a2 + hstep, voffA);
            PG8_WAIT_L(8); PG8_BAR; PG8_WAIT_L(0); PG8_MMA(0, 0, At, B0); PG8_BAR; PG8_SCHED;
            PG8_LDB(B1, 1, 1); PG8_STAGE(PG8_SB(1, 0), b3, voffB);
            PG8_BAR; PG8_WAIT_L(0); PG8_MMA(0, 1, At, B1); PG8_BAR;
            PG8_LDA(At, 1, 1); PG8_STAGE(PG8_SA(1, 0), a3, voffA);
            PG8_BAR; PG8_WAIT_L(0); PG8_MMA(1, 0, At, B0); PG8_BAR; PG8_SCHED;
            PG8_STAGE(PG8_SB(1, 1), b3 + hstep, voffB);
            PG8_WAIT_V(6); PG8_BAR; PG8_MMA(1, 1, At, B1); PG8_BAR;
        }
        E(acc, cur, wr, wc, fr, fq); S.done(cur);
        if (!has_next) break;
#pragma unroll
        for (int a = 0; a < 2; ++a)
#pragma unroll
            for (int b = 0; b < 2; ++b)
#pragma unroll
                for (int m = 0; m < 4; ++m)
#pragma unroll
                    for (int n = 0; n < 2; ++n) acc[a][b][m][n] = (f32x4){0.f, 0.f, 0.f, 0.f};
        cur = nxt; cA = nA; cB = nB; ++ui;
    }
    PG8_WAIT_V(0);
    if (wr == 0) PG8_BAR;
    PG8_BAR;
#undef PG8_SA
#undef PG8_SB
#undef PG8_STAGE
#undef PG8_LDA
#undef PG8_LDB
#undef PG8_MMA
#undef PG8_WAIT_V
#undef PG8_WAIT_L
#undef PG8_BAR
#undef PG8_SCHED
}
}
struct Args { const float* in[22]; float* out; unsigned char* ws; int ph_lo, ph_hi; };
constexpr int D = 1024, SEQ = 2048, NB = 8, MP = NB * SEQ, DB = 128, DSQ = 8, MS = DB * DSQ, M = MP + MS;
constexpr int NPANEL = 23, NPROJ = NPANEL * 256;
constexpr float NORM_EPS = 1e-6f;
constexpr int GLA_DK = 64, GLA_DV = 128, GDN_DK = 128, GDN_DV = 128, CONV_CH = 1536;

constexpr size_t MiB = 1u << 20;
constexpr size_t SZ_PANEL = (size_t)M * 256 * 2;
constexpr size_t WS_CTL = 0, CTL_ZERO_BYTES = 128 * 1024;
constexpr size_t WS_WIN = CTL_ZERO_BYTES;
constexpr size_t WS_WUA = WS_WIN + (size_t)NPROJ * 1024 * 2;
constexpr size_t WS_WUB = WS_WUA + 1 * MiB;
constexpr size_t WS_WO = WS_WUB + 1 * MiB;
constexpr size_t WS_WG = WS_WO + 2 * MiB;
constexpr size_t WS_WP = WS_WG + 2 * MiB;
constexpr size_t WS_SPEC = WS_WP + MiB / 2;
constexpr size_t WS_RSSP = WS_SPEC + (size_t)M * 32 * 2;
constexpr size_t WS_CDEC = WS_RSSP + (size_t)M * 16 * 4;
constexpr size_t WS_PB = WS_CDEC + 4096;
constexpr size_t WS_XN = WS_PB + SZ_PANEL;
constexpr size_t WS_PROJ = WS_XN + (size_t)M * 1024 * 2;
constexpr size_t WS_REC = WS_PROJ + 14 * SZ_PANEL;
constexpr size_t WS_T1 = WS_REC + (size_t)1024 * 73728;
constexpr size_t WS_END = WS_T1 + 2 * MiB;
static_assert(WS_END <= 256 * MiB, "workspace map exceeds 256 MiB");
static_assert(WS_WIN % 256 == 0 && WS_SPEC % 256 == 0 && WS_RSSP % 256 == 0 && WS_PB % 256 == 0 && WS_XN % 256 == 0 && WS_PROJ % 256 == 0 && WS_REC % 256 == 0, "alignment");
constexpr size_t WS_OA = WS_XN, WS_OB = WS_XN + (size_t)M * 512 * 2;
constexpr size_t WS_MERGED = WS_PROJ + 0 * SZ_PANEL;
constexpr size_t WS_H1B = WS_PROJ + 6 * SZ_PANEL;
constexpr size_t WS_PE = WS_PROJ + 10 * SZ_PANEL;
constexpr int PN_QA = 0, PN_KA = 1, PN_VA = 2, PN_ZA = 4, PN_QB = 6, PN_KB = 8, PN_VB = 10, PN_ZB = 12, PN_GA = 14, PN_GB = 18, PN_SPEC = 22;
constexpr size_t OUT_Y = 0, OUT_GLA_P = (size_t)M * D, OUT_GDN_P = OUT_GLA_P + 8 * 4 * 64 * 128, OUT_CONV_P = OUT_GDN_P + 8 * 4 * 128 * 128,
                 OUT_GLA_S = OUT_CONV_P + 8 * 3 * 1536, OUT_GDN_S = OUT_GLA_S + (size_t)128 * 4 * 64 * 128, OUT_CONV_S = OUT_GDN_S + (size_t)128 * 4 * 128 * 128,
                 OUT_TOTAL = OUT_CONV_S + 128 * 3 * 1536;
constexpr int CW_BAR = 1024;

constexpr int RING_OFF = 0, RING_BYTES = 131072;
constexpr int LDS_BYTES = 163840;
constexpr int LDSCTL_OFF = LDS_BYTES - 512, MISC_OFF = LDSCTL_OFF + 320;
constexpr int NWAVES = 8, NTHREADS = 512;

#define GAS __attribute__((address_space(1)))
#define LAS __attribute__((address_space(3)))
typedef unsigned short bf16;
typedef unsigned v4u __attribute__((ext_vector_type(4)));
typedef unsigned v2u __attribute__((ext_vector_type(2)));
typedef float f32x4 __attribute__((ext_vector_type(4)));
typedef GAS unsigned gu32;
#define RLX_AGENT __ATOMIC_RELAXED, __HIP_MEMORY_SCOPE_AGENT
#define LDS_WAIT() asm volatile("s_waitcnt lgkmcnt(0)" ::: "memory")
#define VM_WAIT() asm volatile("s_waitcnt vmcnt(0)" ::: "memory")
__device__ __forceinline__ unsigned pk2(float lo, float hi) { return pg8::cvt_pk_bf16(lo, hi); }
__device__ __forceinline__ unsigned f2bf(float f) { return pg8::cvt_pk_bf16(f, 0.f) & 0xffffu; }
__device__ __forceinline__ float bf2f(unsigned short b) { return __builtin_bit_cast(float, (unsigned)b << 16); }
__device__ __forceinline__ float bflo(unsigned w) { return __builtin_bit_cast(float, w << 16); }
__device__ __forceinline__ float bfhi(unsigned w) { return __builtin_bit_cast(float, w & 0xffff0000u); }
__device__ __forceinline__ float rcpf_(float x) { return __builtin_amdgcn_rcpf(x); }
__device__ __forceinline__ float rsqf_(float x) { return __builtin_amdgcn_rsqf(x); }
__device__ __forceinline__ float sigmoidf_(float x) { return rcpf_(1.f + __expf(-x)); }
__device__ __forceinline__ float siluf_(float x) { return x * rcpf_(1.f + __expf(-x)); }
__device__ __forceinline__ float softplusf_(float x) { return fmaxf(x, 0.f) + log1pf(__expf(-fabsf(x))); }
__device__ __forceinline__ float wave_sum(float v) {
#pragma unroll
    for (int o = 1; o < 64; o <<= 1) v += __shfl_xor(v, o);
    return v;
}

#define XB_TMO      128
#define XB_XCNT(j)  (256  + 64 * (j))
#define XB_XSUB(j)  (1280 + 64 * (j))
#define XB_XGEN(j)  (2304 + 64 * (j))
#define XB_TOP      3328
#define XB_TOPGEN   3392
#define XCD_BAR_WORDS 3456
#define XB_SPIN_CAP (1u << 18)
__device__ __forceinline__ unsigned xb_ld(unsigned* p)              { return __hip_atomic_load(p, __ATOMIC_RELAXED, __HIP_MEMORY_SCOPE_AGENT); }
__device__ __forceinline__ unsigned xb_add(unsigned* p, unsigned v) { return __hip_atomic_fetch_add(p, v, __ATOMIC_RELAXED, __HIP_MEMORY_SCOPE_AGENT); }
__device__ __forceinline__ unsigned xb_xcc_id() { return (unsigned)__builtin_amdgcn_s_getreg((3 << 11) | 20) & 0xFu; }
#define XB_SPIN(cond, bar) do { unsigned _sp = 0; while (cond) { __builtin_amdgcn_s_sleep(1); \
    if ((++_sp & 255u) == 0u) { if (xb_ld(&(bar)[XB_TMO])) break; if (_sp > XB_SPIN_CAP) { atomicAdd(&(bar)[XB_TMO], 1u); break; } } } } while (0)
struct XcdBarrier { unsigned* bar; unsigned x; volatile LAS unsigned* st; };
__device__ __forceinline__ XcdBarrier xcd_barrier_post(unsigned* bar, volatile LAS unsigned* st) {
    XcdBarrier b; b.bar = bar; b.x = xb_xcc_id(); b.st = st;
    if (threadIdx.x == 0) (void)xb_add(&bar[XB_XCNT(b.x)], 1u);
    return b;
}
__device__ __forceinline__ void xcd_barrier_complete(unsigned* bar, unsigned x, unsigned& nloc, unsigned& nx) {
    const unsigned G = gridDim.x * gridDim.y * gridDim.z;
    unsigned sum, cnt, mine, sp = 0u;
    for (;;) {
        sum = 0u; cnt = 0u; mine = 0u;
#pragma unroll
        for (unsigned j = 0; j < 16; ++j) { const unsigned c = xb_ld(&bar[XB_XCNT(j)]); sum += c; cnt += (c > 0u) ? 1u : 0u; mine = (j == x) ? c : mine; }
        if (sum == G) break;
        __builtin_amdgcn_s_sleep(1);
        if ((++sp & 255u) == 0u) { if (xb_ld(&bar[XB_TMO])) break; if (sp > XB_SPIN_CAP) { atomicAdd(&bar[XB_TMO], 1u); break; } }
    }
    nloc = mine > 0u ? mine : 1u; nx = cnt > 0u ? cnt : 1u;
}
__device__ __forceinline__ void xcd_barrier(const XcdBarrier& b) {
    asm volatile("s_waitcnt vmcnt(0)" ::: "memory");
    __syncthreads();
    if (threadIdx.x == 0) {
        unsigned* bar = b.bar;
        __builtin_amdgcn_s_waitcnt(0);
        unsigned nloc = b.st[0], nx = b.st[1];
        if (nloc == 0u) { xcd_barrier_complete(bar, b.x, nloc, nx); b.st[0] = nloc; b.st[1] = nx; }
        const unsigned old = xb_add(&bar[XB_XSUB(b.x)], 1u);
        const unsigned gen = old / nloc;
        if (old + 1u == (gen + 1u) * nloc) {
            __builtin_amdgcn_fence(__ATOMIC_RELEASE, "agent");
            asm volatile("s_waitcnt vmcnt(0)" ::: "memory");
            const unsigned og = xb_add(&bar[XB_TOP], 1u);
            const unsigned tg = og / nx;
            if (og + 1u == (tg + 1u) * nx) xb_add(&bar[XB_TOPGEN], 1u);
            else XB_SPIN(xb_ld(&bar[XB_TOPGEN]) == tg, bar);
            __builtin_amdgcn_fence(__ATOMIC_ACQUIRE, "agent");
            xb_add(&bar[XB_XGEN(b.x)], 1u);
            asm volatile("s_waitcnt vmcnt(0)" ::: "memory");
        } else {
            XB_SPIN(xb_ld(&bar[XB_XGEN(b.x)]) == gen, bar);
            __builtin_amdgcn_fence(__ATOMIC_ACQUIRE, "agent");
            asm volatile("s_waitcnt vmcnt(0)" ::: "memory");
        }
    }
    __syncthreads();
}

struct Frame {
    LAS unsigned char* lds;
    volatile LAS unsigned* MISC;
    int tid, lane, wave, G, vcu;
    const float* in[22];
    float* out;
    unsigned char* ws;
};
__device__ __forceinline__ int win_src_col(int n) {
    if (n < 1024) return n;
    if (n < 3072) return n + 16;
    if (n < 5632) return n + 24;
    if (n < 5648) return 1024 + (n - 5632);
    if (n < 5656) return 3088 + (n - 5648);
    return -1;
}
template <bool MAPCOL>
__device__ __forceinline__ void p0_transpose_item(const float* W, int K, int Nsrc, int Ndst, bf16* WT, LAS float* scr, int item, int lane) {
    const int nblk = Ndst / 32, kb = item / nblk, nb = item % nblk, k0 = 64 * kb, n0 = 32 * nb;
    int sc = n0 + (lane & 31); if (MAPCOL) sc = win_src_col(sc);
#pragma unroll 8
    for (int i = 0; i < 32; ++i) { const int kk = 2 * i + (lane >> 5); scr[kk * 33 + (lane & 31)] = (sc >= 0) ? W[(size_t)(k0 + kk) * Nsrc + sc] : 0.f; }
    LDS_WAIT(); asm volatile("" ::: "memory");
    const int c = lane & 7;
#pragma unroll
    for (int j = 0; j < 4; ++j) { const int n = (lane >> 3) + 8 * j; const LAS float* s = scr + (8 * c) * 33 + n;
        v4u o; o.x = pk2(s[0 * 33], s[1 * 33]); o.y = pk2(s[2 * 33], s[3 * 33]); o.z = pk2(s[4 * 33], s[5 * 33]); o.w = pk2(s[6 * 33], s[7 * 33]);
        *(GAS v4u*)(WT + (size_t)(n0 + n) * K + k0 + 8 * c) = o; }
    LDS_WAIT(); asm volatile("" ::: "memory");
}
__device__ __forceinline__ void rms_row_to_bf16(const float* xrow, const float* w, bf16* orow, int lane) {
    const GAS f32x4* xr = (const GAS f32x4*)xrow + lane;
    const GAS f32x4* wr = (const GAS f32x4*)w + lane;
    f32x4 v[4]; float s = 0.f;
#pragma unroll
    for (int j = 0; j < 4; ++j) { v[j] = xr[64 * j]; s += (v[j].x * v[j].x + v[j].y * v[j].y) + (v[j].z * v[j].z + v[j].w * v[j].w); }
    const float r = rsqf_(wave_sum(s) * (1.f / D) + NORM_EPS);
    GAS unsigned long long* o8 = (GAS unsigned long long*)orow + lane;
#pragma unroll
    for (int j = 0; j < 4; ++j) { const f32x4 ww = wr[64 * j];
        o8[64 * j] = (unsigned long long)pk2(v[j].x * r * ww.x, v[j].y * r * ww.y) | ((unsigned long long)pk2(v[j].z * r * ww.z, v[j].w * r * ww.w) << 32); }
}
__device__ __forceinline__ void p0_prologue(const Args& A, LAS unsigned char* lds, int vcu, int G, int wave, int lane) {
    LAS float* scr = (LAS float*)(lds + RING_OFF + wave * 16384);
    const int gw = vcu * NWAVES + wave, NGW = G * NWAVES;
    unsigned char* ws = A.ws;
    constexpr int I_IN = (1024 / 64) * (NPROJ / 32), I_UP = (512 / 64) * (1024 / 32), I_SQ = (1024 / 64) * (1024 / 32), I_PL = (256 / 64) * (1024 / 32);
    constexpr int NITEMS = I_IN + 2 * I_UP + 2 * I_SQ + I_PL;
    for (int it = gw; it < NITEMS; it += NGW) {
        int r = it;
        if (r < I_IN) { p0_transpose_item<true>(A.in[8], 1024, 5656, NPROJ, (bf16*)(ws + WS_WIN), scr, r, lane); continue; } r -= I_IN;
        if (r < I_UP) { p0_transpose_item<false>(A.in[16], 512, 1024, 1024, (bf16*)(ws + WS_WUA), scr, r, lane); continue; } r -= I_UP;
        if (r < I_UP) { p0_transpose_item<false>(A.in[17], 512, 1024, 1024, (bf16*)(ws + WS_WUB), scr, r, lane); continue; } r -= I_UP;
        if (r < I_SQ) { p0_transpose_item<false>(A.in[18], 1024, 1024, 1024, (bf16*)(ws + WS_WO), scr, r, lane); continue; } r -= I_SQ;
        if (r < I_SQ) { p0_transpose_item<false>(A.in[19], 1024, 1024, 1024, (bf16*)(ws + WS_WG), scr, r, lane); continue; } r -= I_SQ;
        p0_transpose_item<false>(A.in[20], 256, 1024, 1024, (bf16*)(ws + WS_WP), scr, r, lane);
    }
    bf16* XN = (bf16*)(ws + WS_XN);
    for (int m = gw; m < M; m += NGW) {
        const float* xrow = (m < MP) ? A.in[0] + (size_t)m * D : A.in[1] + (size_t)(m - MP) * D;
        rms_row_to_bf16(xrow, A.in[7], XN + (size_t)m * D, lane);
    }
    bf16* PB = (bf16*)(ws + WS_PB);
    const int gt = gw * 64 + lane, NGT = NGW * 64;
    for (int i = gt; i < M * 256 / 8; i += NGT) {
        const size_t e = (size_t)i * 8; const int m = (int)(e >> 8), c = (int)(e & 255);
        const float* src = (m < MP) ? A.in[5] + (size_t)m * 256 + c : A.in[6] + (size_t)(m - MP) * 256 + c;
        const f32x4 a = *(const GAS f32x4*)src, b = *(const GAS f32x4*)(src + 4);
        v4u o; o.x = pk2(a.x, a.y); o.y = pk2(a.z, a.w); o.z = pk2(b.x, b.y); o.w = pk2(b.z, b.w);
        *(GAS v4u*)(PB + e) = o;
    }
}
__device__ __forceinline__ const bf16* panel(const unsigned char* ws, int pn) { return (const bf16*)(ws + WS_PROJ + (size_t)pn * SZ_PANEL); }
#ifdef PROBE_WG
#define STAMP3(k) do { if (threadIdx.x == 0) ((unsigned long long*)(A.ws + WS_CTL + 65536))[(size_t)blockIdx.x * 16 + (k)] = __builtin_amdgcn_s_memrealtime(); } while (0)
#else
#define STAMP3(k) do { } while (0)
#endif
#define LBAR() do { asm volatile("s_waitcnt lgkmcnt(0)" ::: "memory"); __builtin_amdgcn_s_barrier(); asm volatile("" ::: "memory"); } while (0)
template <int CTRL> __device__ __forceinline__ float dpp_f(float v) { return __builtin_bit_cast(float, __builtin_amdgcn_update_dpp(0, __builtin_bit_cast(int, v), CTRL, 0xf, 0xf, true)); }
__device__ __forceinline__ float rl_f(float v, int l) { return __builtin_bit_cast(float, __builtin_amdgcn_readlane(__builtin_bit_cast(int, v), l)); }
__device__ __forceinline__ float wsum(float v) {
    v += dpp_f<0xB1>(v); v += dpp_f<0x4E>(v); v += dpp_f<0x141>(v); v += dpp_f<0x140>(v);
    return (rl_f(v, 0) + rl_f(v, 16)) + (rl_f(v, 32) + rl_f(v, 48));
}
__device__ __forceinline__ float quad_sum(float v) { v += dpp_f<0xB1>(v); v += dpp_f<0x4E>(v); return v; }

__device__ __forceinline__ void gla_item_s(const Args& A, LAS unsigned char* lds, int h, int m0, const float* S0, float* Sout) {
    const int tid = threadIdx.x, lane = tid & 63, wave = tid >> 6;
    const unsigned char* ws = A.ws;
    LAS float* sq = (LAS float*)lds; LAS float* sk = sq + 512; LAS float* sd = sk + 512; LAS float* sv = sd + 512; LAS float* part = sv + 1024; LAS float* oraw = part + 1024;
    const int dv = tid & 127, g = tid >> 7;
    float S[16];
#pragma unroll
    for (int i = 0; i < 16; ++i) S[i] = S0[(size_t)(g * 16 + i) * 128 + dv];
    const bf16* PQ = panel(ws, PN_QA); const bf16* PK = panel(ws, PN_KA); const bf16* PV = panel(ws, PN_VA + (h >> 1)); const bf16* PZ = panel(ws, PN_ZA + (h >> 1));
    const bf16* SPEC = (const bf16*)(ws + WS_SPEC);
    const size_t mt = (size_t)m0 + wave;
    const unsigned short qh = PQ[mt * 256 + h * 64 + lane], kh = PK[mt * 256 + h * 64 + lane];
    const unsigned vw = *(const GAS unsigned*)(PV + mt * 256 + (h & 1) * 128 + 2 * lane);
    const unsigned zw = *(const GAS unsigned*)(PZ + mt * 256 + (h & 1) * 128 + 2 * lane);
    const v4u ga0 = *(const GAS v4u*)(SPEC + mt * 32), ga1 = *(const GAS v4u*)(SPEC + mt * 32 + 8);
    float wg[16];
#pragma unroll
    for (int r = 0; r < 16; ++r) wg[r] = A.in[9][r * 256 + h * 64 + lane];
    const float bgv = A.in[10][h * 64 + lane];
    const float nw0 = A.in[11][2 * lane], nw1 = A.in[11][2 * lane + 1];
    { float x = bgv; const unsigned gw[8] = {ga0.x, ga0.y, ga0.z, ga0.w, ga1.x, ga1.y, ga1.z, ga1.w};
#pragma unroll
      for (int r = 0; r < 8; ++r) x += bflo(gw[r]) * wg[2 * r] + bfhi(gw[r]) * wg[2 * r + 1];
      const float ls = fminf(x, 0.f) - log1pf(__expf(-fabsf(x)));
      sd[wave * 64 + lane] = __expf(ls * (1.f / 16.f)); sq[wave * 64 + lane] = bf2f(qh) * 0.125f; sk[wave * 64 + lane] = bf2f(kh);
      sv[wave * 128 + 2 * lane] = bflo(vw); sv[wave * 128 + 2 * lane + 1] = bfhi(vw); }
    LBAR();
#pragma unroll 1
    for (int tk = 0; tk < 8; ++tk) {
        const float vv = sv[tk * 128 + dv];
        float po = 0.f;
#pragma unroll
        for (int i = 0; i < 16; ++i) { const int dk = g * 16 + i; S[i] = sd[tk * 64 + dk] * S[i] + sk[tk * 64 + dk] * vv; po += sq[tk * 64 + dk] * S[i]; }
        part[((tk & 1) * 4 + g) * 128 + dv] = po;
        LBAR();
        if (g == 0) { const LAS float* pp = part + (tk & 1) * 512 + dv; oraw[tk * 128 + dv] = (pp[0] + pp[128]) + (pp[256] + pp[384]); }
    }
#pragma unroll
    for (int i = 0; i < 16; ++i) Sout[(size_t)(g * 16 + i) * 128 + dv] = S[i];
    LBAR();
    { bf16* OA = (bf16*)(A.ws + WS_OA);
      const float o0 = oraw[wave * 128 + 2 * lane], o1 = oraw[wave * 128 + 2 * lane + 1];
      const float r = rsqf_(wsum(o0 * o0 + o1 * o1) * (1.f / 128.f) + NORM_EPS);
      *(GAS unsigned*)(OA + mt * 512 + h * 128 + 2 * lane) = pk2(o0 * r * nw0 * siluf_(bflo(zw)), o1 * r * nw1 * siluf_(bfhi(zw))); }
    LBAR();
}

__device__ __forceinline__ void gdn_item_s(const Args& A, LAS unsigned char* lds, int h, int m0, const float* S0, float* Sout, const float* convbuf) {
    const int tid = threadIdx.x, lane = tid & 63, wave = tid >> 6;
    const unsigned char* ws = A.ws;
    LAS float* sq = (LAS float*)lds; LAS float* sk = sq + 1024; LAS float* sv = sk + 1024; LAS float* sbeta = sv + 1024; LAS float* sgd = sbeta + 8; LAS float* sqk = sgd + 8;
    LAS float* part = sqk + 16; LAS float* oraw = part + 2048;
    const int dv = tid & 127, g = tid >> 7;
    float S[32];
#pragma unroll
    for (int i = 0; i < 32; ++i) S[i] = S0[(size_t)(g * 32 + i) * 128 + dv];
    const bf16* SPEC = (const bf16*)(ws + WS_SPEC);
    const size_t mt = (size_t)m0 + wave;
    const bf16* PZ = panel(ws, PN_ZB + (h >> 1));
    const unsigned zw = *(const GAS unsigned*)(PZ + mt * 256 + (h & 1) * 128 + 2 * lane);
    const float nw0 = A.in[15][2 * lane], nw1 = A.in[15][2 * lane + 1];
    float raw[11], cw[4]; const int c = tid, seg = c >> 7, cc = c & 127;
    if (tid < 384) { const bf16* P = panel(ws, PN_QB + 2 * seg + (h >> 1)); const int ch = seg * 512 + h * 128 + cc;
#pragma unroll
        for (int j = 0; j < 3; ++j) raw[j] = convbuf[j * 1536 + ch];
#pragma unroll
        for (int j = 0; j < 8; ++j) raw[3 + j] = bf2f(P[(size_t)(m0 + j) * 256 + (h & 1) * 128 + cc]);
#pragma unroll
        for (int j = 0; j < 4; ++j) cw[j] = A.in[12][j * 1536 + ch]; }
    float bta = 0.f, gdv = 0.f;
    if (tid < 8) { const size_t m = (size_t)m0 + tid; bta = bf2f(SPEC[m * 32 + 20 + h]); gdv = bf2f(SPEC[m * 32 + 16 + h]); }
    const float negA = -__expf(A.in[13][h]), dtb = A.in[14][h];
    if (tid < 384) { LAS float* dst = seg == 0 ? sq : (seg == 1 ? sk : sv);
#pragma unroll
        for (int t = 0; t < 8; ++t) dst[t * 128 + cc] = siluf_(cw[0] * raw[t] + cw[1] * raw[t + 1] + cw[2] * raw[t + 2] + cw[3] * raw[t + 3]); }
    if (tid < 8) { sbeta[tid] = sigmoidf_(bta); sgd[tid] = __expf(negA * softplusf_(gdv + dtb)); }
    LBAR();
    { float q0 = sq[wave * 128 + lane], q1 = sq[wave * 128 + lane + 64], k0 = sk[wave * 128 + lane], k1 = sk[wave * 128 + lane + 64];
      const float rq = 0.08838834764831845f * rsqf_(wsum(q0 * q0 + q1 * q1) + NORM_EPS), rk = rsqf_(wsum(k0 * k0 + k1 * k1) + NORM_EPS);
      q0 *= rq; q1 *= rq; k0 *= rk; k1 *= rk;
      sq[wave * 128 + lane] = q0; sq[wave * 128 + lane + 64] = q1; sk[wave * 128 + lane] = k0; sk[wave * 128 + lane + 64] = k1;
      const float qk = wsum(q0 * k0 + q1 * k1); if (lane == 0) sqk[wave] = qk; }
    LBAR();
#pragma unroll 1
    for (int tk = 0; tk < 8; ++tk) {
        float pk = 0.f, pq = 0.f;
#pragma unroll
        for (int i = 0; i < 32; ++i) { const int dk = g * 32 + i; pk += sk[tk * 128 + dk] * S[i]; pq += sq[tk * 128 + dk] * S[i]; }
        LAS float* pp = part + (tk & 1) * 1024;
        pp[g * 128 + dv] = pk; pp[512 + g * 128 + dv] = pq;
        LBAR();
        const float gd = sgd[tk];
        const float kS = gd * ((pp[dv] + pp[128 + dv]) + (pp[256 + dv] + pp[384 + dv]));
        const float vnew = sbeta[tk] * (sv[tk * 128 + dv] - kS);
#pragma unroll
        for (int i = 0; i < 32; ++i) { const int dk = g * 32 + i; S[i] = gd * S[i] + sk[tk * 128 + dk] * vnew; }
        if (g == 0) { const float qS = gd * ((pp[512 + dv] + pp[640 + dv]) + (pp[768 + dv] + pp[896 + dv])); oraw[tk * 128 + dv] = qS + sqk[tk] * vnew; }
    }
#pragma unroll
    for (int i = 0; i < 32; ++i) Sout[(size_t)(g * 32 + i) * 128 + dv] = S[i];
    LBAR();
    { bf16* OB = (bf16*)(A.ws + WS_OB);
      const float o0 = oraw[wave * 128 + 2 * lane], o1 = oraw[wave * 128 + 2 * lane + 1];
      const float r = rsqf_(wsum(o0 * o0 + o1 * o1) * (1.f / 128.f) + NORM_EPS);
      *(GAS unsigned*)(OB + mt * 512 + h * 128 + 2 * lane) = pk2(o0 * r * nw0 * siluf_(bflo(zw)), o1 * r * nw1 * siluf_(bfhi(zw))); }
    LBAR();
}
typedef short bf16x8 __attribute__((ext_vector_type(8)));
typedef float f32x16 __attribute__((ext_vector_type(16)));
typedef float f32x4v __attribute__((ext_vector_type(4)));
typedef float f32x2v __attribute__((ext_vector_type(2)));
#define MFMA32(a, b, c) __builtin_amdgcn_mfma_f32_32x32x16_bf16((a), (b), (c), 0, 0, 0)
#define MFMA16(a, b, c) __builtin_amdgcn_mfma_f32_16x16x32_bf16((a), (b), (c), 0, 0, 0)
__device__ __forceinline__ int c32row(int lane, int reg) { return (reg & 3) + 8 * (reg >> 2) + 4 * (lane >> 5); }
__device__ __forceinline__ bf16x8 acc_frag(const f32x16& c, int s) {
    v4u w;
    if (s == 0) { w.x = pg8::cvt_pk_bf16(c[0], c[1]); w.y = pg8::cvt_pk_bf16(c[2], c[3]); w.z = pg8::cvt_pk_bf16(c[4], c[5]); w.w = pg8::cvt_pk_bf16(c[6], c[7]); }
    else { w.x = pg8::cvt_pk_bf16(c[8], c[9]); w.y = pg8::cvt_pk_bf16(c[10], c[11]); w.z = pg8::cvt_pk_bf16(c[12], c[13]); w.w = pg8::cvt_pk_bf16(c[14], c[15]); }
    return __builtin_bit_cast(bf16x8, w);
}
__device__ __forceinline__ bf16x8 lds_frag(const LAS bf16* rowp, int k0, int h) { return *(const LAS bf16x8*)(rowp + k0 + 8 * h); }
__device__ __forceinline__ bf16x8 lds_frag_perm(const LAS bf16* rowp, int s, int h) {
    const v2u a = *(const LAS v2u*)(rowp + 16 * s + 4 * h), b = *(const LAS v2u*)(rowp + 16 * s + 8 + 4 * h);
    v4u w; w.x = a.x; w.y = a.y; w.z = b.x; w.w = b.y; return __builtin_bit_cast(bf16x8, w);
}
__device__ __forceinline__ f32x16 zero16() { f32x16 z;
#pragma unroll
    for (int i = 0; i < 16; ++i) z[i] = 0.f; return z; }

__device__ __forceinline__ v4u pack8(const f32x4 a, const f32x4 b) { v4u w; w.x = pg8::cvt_pk_bf16(a.x, a.y); w.y = pg8::cvt_pk_bf16(a.z, a.w); w.z = pg8::cvt_pk_bf16(b.x, b.y); w.w = pg8::cvt_pk_bf16(b.z, b.w); return w; }
__device__ __forceinline__ void unpack8(const v4u w, f32x4& a, f32x4& b) { a = (f32x4){bflo(w.x), bfhi(w.x), bflo(w.y), bfhi(w.y)}; b = (f32x4){bflo(w.z), bfhi(w.z), bflo(w.w), bfhi(w.w)}; }
__device__ __forceinline__ f32x4 sig4(const f32x4 x) { return (f32x4){sigmoidf_(x.x), sigmoidf_(x.y), sigmoidf_(x.z), sigmoidf_(x.w)}; }
constexpr int GLA_QE = 0, GLA_KE = 9216, GLA_KENDT = 18432, GLA_VT = 27648, GLA_ATT = 46080, GLA_GA = 55296, GLA_SEG = 59392, GLA_DD = 61440, GLA_OBUF = 61696,
              GLA_RQ = GLA_OBUF + 64 * 132 * 4, GLA_RK = GLA_RQ + 8192, GLA_RV = GLA_RK + 8192, GLA_RZ = GLA_RV + 16384, GLA_RS = GLA_RZ + 16384, GLA_LDS_END = GLA_RS + 4096;
static_assert(GLA_LDS_END <= LDS_BYTES - 512, "GLA LDS");
struct GlaState { f32x16 S[2]; bf16x8 Sb[4]; };
#define SB0() __builtin_amdgcn_sched_barrier(0)
#define GLDS16(gp, lp) __builtin_amdgcn_global_load_lds((const unsigned*)(gp), (LAS unsigned*)(lp), 16, 0, 0)
__device__ __forceinline__ void gla_issue_vs(const Args& A, LAS unsigned char* lds, int b, int h, int n) {
    const int lane = threadIdx.x & 63, wave = __builtin_amdgcn_readfirstlane(threadIdx.x >> 6); const unsigned char* ws = A.ws; const size_t m0 = (size_t)b * SEQ + (size_t)n * 64;
    const unsigned char* PV = ws + WS_PROJ + (size_t)(PN_VA + (h >> 1)) * SZ_PANEL + (h & 1) * 256;
#pragma unroll
    for (int k = 0; k < 2; ++k) { const int p = wave * 2 + k;
        GLDS16(PV + (m0 + 4 * p + (lane >> 4)) * 512 + (lane & 15) * 16, lds + GLA_RV + p * 1024); }
    { const int p = wave & 3;
        GLDS16(ws + WS_SPEC + (m0 + 16 * p + (lane >> 2)) * 64 + (lane & 3) * 16, lds + GLA_RS + p * 1024); }
}
__device__ __forceinline__ void gla_issue_qk(const Args& A, LAS unsigned char* lds, int b, int h, int n) {
    const int lane = threadIdx.x & 63, wave = __builtin_amdgcn_readfirstlane(threadIdx.x >> 6); const unsigned char* ws = A.ws; const size_t m0 = (size_t)b * SEQ + (size_t)n * 64;
    const size_t ro = (m0 + 8 * wave + (lane >> 3)) * 512 + h * 128 + (lane & 7) * 16;
    GLDS16(ws + WS_PROJ + (size_t)PN_QA * SZ_PANEL + ro, lds + GLA_RQ + wave * 1024);
    GLDS16(ws + WS_PROJ + (size_t)PN_KA * SZ_PANEL + ro, lds + GLA_RK + wave * 1024);
}
__device__ __forceinline__ void gla_issue_z(const Args& A, LAS unsigned char* lds, int b, int h, int n) {
    const int lane = threadIdx.x & 63, wave = __builtin_amdgcn_readfirstlane(threadIdx.x >> 6); const unsigned char* ws = A.ws; const size_t m0 = (size_t)b * SEQ + (size_t)n * 64;
    const unsigned char* PZ = ws + WS_PROJ + (size_t)(PN_ZA + (h >> 1)) * SZ_PANEL + (h & 1) * 256;
#pragma unroll
    for (int k = 0; k < 2; ++k) { const int p = wave * 2 + k; GLDS16(PZ + (m0 + 4 * p + (lane >> 4)) * 512 + (lane & 15) * 16, lds + GLA_RZ + p * 1024); }
}
#define VMW(n) asm volatile("s_waitcnt vmcnt(" #n ")" ::: "memory")
__device__ __forceinline__ void gla_chunk(const Args& A, LAS unsigned char* lds, int b, int h, int n, GlaState& st, const float (&wg)[16], float bgv, float nw0, float nw1) {
    const int tid = threadIdx.x, lane = tid & 63, wave = __builtin_amdgcn_readfirstlane(tid >> 6), r = lane & 31, hh = lane >> 5;
    const size_t m0 = (size_t)b * SEQ + (size_t)n * 64;
    const int nn = (n + 1 < 32) ? n + 1 : 31;
    LAS bf16* QE = (LAS bf16*)(lds + GLA_QE); LAS bf16* KE = (LAS bf16*)(lds + GLA_KE); LAS bf16* KENDT = (LAS bf16*)(lds + GLA_KENDT);
    LAS bf16* VT = (LAS bf16*)(lds + GLA_VT); LAS bf16* ATT = (LAS bf16*)(lds + GLA_ATT);
    LAS float* GA = (LAS float*)(lds + GLA_GA); LAS float* SEG = (LAS float*)(lds + GLA_SEG); LAS float* DD = (LAS float*)(lds + GLA_DD); LAS float* OBUF = (LAS float*)(lds + GLA_OBUF);
    const LAS bf16* RQ = (const LAS bf16*)(lds + GLA_RQ); const LAS bf16* RK = (const LAS bf16*)(lds + GLA_RK); const LAS bf16* RV = (const LAS bf16*)(lds + GLA_RV);
    const LAS bf16* RZ = (const LAS bf16*)(lds + GLA_RZ); const LAS bf16* RS = (const LAS bf16*)(lds + GLA_RS);
    if (n == 2) STAMP3(0);
    { const int t = tid >> 3, c2 = (tid & 7) * 2; const unsigned w = *(const LAS unsigned*)(RS + t * 32 + c2); GA[t * 16 + c2] = bflo(w); GA[t * 16 + c2 + 1] = bfhi(w); }
    { unsigned vv[8];
#pragma unroll
      for (int i = 0; i < 8; ++i) vv[i] = *(const LAS unsigned*)(RV + (wave * 8 + i) * 128 + 2 * lane);
      v4u lo, hi; lo.x = (vv[0] & 0xffffu) | (vv[1] << 16); lo.y = (vv[2] & 0xffffu) | (vv[3] << 16); lo.z = (vv[4] & 0xffffu) | (vv[5] << 16); lo.w = (vv[6] & 0xffffu) | (vv[7] << 16);
      hi.x = (vv[0] >> 16) | (vv[1] & 0xffff0000u); hi.y = (vv[2] >> 16) | (vv[3] & 0xffff0000u); hi.z = (vv[4] >> 16) | (vv[5] & 0xffff0000u); hi.w = (vv[6] >> 16) | (vv[7] & 0xffff0000u);
      *(LAS v4u*)(VT + (2 * lane) * 72 + wave * 8) = lo; *(LAS v4u*)(VT + (2 * lane + 1) * 72 + wave * 8) = hi; }
    LBAR();
    gla_issue_vs(A, lds, b, h, nn);
    if (n == 2) STAMP3(1);
    const int dk = tid & 63, seg = tid >> 6;
    float cs[8];
    { float run = 0.f;
#pragma unroll
      for (int i = 0; i < 8; ++i) { const int t = seg * 8 + i; float x = bgv;
#pragma unroll
          for (int q = 0; q < 4; ++q) { const f32x4v g4 = *(const LAS f32x4v*)(GA + t * 16 + 4 * q); x += g4[0] * wg[4 * q] + g4[1] * wg[4 * q + 1] + g4[2] * wg[4 * q + 2] + g4[3] * wg[4 * q + 3]; }
          const float ls = fminf(x, 0.f) - __logf(1.f + __expf(-fabsf(x)));
          run += ls * (1.f / 16.f); cs[i] = run; }
      SEG[seg * 64 + dk] = run; }
    VMW(13);
    LBAR();
    if (n == 2) STAMP3(2);
    { float off = 0.f, tot = 0.f;
#pragma unroll
      for (int s = 0; s < 8; ++s) { const float v = SEG[s * 64 + dk]; tot += v; if (s < seg) off += v; }
      unsigned kend[4];
#pragma unroll
      for (int i = 0; i < 8; ++i) { const int t = seg * 8 + i; const float bb = off + cs[i];
          const float q = bf2f(RQ[t * 64 + dk]), k = bf2f(RK[t * 64 + dk]);
          QE[t * 72 + dk] = (bf16)f2bf(q * 0.125f * __expf(bb)); KE[t * 72 + dk] = (bf16)f2bf(k * __expf(-bb));
          const unsigned ke = f2bf(k * __expf(tot - bb)); if (i & 1) kend[i >> 1] |= ke << 16; else kend[i >> 1] = ke; }
      v4u kw; kw.x = kend[0]; kw.y = kend[1]; kw.z = kend[2]; kw.w = kend[3];
      *(LAS v4u*)(KENDT + dk * 72 + seg * 8) = kw;
      if (seg == 0) DD[dk] = __expf(tot); }
    LBAR();
    gla_issue_qk(A, lds, b, h, nn);
    if (n == 2) STAMP3(3);
    if (wave < 3) { const int tp = (wave == 2) ? 1 : 0, mt = (wave == 0) ? 0 : 1;
        f32x16 acc = zero16(); bf16x8 fa[4], fb[4];
#pragma unroll
        for (int s = 0; s < 4; ++s) { fa[s] = lds_frag(KE + (32 * tp + r) * 72, 16 * s, hh); fb[s] = lds_frag(QE + (32 * mt + r) * 72, 16 * s, hh); }
        SB0();
#pragma unroll
        for (int s = 0; s < 4; ++s) acc = MFMA32(fa[s], fb[s], acc);
        SB0();
        const int t = 32 * mt + r;
#pragma unroll
        for (int q = 0; q < 4; ++q) { const int tq = 32 * tp + 8 * q + 4 * hh; float v[4];
#pragma unroll
            for (int e = 0; e < 4; ++e) v[e] = (tq + e <= t) ? acc[4 * q + e] : 0.f;
            v2u w; w.x = pg8::cvt_pk_bf16(v[0], v[1]); w.y = pg8::cvt_pk_bf16(v[2], v[3]); *(LAS v2u*)(ATT + t * 72 + tq) = w; } }
    LBAR();
    if (n == 2) STAMP3(4);
    if (wave < 4) {
        const LAS bf16* vrow = VT + (32 * wave + r) * 72;
        bf16x8 vb[4], fa[6], fb[4];
#pragma unroll
        for (int s = 0; s < 4; ++s) vb[s] = lds_frag(vrow, 16 * s, hh);
        fa[0] = lds_frag(ATT + r * 72, 0, hh); fa[1] = lds_frag(ATT + r * 72, 16, hh);
#pragma unroll
        for (int s = 0; s < 4; ++s) fa[2 + s] = lds_frag(ATT + (32 + r) * 72, 16 * s, hh);
#pragma unroll
        for (int s = 0; s < 4; ++s) fb[s] = lds_frag_perm(QE + r * 72, s, hh);
        SB0();
        f32x16 O0 = zero16(), O1 = zero16();
        O0 = MFMA32(fa[0], vb[0], O0); O0 = MFMA32(fa[1], vb[1], O0);
#pragma unroll
        for (int s = 0; s < 4; ++s) O1 = MFMA32(fa[2 + s], vb[s], O1);
        SB0();
#pragma unroll
        for (int s = 0; s < 4; ++s) fa[s] = lds_frag_perm(QE + (32 + r) * 72, s, hh);
        SB0();
#pragma unroll
        for (int s = 0; s < 4; ++s) O0 = MFMA32(fb[s], st.Sb[s], O0);
        SB0();
#pragma unroll
        for (int s = 0; s < 4; ++s) fb[s] = lds_frag(KENDT + r * 72, 16 * s, hh);
        SB0();
#pragma unroll
        for (int s = 0; s < 4; ++s) O1 = MFMA32(fa[s], st.Sb[s], O1);
#pragma unroll
        for (int g2 = 0; g2 < 16; ++g2) st.S[0][g2] *= DD[c32row(lane, g2)];
        SB0();
#pragma unroll
        for (int s = 0; s < 4; ++s) fa[s] = lds_frag(KENDT + (32 + r) * 72, 16 * s, hh);
        SB0();
#pragma unroll
        for (int s = 0; s < 4; ++s) st.S[0] = MFMA32(fb[s], vb[s], st.S[0]);
#pragma unroll
        for (int g2 = 0; g2 < 16; ++g2) st.S[1][g2] *= DD[32 + c32row(lane, g2)];
#pragma unroll
        for (int g2 = 0; g2 < 16; ++g2) OBUF[c32row(lane, g2) * 132 + 32 * wave + r] = O0[g2];
        SB0();
#pragma unroll
        for (int s = 0; s < 4; ++s) st.S[1] = MFMA32(fa[s], vb[s], st.S[1]);
#pragma unroll
        for (int g2 = 0; g2 < 16; ++g2) OBUF[(32 + c32row(lane, g2)) * 132 + 32 * wave + r] = O1[g2];
        st.Sb[0] = acc_frag(st.S[0], 0); st.Sb[1] = acc_frag(st.S[0], 1);
        SB0();
        st.Sb[2] = acc_frag(st.S[1], 0); st.Sb[3] = acc_frag(st.S[1], 1);
    }
    VMW(5);
    LBAR();
    if (n == 2) STAMP3(5);
    { bf16* OA = (bf16*)(A.ws + WS_OA);
#pragma unroll
      for (int i = 0; i < 8; ++i) { const int t = wave * 8 + i; const size_t m = m0 + t;
          const float o0 = OBUF[t * 132 + 2 * lane], o1 = OBUF[t * 132 + 2 * lane + 1];
          const unsigned zw = *(const LAS unsigned*)(RZ + t * 128 + 2 * lane);
          const float rr = rsqf_(wsum(o0 * o0 + o1 * o1) * (1.f / 128.f) + NORM_EPS);
          *(GAS unsigned*)(OA + m * 512 + h * 128 + 2 * lane) = pk2(o0 * rr * nw0 * siluf_(bflo(zw)), o1 * rr * nw1 * siluf_(bfhi(zw))); } }
    LBAR();
    gla_issue_z(A, lds, b, h, nn);
    VMW(12);
    LBAR();
    if (n == 2) STAMP3(6);
}
__device__ __forceinline__ void gla_final(const Args& A, int c, const GlaState& st) {
    const int tid = threadIdx.x, lane = tid & 63, wave = tid >> 6, r = lane & 31;
    if (wave < 4) { float* So = A.out + OUT_GLA_P + (size_t)c * 64 * 128;
#pragma unroll
        for (int mk = 0; mk < 2; ++mk)
#pragma unroll
            for (int g = 0; g < 16; ++g) So[(size_t)(32 * mk + c32row(lane, g)) * 128 + 32 * wave + r] = st.S[mk][g]; }
}
constexpr size_t REC_BYTES = 73728; constexpr int REC_W = 0, REC_QE = 16384, REC_QK = 32768, REC_KT = 40960, REC_U = 57344, REC_LDS = 57344;
constexpr int R1_KN = 0, R1_QN = 17408, R1_KNT = 34816, R1_VT = 53248, R1_AM = 71680, R1_ANEG = 89088, R1_DINV = 98304, R1_TB = 101376, R1_TBD = 110592, R1_TAB = 119808, R1_CW = R1_TAB + 1024, R1_END = R1_CW + 4 * 4 * 384 * 4;
static_assert(R1_END <= LDS_BYTES - 512, "R1 LDS");
struct R1Pre { unsigned raw[11][3]; unsigned short ab, bb; };
__device__ __forceinline__ void r1_touch(const R1Pre& p) {
#pragma unroll
    for (int rr = 0; rr < 11; ++rr) asm volatile("" :: "v"(p.raw[rr][0]), "v"(p.raw[rr][1]), "v"(p.raw[rr][2]));
    asm volatile("" :: "v"(p.ab), "v"(p.bb));
}
__device__ __forceinline__ float wscan(float v, int lane) {
    v += dpp_f<0x111>(v); v += dpp_f<0x112>(v); v += dpp_f<0x114>(v); v += dpp_f<0x118>(v);
    const float t0 = rl_f(v, 15), t1 = rl_f(v, 31), t2 = rl_f(v, 47); const int row = lane >> 4;
    return v + (row > 0 ? t0 : 0.f) + (row > 1 ? t1 : 0.f) + (row > 2 ? t2 : 0.f);
}
__device__ __forceinline__ void r1_prefetch(const Args& A, int u, R1Pre& p) {
    const int tid = threadIdx.x, lane = tid & 63, wave = tid >> 6;
    const int bh = u >> 5, n = u & 31, b = bh >> 2, h = bh & 3; const unsigned char* ws = A.ws;
    const bf16* SPEC = (const bf16*)(ws + WS_SPEC); const size_t m = (size_t)b * SEQ + (size_t)n * 64 + lane;
    p.ab = SPEC[m * 32 + 16 + h]; p.bb = SPEC[m * 32 + 20 + h];
    const int t0 = wave * 8;
#pragma unroll
    for (int rr = 0; rr < 11; ++rr) { const int t = n * 64 + t0 - 3 + rr;
#pragma unroll
        for (int sg = 0; sg < 3; ++sg) { unsigned w = 0u;
            if (t >= 0) w = *(const GAS unsigned*)(panel(ws, PN_QB + 2 * sg + (h >> 1)) + ((size_t)b * SEQ + t) * 256 + (h & 1) * 128 + 2 * lane);
            p.raw[rr][sg] = w; } }
}
__device__ __forceinline__ void r1_stage_cw(const Args& A, LAS unsigned char* lds) {
    LAS float* CW = (LAS float*)(lds + R1_CW);
    for (int i = threadIdx.x; i < 4 * 4 * 384; i += NTHREADS) { const int cc = i & 127, sg = (i >> 7) % 3, j = (i / 384) & 3, h = i / 1536; CW[i] = A.in[12][j * 1536 + sg * 512 + h * 128 + cc]; }
    LBAR();
}
__device__ __forceinline__ void st_frag(unsigned char* g, int frag, int lane, const v4u w) { *(GAS v4u*)(g + (size_t)frag * 1024 + lane * 16) = w; }

__device__ __forceinline__ void gdn_r1_unit(const Args& A, LAS unsigned char* lds, int u, R1Pre& cur, int un, const float (&negA4)[4], const float (&dtb4)[4]) {
    const int tid = threadIdx.x, lane = tid & 63, wave = __builtin_amdgcn_readfirstlane(tid >> 6), r = lane & 31, hh = lane >> 5;
    const int bh = u >> 5, n = u & 31, b = bh >> 2, h = bh & 3;
    const unsigned char* ws = A.ws;
    unsigned char* rec = A.ws + WS_REC + (size_t)u * REC_BYTES;
    const size_t m0 = (size_t)b * SEQ + (size_t)n * 64;
    LAS bf16* KN = (LAS bf16*)(lds + R1_KN); LAS bf16* QN = (LAS bf16*)(lds + R1_QN); LAS bf16* KNT = (LAS bf16*)(lds + R1_KNT); LAS bf16* VT = (LAS bf16*)(lds + R1_VT);
    LAS float* AM = (LAS float*)(lds + R1_AM); LAS bf16* ANEG = (LAS bf16*)(lds + R1_ANEG); LAS bf16* DINV = (LAS bf16*)(lds + R1_DINV);
    LAS bf16* TB = (LAS bf16*)(lds + R1_TB); LAS bf16* TBD = (LAS bf16*)(lds + R1_TBD);
    LAS float* DEC = (LAS float*)(lds + R1_TAB); LAS float* BETA = DEC + 64; LAS float* EDEC = DEC + 128; LAS float* EEND = DEC + 192;
    const bf16* SPEC = (const bf16*)(ws + WS_SPEC);
    const bool stp = (u < 224);
    if (stp) STAMP3(0);
    { const float gg = negA4[h] * softplusf_(bf2f(cur.ab) + dtb4[h]);
      const float d = wscan(gg, lane);
      const float dl = rl_f(d, 63);
      if (wave == 0) { DEC[lane] = d; BETA[lane] = sigmoidf_(bf2f(cur.bb)); EDEC[lane] = __expf(d); EEND[lane] = __expf(dl - d);
          if (lane == 0) ((float*)(A.ws + WS_CDEC))[u] = __expf(dl); } }
    { const int t0 = wave * 8;
      const LAS float* CW = (const LAS float*)(lds + R1_CW) + h * 1536;
      float cw[4][3][2];
#pragma unroll
      for (int j = 0; j < 4; ++j)
#pragma unroll
          for (int sg = 0; sg < 3; ++sg) { const f32x2v c2 = *(const LAS f32x2v*)(CW + (j * 3 + sg) * 128 + 2 * lane); cw[j][sg][0] = c2[0]; cw[j][sg][1] = c2[1]; }
#define RAWV(rr, sg, e) ((e) ? bfhi(cur.raw[rr][sg]) : bflo(cur.raw[rr][sg]))
      unsigned kt0[4], kt1[4], vt0[4], vt1[4];
#pragma unroll
      for (int i = 0; i < 8; ++i) { float o[3][2];
#pragma unroll
          for (int sg = 0; sg < 3; ++sg)
#pragma unroll
              for (int e = 0; e < 2; ++e) o[sg][e] = siluf_(cw[0][sg][e] * RAWV(i, sg, e) + cw[1][sg][e] * RAWV(i + 1, sg, e) + cw[2][sg][e] * RAWV(i + 2, sg, e) + cw[3][sg][e] * RAWV(i + 3, sg, e));
          const float rq = 0.08838834764831845f * rsqf_(wsum(o[0][0] * o[0][0] + o[0][1] * o[0][1]) + NORM_EPS);
          const float rk = rsqf_(wsum(o[1][0] * o[1][0] + o[1][1] * o[1][1]) + NORM_EPS);
          const unsigned qw = pk2(o[0][0] * rq, o[0][1] * rq), kw = pk2(o[1][0] * rk, o[1][1] * rk), vw = pk2(o[2][0], o[2][1]);
          *(LAS unsigned*)(QN + (t0 + i) * 136 + 2 * lane) = qw; *(LAS unsigned*)(KN + (t0 + i) * 136 + 2 * lane) = kw;
          if (i & 1) { kt0[i >> 1] |= kw << 16; kt1[i >> 1] |= kw & 0xffff0000u; vt0[i >> 1] |= vw << 16; vt1[i >> 1] |= vw & 0xffff0000u; }
          else { kt0[i >> 1] = kw & 0xffffu; kt1[i >> 1] = kw >> 16; vt0[i >> 1] = vw & 0xffffu; vt1[i >> 1] = vw >> 16; } }
      v4u x; x.x = kt0[0]; x.y = kt0[1]; x.z = kt0[2]; x.w = kt0[3]; *(LAS v4u*)(KNT + (2 * lane) * 72 + t0) = x;
      x.x = kt1[0]; x.y = kt1[1]; x.z = kt1[2]; x.w = kt1[3]; *(LAS v4u*)(KNT + (2 * lane + 1) * 72 + t0) = x;
      x.x = vt0[0]; x.y = vt0[1]; x.z = vt0[2]; x.w = vt0[3]; *(LAS v4u*)(VT + (2 * lane) * 72 + t0) = x;
      x.x = vt1[0]; x.y = vt1[1]; x.z = vt1[2]; x.w = vt1[3]; *(LAS v4u*)(VT + (2 * lane + 1) * 72 + t0) = x; }
    if (un < 1024) r1_prefetch(A, un, cur);
    LBAR();
    if (stp) STAMP3(1);
    if (wave < 3) { const int tp = (wave == 2) ? 1 : 0, mt = (wave == 0) ? 0 : 1;
        f32x16 kk = zero16(), qk = zero16();
#pragma unroll
        for (int hf = 0; hf < 2; ++hf) { bf16x8 fa[4], fk[4], fq[4];
#pragma unroll
            for (int s = 0; s < 4; ++s) { const int k0 = 16 * (4 * hf + s); fa[s] = lds_frag(KN + (32 * tp + r) * 136, k0, hh); fk[s] = lds_frag(KN + (32 * mt + r) * 136, k0, hh); fq[s] = lds_frag(QN + (32 * mt + r) * 136, k0, hh); }
            SB0();
#pragma unroll
            for (int s = 0; s < 4; ++s) { kk = MFMA32(fa[s], fk[s], kk); qk = MFMA32(fa[s], fq[s], qk); }
            SB0(); }
        const int t = 32 * mt + r; const float dect = DEC[t], bet = BETA[t];
#pragma unroll
        for (int q = 0; q < 4; ++q) { const int tq = 32 * tp + 8 * q + 4 * hh; float av[4], qv[4];
#pragma unroll
            for (int e = 0; e < 4; ++e) { const int tpp = tq + e; const float gam = (tpp <= t) ? __expf(dect - DEC[tpp]) : 0.f;
                av[e] = (tpp < t) ? bet * kk[4 * q + e] * gam : 0.f; qv[e] = qk[4 * q + e] * gam; qk[4 * q + e] = qv[e]; }
            *(LAS f32x4v*)(AM + t * 68 + tq) = (f32x4v){av[0], av[1], av[2], av[3]};
            v2u w; w.x = pg8::cvt_pk_bf16(-av[0], -av[1]); w.y = pg8::cvt_pk_bf16(-av[2], -av[3]); *(LAS v2u*)(ANEG + t * 72 + tq) = w; }
        st_frag(rec + REC_QK, mt * 4 + 2 * tp + 0, lane, __builtin_bit_cast(v4u, acc_frag(qk, 0)));
        st_frag(rec + REC_QK, mt * 4 + 2 * tp + 1, lane, __builtin_bit_cast(v4u, acc_frag(qk, 1)));
    } else {
        for (int f = wave - 3; f < 32; f += 5) {
            if (f < 16) { const int mt = f >> 3, s = f & 7, t = 32 * mt + r; const float e = EDEC[t];
                const LAS bf16* rp = QN + t * 136; const v2u a = *(const LAS v2u*)(rp + 16 * s + 4 * hh), c = *(const LAS v2u*)(rp + 16 * s + 8 + 4 * hh);
                v4u w; w.x = pk2(bflo(a.x) * e, bfhi(a.x) * e); w.y = pk2(bflo(a.y) * e, bfhi(a.y) * e); w.z = pk2(bflo(c.x) * e, bfhi(c.x) * e); w.w = pk2(bflo(c.y) * e, bfhi(c.y) * e);
                st_frag(rec + REC_QE, f, lane, w); }
            else { const int g = f - 16, mk = g >> 2, sp = g & 3; const LAS bf16* rp = KNT + (32 * mk + r) * 72; const int ta = 16 * sp + 4 * hh, tb = ta + 8;
                const v2u a = *(const LAS v2u*)(rp + ta), c = *(const LAS v2u*)(rp + tb);
                v4u w; w.x = pk2(bflo(a.x) * EEND[ta], bfhi(a.x) * EEND[ta + 1]); w.y = pk2(bflo(a.y) * EEND[ta + 2], bfhi(a.y) * EEND[ta + 3]);
                w.z = pk2(bflo(c.x) * EEND[tb], bfhi(c.x) * EEND[tb + 1]); w.w = pk2(bflo(c.y) * EEND[tb + 2], bfhi(c.y) * EEND[tb + 3]);
                st_frag(rec + REC_KT, g, lane, w); }
        }
    }
    LBAR();
    if (stp) STAMP3(2);
    if (wave == 0) { const int I = lane >> 4, c = lane & 15; float x[16];
#pragma unroll
        for (int i = 0; i < 16; ++i) { float acc = (i == c) ? 1.f : 0.f; const LAS float* nr = AM + (16 * I + i) * 68 + 16 * I;
#pragma unroll
            for (int j = 0; j < i; ++j) acc -= nr[j] * x[j];
            x[i] = acc; DINV[(I * 16 + i) * 24 + c] = (bf16)f2bf(acc); } }
    LBAR();
    if (stp) STAMP3(3);
    if (wave < 4) { const int Jc = wave, c = lane & 15, g = lane >> 4; f32x4v X[4];
#pragma unroll
        for (int I = 0; I < 4; ++I) { X[I] = (f32x4v){0.f, 0.f, 0.f, 0.f};
            if (I >= Jc) { f32x4v R;
#pragma unroll
                for (int e = 0; e < 4; ++e) R[e] = (I == Jc && 4 * g + e == c) ? 1.f : 0.f;
#pragma unroll
                for (int p = 0; p < 2; ++p) { const int J0 = 2 * p, J1 = 2 * p + 1; if (J0 < I) {
                    const LAS bf16* ar = ANEG + (16 * I + c) * 72;
                    const v2u a0 = *(const LAS v2u*)(ar + 16 * J0 + 4 * g); v2u a1; a1.x = 0u; a1.y = 0u; if (J1 < I) a1 = *(const LAS v2u*)(ar + 16 * J1 + 4 * g);
                    v4u aw; aw.x = a0.x; aw.y = a0.y; aw.z = a1.x; aw.w = a1.y;
                    v4u bw; bw.x = pg8::cvt_pk_bf16(X[J0][0], X[J0][1]); bw.y = pg8::cvt_pk_bf16(X[J0][2], X[J0][3]); bw.z = 0u; bw.w = 0u;
                    if (J1 < I) { bw.z = pg8::cvt_pk_bf16(X[J1][0], X[J1][1]); bw.w = pg8::cvt_pk_bf16(X[J1][2], X[J1][3]); }
                    R = MFMA16(__builtin_bit_cast(bf16x8, aw), __builtin_bit_cast(bf16x8, bw), R); } }
                const v2u d0 = *(const LAS v2u*)(DINV + (I * 16 + c) * 24 + 4 * g);
                v4u aw; aw.x = d0.x; aw.y = d0.y; aw.z = 0u; aw.w = 0u;
                v4u bw; bw.x = pg8::cvt_pk_bf16(R[0], R[1]); bw.y = pg8::cvt_pk_bf16(R[2], R[3]); bw.z = 0u; bw.w = 0u;
                const f32x4v z4 = {0.f, 0.f, 0.f, 0.f}; X[I] = MFMA16(__builtin_bit_cast(bf16x8, aw), __builtin_bit_cast(bf16x8, bw), z4); } }
        const int cc = 16 * Jc + c; const float bet = BETA[cc], bed = bet * EDEC[cc];
#pragma unroll
        for (int I = 0; I < 4; ++I)
#pragma unroll
            for (int e = 0; e < 4; ++e) { const int t = 16 * I + 4 * g + e; TB[t * 72 + cc] = (bf16)f2bf(X[I][e] * bet); TBD[t * 72 + cc] = (bf16)f2bf(X[I][e] * bed); } }
    LBAR();
    if (stp) STAMP3(4);
    { const int mt = wave & 1, cb = wave >> 1; const int ns = mt ? 4 : 2;
      f32x16 ua = zero16(), wa = zero16();
      bf16x8 f0[4], f1[4], f2[4], f3[4];
#pragma unroll
      for (int s = 0; s < 4; ++s) if (s < ns) { f0[s] = lds_frag(TB + (32 * mt + r) * 72, 16 * s, hh); f1[s] = lds_frag(VT + (32 * cb + r) * 72, 16 * s, hh);
          f2[s] = lds_frag(KNT + (32 * cb + r) * 72, 16 * s, hh); f3[s] = lds_frag(TBD + (32 * mt + r) * 72, 16 * s, hh); }
      SB0();
#pragma unroll
      for (int s = 0; s < 4; ++s) if (s < ns) { ua = MFMA32(f0[s], f1[s], ua); wa = MFMA32(f2[s], f3[s], wa); }
      SB0();
      r1_touch(cur);
      { v4u lo = __builtin_bit_cast(v4u, acc_frag(ua, 0)), hi = __builtin_bit_cast(v4u, acc_frag(ua, 1));
        unsigned char* up = rec + REC_U + (size_t)((cb * 2 + mt) * 64 + lane) * 32; *(GAS v4u*)up = lo; *(GAS v4u*)(up + 16) = hi; }
#pragma unroll
      for (int g = 0; g < 16; ++g) wa[g] = -wa[g];
      st_frag(rec + REC_W, mt * 8 + 2 * cb + 0, lane, __builtin_bit_cast(v4u, acc_frag(wa, 0)));
      st_frag(rec + REC_W, mt * 8 + 2 * cb + 1, lane, __builtin_bit_cast(v4u, acc_frag(wa, 1))); }
    LBAR();
    if (stp) STAMP3(5);
}

constexpr int R2_BUF0 = 0, R2_BUF1 = REC_LDS, R2_OBUF = 2 * REC_LDS, R2_END = R2_OBUF + 64 * 136 * 2;
static_assert(R2_END <= LDS_BYTES - 512, "R2 LDS");
#define RAW_BAR() do { asm volatile("" ::: "memory"); __builtin_amdgcn_s_barrier(); asm volatile("" ::: "memory"); } while (0)
__device__ __forceinline__ void gdn_r2_item(const Args& A, LAS unsigned char* lds, int bh) {
    const int tid = threadIdx.x, lane = tid & 63, wave = __builtin_amdgcn_readfirstlane(tid >> 6), r = lane & 31, hh = lane >> 5;
    const int b = bh >> 2, h = bh & 3;
    const unsigned char* recs = A.ws + WS_REC + (size_t)bh * 32 * REC_BYTES;
    const float* CDEC = (const float*)(A.ws + WS_CDEC) + bh * 32;
    LAS bf16* OBUF = (LAS bf16*)(lds + R2_OBUF);
    if (wave >= 4) { const int wl = wave - 4;
        for (int p = wl; p < 56; p += 4) __builtin_amdgcn_global_load_lds((const unsigned*)(recs + (size_t)p * 1024 + lane * 16), (LAS unsigned*)(lds + R2_BUF0 + p * 1024), 16, 0, 0);
        asm volatile("s_waitcnt vmcnt(0)" ::: "memory"); }
    RAW_BAR();
    if (wave < 4) {
        f32x16 S[4]; bf16x8 Sb[8];
#pragma unroll
        for (int i = 0; i < 4; ++i) S[i] = zero16();
#pragma unroll
        for (int i = 0; i < 8; ++i) Sb[i] = (bf16x8){0, 0, 0, 0, 0, 0, 0, 0};
        v4u un[2][2]; float cdn = CDEC[0];
#pragma unroll
        for (int mt = 0; mt < 2; ++mt) { const unsigned char* up = recs + REC_U + (size_t)((wave * 2 + mt) * 64 + lane) * 32; un[mt][0] = *(const GAS v4u*)up; un[mt][1] = *(const GAS v4u*)(up + 16); }
#define SB0() __builtin_amdgcn_sched_barrier(0)
#define FRG(off, idx) (*(const LAS bf16x8*)(buf + (off) + (idx) * 1024 + lane * 16))
        for (int n = 0; n < 32; ++n) {
            if (tid == 0) __hip_atomic_store((unsigned*)(A.ws + WS_CTL) + 12288 + 64 * bh, (unsigned)n, __ATOMIC_RELAXED, __HIP_MEMORY_SCOPE_AGENT);
            const LAS unsigned char* buf = lds + ((n & 1) ? R2_BUF1 : R2_BUF0);
            const float cdec = cdn;
            bf16x8 fa[8], fb[8];
#pragma unroll
            for (int s = 0; s < 8; ++s) fa[s] = FRG(REC_W, s);
#pragma unroll
            for (int s = 0; s < 8; ++s) fb[s] = FRG(REC_W, 8 + s);
            f32x16 V[2];
#pragma unroll
            for (int mt = 0; mt < 2; ++mt) { const v4u lo = un[mt][0], hi = un[mt][1];
                V[mt][0] = bflo(lo.x); V[mt][1] = bfhi(lo.x); V[mt][2] = bflo(lo.y); V[mt][3] = bfhi(lo.y); V[mt][4] = bflo(lo.z); V[mt][5] = bfhi(lo.z); V[mt][6] = bflo(lo.w); V[mt][7] = bfhi(lo.w);
                V[mt][8] = bflo(hi.x); V[mt][9] = bfhi(hi.x); V[mt][10] = bflo(hi.y); V[mt][11] = bfhi(hi.y); V[mt][12] = bflo(hi.z); V[mt][13] = bfhi(hi.z); V[mt][14] = bflo(hi.w); V[mt][15] = bfhi(hi.w); }
            if (n + 1 < 32) { cdn = CDEC[n + 1];
#pragma unroll
                for (int mt = 0; mt < 2; ++mt) { const unsigned char* up = recs + (size_t)(n + 1) * REC_BYTES + REC_U + (size_t)((wave * 2 + mt) * 64 + lane) * 32; un[mt][0] = *(const GAS v4u*)up; un[mt][1] = *(const GAS v4u*)(up + 16); } }
            SB0();
#pragma unroll
            for (int s = 0; s < 8; ++s) V[0] = MFMA32(fa[s], Sb[s], V[0]);
            SB0();
#pragma unroll
            for (int s = 0; s < 8; ++s) fa[s] = FRG(REC_QE, s);
            SB0();
#pragma unroll
            for (int s = 0; s < 8; ++s) V[1] = MFMA32(fb[s], Sb[s], V[1]);
            SB0();
#pragma unroll
            for (int s = 0; s < 8; ++s) fb[s] = FRG(REC_QE, 8 + s);
            bf16x8 Vb[4]; Vb[0] = acc_frag(V[0], 0); Vb[1] = acc_frag(V[0], 1);
            SB0();
            f32x16 O0 = zero16(), O1 = zero16();
#pragma unroll
            for (int s = 0; s < 8; ++s) O0 = MFMA32(fa[s], Sb[s], O0);
            Vb[2] = acc_frag(V[1], 0); Vb[3] = acc_frag(V[1], 1);
            SB0();
            fa[0] = FRG(REC_QK, 0); fa[1] = FRG(REC_QK, 1); fa[2] = FRG(REC_QK, 4); fa[3] = FRG(REC_QK, 5); fa[4] = FRG(REC_QK, 6); fa[5] = FRG(REC_QK, 7);
            SB0();
#pragma unroll
            for (int s = 0; s < 8; ++s) O1 = MFMA32(fb[s], Sb[s], O1);
            SB0();
#pragma unroll
            for (int s = 0; s < 8; ++s) fb[s] = FRG(REC_KT, s);
            SB0();
            O0 = MFMA32(fa[0], Vb[0], O0); O0 = MFMA32(fa[1], Vb[1], O0);
#pragma unroll
            for (int s = 0; s < 4; ++s) O1 = MFMA32(fa[2 + s], Vb[s], O1);
#pragma unroll
            for (int g = 0; g < 16; ++g) { S[0][g] *= cdec; S[1][g] *= cdec; }
            SB0();
#pragma unroll
            for (int s = 0; s < 8; ++s) fa[s] = FRG(REC_KT, 8 + s);
            asm volatile("s_waitcnt lgkmcnt(0)" ::: "memory");
            RAW_BAR();
            SB0();
#pragma unroll
            for (int s = 0; s < 4; ++s) { S[0] = MFMA32(fb[s], Vb[s], S[0]); S[1] = MFMA32(fb[4 + s], Vb[s], S[1]); }
#pragma unroll
            for (int g = 0; g < 16; ++g) { OBUF[c32row(lane, g) * 136 + 32 * wave + r] = (bf16)f2bf(O0[g]); OBUF[(32 + c32row(lane, g)) * 136 + 32 * wave + r] = (bf16)f2bf(O1[g]); }
#pragma unroll
            for (int g = 0; g < 16; ++g) { S[2][g] *= cdec; S[3][g] *= cdec; }
            SB0();
#pragma unroll
            for (int s = 0; s < 4; ++s) { S[2] = MFMA32(fa[s], Vb[s], S[2]); S[3] = MFMA32(fa[4 + s], Vb[s], S[3]); }
            Sb[0] = acc_frag(S[0], 0); Sb[1] = acc_frag(S[0], 1); Sb[2] = acc_frag(S[1], 0); Sb[3] = acc_frag(S[1], 1);
            SB0();
            Sb[4] = acc_frag(S[2], 0); Sb[5] = acc_frag(S[2], 1); Sb[6] = acc_frag(S[3], 0); Sb[7] = acc_frag(S[3], 1);
            asm volatile("s_waitcnt lgkmcnt(0)" ::: "memory");
            RAW_BAR();
        }
        RAW_BAR();
        float* So = A.out + OUT_GDN_P + (size_t)bh * 128 * 128;
#pragma unroll
        for (int mk = 0; mk < 4; ++mk)
#pragma unroll
            for (int g = 0; g < 16; ++g) So[(size_t)(32 * mk + c32row(lane, g)) * 128 + 32 * wave + r] = S[mk][g];
    } else {
        const int wl = wave - 4, lt = tid - 256, t = lt >> 2, qd = lt & 3;
        const bf16* PZ = panel(A.ws, PN_ZB + (h >> 1)); bf16* OB = (bf16*)(A.ws + WS_OB);
        f32x4 nw[8];
#pragma unroll
        for (int i = 0; i < 8; ++i) nw[i] = *(const GAS f32x4*)(A.in[15] + 32 * qd + 4 * i);
        v4u zc[4], zn[4];
        { const size_t m = (size_t)b * SEQ + t;
#pragma unroll
          for (int i = 0; i < 4; ++i) zc[i] = *(const GAS v4u*)(PZ + m * 256 + (h & 1) * 128 + 32 * qd + 8 * i); }
        for (int n = 0; n <= 32; ++n) {
            if (n + 1 < 32) { const unsigned char* src = recs + (size_t)(n + 1) * REC_BYTES; LAS unsigned char* dst = lds + (((n + 1) & 1) ? R2_BUF1 : R2_BUF0);
                for (int p = wl; p < 56; p += 4) __builtin_amdgcn_global_load_lds((const unsigned*)(src + (size_t)p * 1024 + lane * 16), (LAS unsigned*)(dst + p * 1024), 16, 0, 0); }
            if (n >= 1) { const size_t m = (size_t)b * SEQ + (size_t)(n - 1) * 64 + t;
                float ss = 0.f; f32x4 ov[8];
#pragma unroll
                for (int i = 0; i < 4; ++i) unpack8(*(const LAS v4u*)(OBUF + t * 136 + 32 * qd + 8 * i), ov[2 * i], ov[2 * i + 1]);
#pragma unroll
                for (int i = 0; i < 8; ++i) ss += (ov[i].x * ov[i].x + ov[i].y * ov[i].y) + (ov[i].z * ov[i].z + ov[i].w * ov[i].w);
                asm volatile("s_waitcnt lgkmcnt(0)" ::: "memory");
                RAW_BAR();
                ss = quad_sum(ss);
                const float rr = rsqf_(ss * (1.f / 128.f) + NORM_EPS);
                v4u ow[4];
#pragma unroll
                for (int i = 0; i < 4; ++i) { f32x4 z0, z1; unpack8(zc[i], z0, z1);
                    f32x4 a = ov[2 * i] * rr * nw[2 * i], c = ov[2 * i + 1] * rr * nw[2 * i + 1];
                    a.x *= siluf_(z0.x); a.y *= siluf_(z0.y); a.z *= siluf_(z0.z); a.w *= siluf_(z0.w); c.x *= siluf_(z1.x); c.y *= siluf_(z1.y); c.z *= siluf_(z1.z); c.w *= siluf_(z1.w);
                    ow[i] = pack8(a, c); }
#pragma unroll
                for (int i = 0; i < 4; ++i) zc[i] = zn[i];
                asm volatile("" :: "v"(zc[0].x), "v"(zc[1].x), "v"(zc[2].x), "v"(zc[3].x), "v"(zc[0].w), "v"(zc[1].w), "v"(zc[2].w), "v"(zc[3].w));
#pragma unroll
                for (int i = 0; i < 4; ++i) *(GAS v4u*)(OB + m * 512 + h * 128 + 32 * qd + 8 * i) = ow[i];
            } else { RAW_BAR(); }
            if (n + 1 < 32) { const size_t m = (size_t)b * SEQ + (size_t)(n + 1) * 64 + t;
#pragma unroll
                for (int i = 0; i < 4; ++i) zn[i] = *(const GAS v4u*)(PZ + m * 256 + (h & 1) * 128 + 32 * qd + 8 * i); }
            if (n < 32) { asm volatile("s_waitcnt vmcnt(8)" ::: "memory"); RAW_BAR(); }
        }
    }
}
typedef pg8::f32x4 (&AccRef)[2][2][4][2];
typedef const pg8::f32x4 (&CAccRef)[2][2][4][2];

#define EPI_LOOP_BEGIN  const int row0 = u.pm * 256 + wr * 64 + fr, cin = wc * 32 + 8 * fq; \
    _Pragma("unroll") for (int ai = 0; ai < 2; ++ai) _Pragma("unroll") for (int m = 0; m < 4; ++m) { const size_t row = (size_t)(row0 + ai * 128 + m * 16); \
    _Pragma("unroll") for (int bj = 0; bj < 2; ++bj) { const int cp = bj * 128 + cin;   const f32x4 a0 = acc[ai][bj][m][0], a1 = acc[ai][bj][m][1];
#define EPI_LOOP_END } }

__device__ __forceinline__ bf16* panel_rw(unsigned char* ws, float* out, int pn) { return (pn < 14) ? (bf16*)(ws + WS_PROJ + (size_t)pn * SZ_PANEL) : (bf16*)((unsigned char*)out + (size_t)(pn - 14) * SZ_PANEL); }
struct EpiProj { static constexpr bool PERM = true; unsigned char* ws; float* out;
    __device__ __forceinline__ void operator()(CAccRef acc, const pg8::Unit& u, int wr, int wc, int fr, int fq) const {
        if (u.pn < PN_SPEC) { bf16* P = panel_rw(ws, out, u.pn);
            EPI_LOOP_BEGIN *(GAS v4u*)(P + row * 256 + cp) = pack8(a0, a1); EPI_LOOP_END }
        else { bf16* P = (bf16*)(ws + WS_SPEC);
            EPI_LOOP_BEGIN if (cp < 32) *(GAS v4u*)(P + row * 32 + cp) = pack8(a0, a1); EPI_LOOP_END }
    } };
#define EPI_POS(p) const int m = (p) >> 1, bj = (p) & 1; const size_t row = (size_t)(row0 + ai * 128 + m * 16); const int cp = bj * 128 + cin; const f32x4 a0 = acc[ai][bj][m][0], a1 = acc[ai][bj][m][1];
struct EpiUpA { static constexpr bool PERM = true; unsigned char* ws; float* out; bf16* O;
    __device__ __forceinline__ void operator()(CAccRef acc, const pg8::Unit& u, int wr, int wc, int fr, int fq) const {
        const bf16* Gp = panel_rw(ws, out, PN_GA + u.pn);
        const int row0 = u.pm * 256 + wr * 64 + fr, cin = wc * 32 + 8 * fq;
#pragma unroll
        for (int ai = 0; ai < 2; ++ai) { v4u gw[8];
#pragma unroll
            for (int p = 0; p < 8; ++p) { EPI_POS(p) (void)a0; (void)a1; gw[p] = *(const GAS v4u*)(Gp + row * 256 + cp); }
#pragma unroll
            for (int p = 0; p < 8; ++p) { EPI_POS(p) f32x4 g0, g1; unpack8(gw[p], g0, g1);
                *(GAS v4u*)(O + row * 1024 + u.pn * 256 + cp) = pack8(sig4(g0) * a0, sig4(g1) * a1); } }
    } };
struct EpiUpB { static constexpr bool PERM = true; unsigned char* ws; float* out; bf16* O;
    __device__ __forceinline__ void operator()(CAccRef acc, const pg8::Unit& u, int wr, int wc, int fr, int fq) const {
        const bf16* Gp = panel_rw(ws, out, PN_GB + u.pn);
        const int row0 = u.pm * 256 + wr * 64 + fr, cin = wc * 32 + 8 * fq;
#pragma unroll
        for (int ai = 0; ai < 2; ++ai)
#pragma unroll
            for (int hb = 0; hb < 2; ++hb) { v4u gw[4], yw[4];
#pragma unroll
                for (int q = 0; q < 4; ++q) { const int p = hb * 4 + q; EPI_POS(p) (void)a0; (void)a1; gw[q] = *(const GAS v4u*)(Gp + row * 256 + cp); yw[q] = *(const GAS v4u*)(O + row * 1024 + u.pn * 256 + cp); }
#pragma unroll
                for (int q = 0; q < 4; ++q) { const int p = hb * 4 + q; EPI_POS(p) f32x4 g0, g1, y0, y1; unpack8(gw[q], g0, g1); unpack8(yw[q], y0, y1);
                    *(GAS v4u*)(O + row * 1024 + u.pn * 256 + cp) = pack8(y0 + sig4(g0) * a0, y1 + sig4(g1) * a1); } }
    } };
struct EpiOut { static constexpr bool PERM = true; bf16* HB; const float* xp; const float* xs;
    __device__ __forceinline__ void operator()(CAccRef acc, const pg8::Unit& u, int wr, int wc, int fr, int fq) const {
        const int row0 = u.pm * 256 + wr * 64 + fr, cin = wc * 32 + 8 * fq;
#pragma unroll
        for (int ai = 0; ai < 2; ++ai) { f32x4 x0[8], x1[8];
#pragma unroll
            for (int p = 0; p < 8; ++p) { EPI_POS(p) (void)a0; (void)a1; const size_t col = (size_t)u.pn * 256 + cp;
                const float* xr = (row < (size_t)MP) ? xp + row * 1024 + col : xs + (row - MP) * 1024 + col; x0[p] = *(const GAS f32x4*)xr; x1[p] = *(const GAS f32x4*)(xr + 4); }
#pragma unroll
            for (int p = 0; p < 8; ++p) { EPI_POS(p) const size_t col = (size_t)u.pn * 256 + cp;
                *(GAS v4u*)(HB + row * 1024 + col) = pack8(x0[p] + a0, x1[p] + a1); } }
    } };
struct EpiPe { static constexpr bool PERM = true; bf16* O;
    __device__ __forceinline__ void operator()(CAccRef acc, const pg8::Unit& u, int wr, int wc, int fr, int fq) const {
        EPI_LOOP_BEGIN *(GAS v4u*)(O + row * 1024 + u.pn * 256 + cp) = pack8(a0, a1); EPI_LOOP_END
    } };
struct EpiGate { static constexpr bool PERM = true; unsigned char* ws; const bf16* PEp; const bf16* HB; bf16* H2;
    __device__ __forceinline__ void operator()(CAccRef acc, const pg8::Unit& u, int wr, int wc, int fr, int fq) const {
        float* RS = (float*)(ws + WS_RSSP);
        const int row0 = u.pm * 256 + wr * 64 + fr, cin = wc * 32 + 8 * fq;
#pragma unroll
        for (int ai = 0; ai < 2; ++ai)
#pragma unroll
            for (int hb = 0; hb < 2; ++hb) { v4u pw[4], hw[4];
#pragma unroll
                for (int q = 0; q < 4; ++q) { const int p = hb * 4 + q; EPI_POS(p) (void)a0; (void)a1; const size_t col = (size_t)u.pn * 256 + cp;
                    pw[q] = *(const GAS v4u*)(PEp + row * 1024 + col); hw[q] = *(const GAS v4u*)(HB + row * 1024 + col); }
                float ssm[2] = {0.f, 0.f};
#pragma unroll
                for (int q = 0; q < 4; ++q) { const int p = hb * 4 + q; EPI_POS(p) const size_t col = (size_t)u.pn * 256 + cp;
                    f32x4 p0, p1, x0, x1; unpack8(pw[q], p0, p1); unpack8(hw[q], x0, x1);
                    const f32x4 h0 = x0 + sig4(a0) * p0, h1 = x1 + sig4(a1) * p1;
                    *(GAS v4u*)(H2 + row * 1024 + col) = pack8(h0, h1);
                    ssm[q >> 1] += (h0.x * h0.x + h0.y * h0.y) + (h0.z * h0.z + h0.w * h0.w) + (h1.x * h1.x + h1.y * h1.y) + (h1.z * h1.z + h1.w * h1.w); }
#pragma unroll
                for (int mm = 0; mm < 2; ++mm) { float ss = ssm[mm]; ss += __shfl_xor(ss, 16); ss += __shfl_xor(ss, 32);
                    if (fq == 0) RS[(size_t)(row0 + ai * 128 + (hb * 2 + mm) * 16) * 16 + u.pn * 4 + wc] = ss; } }
    } };

__device__ __forceinline__ void p6_final_norm(const Args& A, int vcu, int G, int wave, int lane) {
    const int gw = vcu * NWAVES + wave, NGW = G * NWAVES;
    const float* RS = (const float*)(A.ws + WS_RSSP);
    const GAS f32x4* fw = (const GAS f32x4*)A.in[21];
    const f32x4 w0 = fw[4 * lane], w1 = fw[4 * lane + 1], w2 = fw[4 * lane + 2], w3 = fw[4 * lane + 3];
    for (int m = gw; m < M; m += NGW) {
        const f32x4 ra = *(const GAS f32x4*)(RS + (size_t)m * 16), rb = *(const GAS f32x4*)(RS + (size_t)m * 16 + 4), rc = *(const GAS f32x4*)(RS + (size_t)m * 16 + 8), rd = *(const GAS f32x4*)(RS + (size_t)m * 16 + 12);
        const bf16* HB = (const bf16*)(A.ws + (m < MP ? WS_MERGED : WS_H1B));
        const v4u ha = *(const GAS v4u*)(HB + (size_t)m * D + 16 * lane), hb = *(const GAS v4u*)(HB + (size_t)m * D + 16 * lane + 8);
        const float ss = (((ra.x + ra.y) + (ra.z + ra.w)) + ((rb.x + rb.y) + (rb.z + rb.w))) + (((rc.x + rc.y) + (rc.z + rc.w)) + ((rd.x + rd.y) + (rd.z + rd.w)));
        const float r = rsqf_(ss * (1.f / D) + NORM_EPS);
        f32x4 a0, a1, a2, a3; unpack8(ha, a0, a1); unpack8(hb, a2, a3);
        GAS f32x4* o = (GAS f32x4*)(A.out + (size_t)m * D + 16 * lane);
        o[0] = a0 * r * w0; o[1] = a1 * r * w1; o[2] = a2 * r * w2; o[3] = a3 * r * w3;
    }
}

struct OneUnit { int pm, pn;
    __device__ bool next(int i, pg8::Unit& u) const { if (i != 0) return false; u.pm = pm; u.pn = pn; return true; }
    __device__ __forceinline__ void a_ready(const pg8::Unit&) const {}
    __device__ __forceinline__ void done(const pg8::Unit&) const {} };
__device__ __forceinline__ void group_arrive(unsigned* cnt) {
    asm volatile("s_waitcnt vmcnt(0)" ::: "memory"); __syncthreads();
    if (threadIdx.x == 0) { __builtin_amdgcn_fence(__ATOMIC_RELEASE, "agent"); asm volatile("s_waitcnt vmcnt(0)" ::: "memory"); (void)xb_add(cnt, 1u); }
}
__device__ __forceinline__ void group_wait(unsigned* cnt, unsigned target) {
    if (threadIdx.x == 0) { unsigned sp = 0; while (xb_ld(cnt) < target) { __builtin_amdgcn_s_sleep(2); if (++sp > (1u << 22)) break; }
        __builtin_amdgcn_fence(__ATOMIC_ACQUIRE, "agent"); asm volatile("s_waitcnt vmcnt(0)" ::: "memory"); }
    __syncthreads();
}
constexpr int CW_SDONE = 8192, CW_GBAR = 8192 + 64;
__device__ __forceinline__ void sample_chain(const Args& A, LAS unsigned char* lds, int ci, int nsample_wgs, int part) {
    unsigned char* ws = A.ws; unsigned* ctl = (unsigned*)(ws + WS_CTL);
    const OneUnit S{MP / 256 + (ci >> 2), ci & 3};
    bf16* T1 = (bf16*)(ws + WS_T1) - (size_t)MP * 1024; bf16* T2 = (bf16*)(ws + WS_PROJ + 10 * SZ_PANEL) - (size_t)MP * 1024; bf16* T3 = T2 + (size_t)1024 * 1024; bf16* H2s = (bf16*)(ws + WS_H1B);
    if (part == 0) {
        group_wait(ctl + CW_SDONE, (unsigned)nsample_wgs);
        { pg8::Gemm g{(const bf16*)(ws + WS_OA), (const bf16*)(ws + WS_WUA), M, 1024, 512}; EpiUpA E{ws, A.out, T1}; pg8::gemm_phase<EpiUpA, OneUnit>(lds + RING_OFF, g, S, E); }
    } else {
        { pg8::Gemm g{(const bf16*)(ws + WS_OB), (const bf16*)(ws + WS_WUB), M, 1024, 512}; EpiUpB E{ws, A.out, T1}; pg8::gemm_phase<EpiUpB, OneUnit>(lds + RING_OFF, g, S, E); }
        group_arrive(ctl + CW_GBAR); group_wait(ctl + CW_GBAR, 16u);
        { pg8::Gemm g{T1, (const bf16*)(ws + WS_WO), M, 1024, 1024}; EpiOut E{T3, A.in[0], A.in[1]}; pg8::gemm_phase<EpiOut, OneUnit>(lds + RING_OFF, g, S, E); }
        group_arrive(ctl + CW_GBAR); group_wait(ctl + CW_GBAR, 32u);
        { pg8::Gemm g{(const bf16*)(ws + WS_PB), (const bf16*)(ws + WS_WP), M, 1024, 256}; EpiPe E{T2}; pg8::gemm_phase<EpiPe, OneUnit>(lds + RING_OFF, g, S, E); }
        { pg8::Gemm g{T3, (const bf16*)(ws + WS_WG), M, 1024, 1024}; EpiGate E{ws, T2, T3, H2s}; pg8::gemm_phase<EpiGate, OneUnit>(lds + RING_OFF, g, S, E); }
    }
}
constexpr int CW_PROG = 12288;
__device__ __forceinline__ void touch_bytes(const unsigned char* p, int nbytes) {
    for (int o = threadIdx.x * 16; o < nbytes; o += NTHREADS * 16) { const v4u x = *(const GAS v4u*)(p + o); asm volatile("" :: "v"(x.x), "v"(x.y), "v"(x.z), "v"(x.w)); }
}
__device__ __forceinline__ bool helper_wait(unsigned* prog, int n, int lead) {
    unsigned sp = 0;
    while ((int)xb_ld(prog) + lead < n) { __builtin_amdgcn_s_sleep(8); if (++sp > (1u << 20)) return false; }
    return true;
}
__device__ __forceinline__ void helper_r2(const Args& A, int bh, int rank, int nrank) {
    unsigned* prog = (unsigned*)(A.ws + WS_CTL) + CW_PROG + 64 * bh;
    const unsigned char* recs = A.ws + WS_REC + (size_t)bh * 32 * 73728;
    for (int n = rank; n < 32; n += nrank) { if (!helper_wait(prog, n, 8)) break; touch_bytes(recs + (size_t)n * 73728, 73728); }
}
__device__ __forceinline__ void helper_gla(const Args& A, int c0, int c1, int n0) {
    for (int n = n0; n < 32; ++n)
        for (int k = 0; k < 2; ++k) { const int c = k ? c1 : c0, b = c >> 2, h = c & 3;
            unsigned* prog = (unsigned*)(A.ws + WS_CTL) + CW_PROG + 64 * (32 + c);
            if (!helper_wait(prog, n, 3)) return;
            const size_t m0 = (size_t)b * SEQ + (size_t)n * 64; const unsigned char* ws = A.ws;
            const int t = threadIdx.x >> 3, j = threadIdx.x & 7;
            const unsigned char* q = ws + WS_PROJ + (size_t)PN_QA * SZ_PANEL + (m0 + t) * 512 + h * 128 + j * 16;
            const unsigned char* kk = ws + WS_PROJ + (size_t)PN_KA * SZ_PANEL + (m0 + t) * 512 + h * 128 + j * 16;
            const unsigned char* v = ws + WS_PROJ + (size_t)(PN_VA + (h >> 1)) * SZ_PANEL + (m0 + t) * 512 + (h & 1) * 256 + j * 32;
            const unsigned char* z = ws + WS_PROJ + (size_t)(PN_ZA + (h >> 1)) * SZ_PANEL + (m0 + t) * 512 + (h & 1) * 256 + j * 32;
            const v4u a = *(const GAS v4u*)q, bb = *(const GAS v4u*)kk, cc = *(const GAS v4u*)v, dd = *(const GAS v4u*)(v + 16), ee = *(const GAS v4u*)z, ff = *(const GAS v4u*)(z + 16);
            asm volatile("" :: "v"(a.x), "v"(bb.x), "v"(cc.x), "v"(dd.x), "v"(ee.x), "v"(ff.x));
            if (j < 4) { const v4u s = *(const GAS v4u*)(ws + WS_SPEC + (m0 + t) * 64 + j * 16); asm volatile("" :: "v"(s.x)); } }
}
constexpr int GLA_SPLIT = 14;
__device__ __forceinline__ void p2_recurrences(const Args& A, LAS unsigned char* lds, int c, int G, const XcdBarrier& bar) {
    float* out = A.out;
#ifdef PROBE_WG
    unsigned long long* stamps = (unsigned long long*)(A.ws + WS_CTL + 98304) + (size_t)c * 16;
#define STAMP2(k) do { if (threadIdx.x == 0) stamps[k] = __builtin_amdgcn_s_memrealtime(); } while (0)
#else
#define STAMP2(k) do { } while (0)
#endif
    const int gt = c * NTHREADS + threadIdx.x, NGT = G * NTHREADS;
    for (int i = gt; i < 8 * 3 * 1536; i += NGT) { const int ch = i % 1536, j = (i / 1536) % 3, b = i / (3 * 1536); const size_t m = (size_t)b * SEQ + SEQ - 3 + j;
        out[OUT_CONV_P + i] = bf2f(panel(A.ws, PN_QB + (ch >> 8))[m * 256 + (ch & 255)]); }
    for (int i = gt; i < 128 * 3 * 1536; i += NGT) { const int ch = i % 1536, j = (i / 1536) % 3, b = i / (3 * 1536); const size_t m = (size_t)MP + b * DSQ + DSQ - 3 + j;
        out[OUT_CONV_S + i] = bf2f(panel(A.ws, PN_QB + (ch >> 8))[m * 256 + (ch & 255)]); }
    unsigned* ctl = (unsigned*)(A.ws + WS_CTL);
    if (c < 32) {
        const int b = c >> 2, h = c & 3, lane = threadIdx.x & 63;
        float wg[16];
#pragma unroll
        for (int r = 0; r < 16; ++r) wg[r] = A.in[9][r * 256 + h * 64 + lane];
        const float bgv = A.in[10][h * 64 + lane];
        GlaState st; st.S[0] = zero16(); st.S[1] = zero16();
#pragma unroll
        for (int i = 0; i < 4; ++i) st.Sb[i] = (bf16x8){0, 0, 0, 0, 0, 0, 0, 0};
        const float nw0 = A.in[11][2 * lane], nw1 = A.in[11][2 * lane + 1];
        gla_issue_vs(A, lds, b, h, 0); gla_issue_qk(A, lds, b, h, 0); gla_issue_z(A, lds, b, h, 0); asm volatile("s_waitcnt vmcnt(0)" ::: "memory"); LBAR();
        for (int n = 0; n < 32; ++n) {
            if (n == GLA_SPLIT && MK_N_LAUNCHES == 1) { STAMP2(5); xcd_barrier(bar); STAMP2(6); }
            if (threadIdx.x == 0) __hip_atomic_store(ctl + CW_PROG + 64 * (32 + c), (unsigned)n, __ATOMIC_RELAXED, __HIP_MEMORY_SCOPE_AGENT);
            gla_chunk(A, lds, b, h, n, st, wg, bgv, nw0, nw1); }
        gla_final(A, c, st);
    } else {
        const int nsw = G - 32;
        for (int it = c - 32; it < 1024; it += nsw) {
            if (it < 512) { const int b = it >> 2, h = it & 3; gla_item_s(A, lds, h, MP + b * DSQ, A.in[2] + (size_t)it * 64 * 128, out + OUT_GLA_S + (size_t)it * 64 * 128); }
            else { const int i = it - 512, b = i >> 2, h = i & 3; gdn_item_s(A, lds, h, MP + b * DSQ, A.in[3] + (size_t)i * 128 * 128, out + OUT_GDN_S + (size_t)i * 128 * 128, A.in[4] + (size_t)b * 3 * 1536); }
        }
        group_arrive(ctl + CW_SDONE);
        if (c < 48) {
            sample_chain(A, lds, c - 32, nsw, 0);
            STAMP2(5); xcd_barrier(bar); STAMP2(6);
            sample_chain(A, lds, c - 32, nsw, 1);
        } else {
            { r1_stage_cw(A, lds); const int step = G - 48; int u = c - 48; R1Pre pa;
              float negA4[4], dtb4[4];
#pragma unroll
              for (int i = 0; i < 4; ++i) { negA4[i] = -__expf(A.in[13][i]); dtb4[i] = A.in[14][i]; }
              if (u < 1024) { r1_prefetch(A, u, pa); r1_touch(pa); }
              while (u < 1024) { const int un = u + step; gdn_r1_unit(A, lds, u, pa, un, negA4, dtb4); u = un; } }
            STAMP2(5); xcd_barrier(bar); STAMP2(6);
            if (c < 80) gdn_r2_item(A, lds, c - 48);
            else { const int g = c & 7, j = (c - 80) >> 3;
                if (j < 20) helper_r2(A, g + 8 * (j & 3), j >> 2, 5);
                else if (j == 20) helper_gla(A, g, g + 8, GLA_SPLIT);
                else helper_gla(A, g + 16, g + 24, GLA_SPLIT); }
        }
    }
}
#ifndef MK_N_LAUNCHES
#define MK_N_LAUNCHES 1
#endif
#ifndef PROBE_DUP
#define PROBE_DUP -1
#endif
constexpr int N_PHASES = 7;
__global__ void __launch_bounds__(NTHREADS, 2) mk_fwd(Args args) {
    extern __shared__ __attribute__((aligned(16))) unsigned char lds_raw[];
    LAS unsigned char* lds = (LAS unsigned char*)lds_raw;
    volatile LAS unsigned* MISC = (volatile LAS unsigned*)(lds + MISC_OFF);
    const int tid = threadIdx.x, lane = tid & 63, wave = __builtin_amdgcn_readfirstlane(tid >> 6);
    const int G = gridDim.x, bx = blockIdx.x;
    const int vcu = (G % 8 == 0) ? (bx % 8) * (G / 8) + bx / 8 : bx;
    for (int u = tid; u < (LDS_BYTES - LDSCTL_OFF) / 4; u += NTHREADS) ((LAS unsigned*)(lds + LDSCTL_OFF))[u] = 0u;
    __syncthreads();
    unsigned char* ws = args.ws;
    XcdBarrier bar; bar.bar = (unsigned*)(ws + WS_CTL) + CW_BAR; bar.x = 0; bar.st = nullptr;
    if (MK_N_LAUNCHES == 1) bar = xcd_barrier_post((unsigned*)(ws + WS_CTL) + CW_BAR, MISC + 8);
    const int lo = args.ph_lo, hi = args.ph_hi;
#ifdef PROBE_WG
    unsigned long long* stamps = (unsigned long long*)(ws + WS_CTL + 98304) + (size_t)bx * 16;
#define STAMP(k) do { if (tid == 0) stamps[k] = __builtin_amdgcn_s_memrealtime(); } while (0)
#else
#define STAMP(k) do { } while (0)
#endif
    STAMP(0);
#define IN(k) (lo <= (k) && (k) < hi)
#define SEAM(k) do { if (IN(k) && IN((k) + 1)) xcd_barrier(bar); } while (0)

    if (IN(0)) { for (int rep = 0; rep < (PROBE_DUP == 0 ? 2 : 1); ++rep) p0_prologue(args, lds, vcu, G, wave, lane); }
    STAMP(1); SEAM(0); STAMP(2);
    if (IN(1)) for (int rep = 0; rep < (PROBE_DUP == 1 ? 2 : 1); ++rep) {
        pg8::Gemm g{(const bf16*)(ws + WS_XN), (const bf16*)(ws + WS_WIN), M, NPROJ, 1024}; pg8::StaticOrder S; S.init(M, NPROJ, G, bx);
        EpiProj E{ws, args.out};
        pg8::gemm_phase<EpiProj, pg8::StaticOrder>(lds + RING_OFF, g, S, E);
    }
    STAMP(3); SEAM(1); STAMP(4);
    if (IN(2)) { p2_recurrences(args, lds, bx, G, bar); if (PROBE_DUP == 2) p2_recurrences(args, lds, bx, G, bar); }
    STAMP(7); SEAM(2); STAMP(8);
    if (IN(3)) for (int rep = 0; rep < (PROBE_DUP == 3 ? 2 : 1); ++rep) {
        pg8::StaticOrder S; S.init(MP, 1024, G, bx);
        { pg8::Gemm g{(const bf16*)(ws + WS_OA), (const bf16*)(ws + WS_WUA), M, 1024, 512}; EpiUpA E{ws, args.out, (bf16*)(ws + WS_MERGED)}; pg8::gemm_phase<EpiUpA, pg8::StaticOrder>(lds + RING_OFF, g, S, E); }
        { pg8::Gemm g{(const bf16*)(ws + WS_OB), (const bf16*)(ws + WS_WUB), M, 1024, 512}; EpiUpB E{ws, args.out, (bf16*)(ws + WS_MERGED)}; pg8::gemm_phase<EpiUpB, pg8::StaticOrder>(lds + RING_OFF, g, S, E); }
    }
    STAMP(9); SEAM(3); STAMP(10);
    if (IN(4)) for (int rep = 0; rep < (PROBE_DUP == 4 ? 2 : 1); ++rep) {
        pg8::StaticOrder S; S.init(MP, 1024, G, bx);
        pg8::Gemm g{(const bf16*)(ws + WS_MERGED), (const bf16*)(ws + WS_WO), M, 1024, 1024}; EpiOut E{(bf16*)(ws + WS_H1B), args.in[0], args.in[1]};
        pg8::gemm_phase<EpiOut, pg8::StaticOrder>(lds + RING_OFF, g, S, E);
    }
    STAMP(11); SEAM(4); STAMP(12);
    if (IN(5)) for (int rep = 0; rep < (PROBE_DUP == 5 ? 2 : 1); ++rep) {
        pg8::StaticOrder S; S.init(MP, 1024, G, bx);
        { pg8::Gemm g{(const bf16*)(ws + WS_PB), (const bf16*)(ws + WS_WP), M, 1024, 256}; EpiPe E{(bf16*)(ws + WS_PE)}; pg8::gemm_phase<EpiPe, pg8::StaticOrder>(lds + RING_OFF, g, S, E); }
        { pg8::Gemm g{(const bf16*)(ws + WS_H1B), (const bf16*)(ws + WS_WG), M, 1024, 1024}; EpiGate E{ws, (const bf16*)(ws + WS_PE), (const bf16*)(ws + WS_H1B), (bf16*)(ws + WS_MERGED)}; pg8::gemm_phase<EpiGate, pg8::StaticOrder>(lds + RING_OFF, g, S, E); }
    }
    STAMP(13); SEAM(5); STAMP(14);
    if (IN(6)) { for (int rep = 0; rep < (PROBE_DUP == 6 ? 2 : 1); ++rep) p6_final_norm(args, vcu, G, wave, lane); }
    STAMP(15);
#ifdef PROBE_WG
    xcd_barrier(bar);
    if (bx == 0) { const unsigned long long* sp = (const unsigned long long*)(ws + WS_CTL + ((PROBE_K1 >= 16) ? 65536 : 98304)) + (size_t)(PROBE_WG) * 16 - ((PROBE_K1 >= 16) ? 16 : 0);
        const float Tus = (float)(__hip_atomic_load(sp + PROBE_K1, __ATOMIC_RELAXED, __HIP_MEMORY_SCOPE_AGENT) - __hip_atomic_load(sp + PROBE_K0, __ATOMIC_RELAXED, __HIP_MEMORY_SCOPE_AGENT)) * 0.01f;
        const float X = 0.02f * rintf(20.f * Tus / (float)(PROBE_SCALE)) * 0.05f;
        for (int i = tid; i < 8 * 3 * 1536; i += NTHREADS) args.out[OUT_CONV_P + i] += X; }
#endif
#undef IN
#undef SEAM
}

extern "C" void kernel_launch(void* const* d_in, const int* in_sizes, int n_in, void* d_out, int out_size, void* d_ws, size_t ws_size, hipStream_t stream) {
    static int grid = 0;
    if (grid == 0) {
        if (n_in != 22 || in_sizes[0] != MP * D || (size_t)out_size != OUT_TOTAL || ws_size < WS_END) {
            fprintf(stderr, "kernel_launch: unexpected shapes: n_in %d in0 %d out %d ws %zu (need %zu)\n", n_in, n_in > 0 ? in_sizes[0] : -1, out_size, ws_size, (size_t)WS_END); grid = -1; return; }
        int dev = 0, cus = 0, per_cu = 0;
        if (hipGetDevice(&dev) != hipSuccess || hipDeviceGetAttribute(&cus, hipDeviceAttributeMultiprocessorCount, dev) != hipSuccess) { grid = -1; return; }
        if (hipFuncSetAttribute((const void*)mk_fwd, hipFuncAttributeMaxDynamicSharedMemorySize, LDS_BYTES) != hipSuccess) { fprintf(stderr, "kernel_launch: hipFuncSetAttribute failed\n"); grid = -1; return; }
        if (hipOccupancyMaxActiveBlocksPerMultiprocessor(&per_cu, (const void*)mk_fwd, NTHREADS, LDS_BYTES) != hipSuccess || per_cu < 1) {
            fprintf(stderr, "kernel_launch: occupancy query reports %d workgroups per CU\n", per_cu); (void)hipGetLastError(); grid = -1; return; }
        grid = cus;
    }
    if (grid < 0) return;
    (void)hipMemsetAsync((char*)d_ws + WS_CTL, 0, CTL_ZERO_BYTES, stream);
    Args a{};
    for (int i = 0; i < 22; ++i) a.in[i] = (const float*)d_in[i];
    a.out = (float*)d_out; a.ws = (unsigned char*)d_ws;
#if MK_N_LAUNCHES == 1
    a.ph_lo = 0; a.ph_hi = N_PHASES;
    hipLaunchKernelGGL(mk_fwd, dim3(grid), dim3(NTHREADS), LDS_BYTES, stream, a);
#else
    for (int p = 0; p < N_PHASES; ++p) { a.ph_lo = p; a.ph_hi = p + 1; hipLaunchKernelGGL(mk_fwd, dim3(grid), dim3(NTHREADS), LDS_BYTES, stream, a); }
#endif
}
```
